# Optimizing an MI355X kernel written in HIP

```python
import jax, jax.numpy as jnp
from jax import lax
import numpy as np

D_MODEL = 2048
BATCH = 4
SEQ = 2048
DEPTH = 2

CHUNK = 64
Q_BLOCK = 128
EPS = 1e-6
MIX_WIDTH = D_MODEL
N_GROUPS = 4
GROUP_WIDTH = MIX_WIDTH // N_GROUPS
CONV_WIDTH = 3
POOL_WINDOWS = (2, 4, 8, 16)
POOL_GROUP_DIM = GROUP_WIDTH // len(POOL_WINDOWS)
GLA_HEADS = 4
GLA_VALUE_DIM = GROUP_WIDTH // GLA_HEADS
GLA_KEY_DIM = GLA_VALUE_DIM // 2
GLA_RANK = 16
GLA_TAU = 16.0
FOX_HEADS = 4
FOX_HEAD_DIM = GROUP_WIDTH // FOX_HEADS
FOX_GATE_BIAS = 3.0
D_FF = -(-8 * D_MODEL // (3 * 256)) * 256

IN_SPLITS = (
    GROUP_WIDTH, GROUP_WIDTH, GROUP_WIDTH,
    GROUP_WIDTH,
    GLA_HEADS * GLA_KEY_DIM, GLA_HEADS * GLA_KEY_DIM, GROUP_WIDTH, GROUP_WIDTH, GLA_RANK,
    GROUP_WIDTH, GROUP_WIDTH, GROUP_WIDTH, FOX_HEADS,
)
IN_COLS = sum(IN_SPLITS)

kernel_name = 'hybrid_conv_pool_gla_fox_trunk'


def _split_points():
    pts, acc = [], 0
    for s in IN_SPLITS[:-1]:
        acc += s
        pts.append(acc)
    return pts


def rmsnorm(x, g):
    xf = x.astype(jnp.float32)
    y = xf * lax.rsqrt(jnp.mean(xf * xf, axis=-1, keepdims=True) + EPS)
    return (y * g.astype(jnp.float32)).astype(x.dtype)


def short_gated_conv(b_gate, c_gate, h, conv_w):
    u = c_gate * h
    y = lax.conv_general_dilated(u, conv_w.astype(u.dtype), window_strides=(1,),
                                 padding=[(CONV_WIDTH - 1, 0)],
                                 dimension_numbers=('NWC', 'WIO', 'NWC'),
                                 feature_group_count=u.shape[-1])
    return b_gate * y


def multiscale_pool(p, pool_w, pool_scale):
    Bn, S, G = p.shape
    P = POOL_WINDOWS[-1]
    pg = p.astype(jnp.float32).reshape(Bn, S, len(POOL_WINDOWS), POOL_GROUP_DIM)
    cs = jnp.cumsum(jnp.pad(pg, ((0, 0), (P + 1, 0), (0, 0), (0, 0))), axis=1)
    t = jnp.arange(S, dtype=jnp.float32)
    diffs = []
    for gi, w in enumerate(POOL_WINDOWS):
        wsum = cs[:, P + 1:P + 1 + S, gi] - cs[:, P + 1 - w:P + 1 - w + S, gi]
        count = jnp.minimum(t + 1.0, float(w))[:, None]
        diffs.append(wsum / count - pg[:, :, gi])
    d = jnp.stack(diffs, axis=2)
    y = jnp.einsum('bsgc,gcd->bsgd', d, pool_w.astype(jnp.float32))
    return (y.reshape(Bn, S, G) * pool_scale.astype(jnp.float32)).astype(p.dtype)


def gated_linear_attention(q, k, v, g, a_low, w_decay, b_decay, out_g):
    Bn, S, _ = q.shape
    H, K, V = GLA_HEADS, GLA_KEY_DIM, GLA_VALUE_DIM
    N = S // CHUNK
    f32 = jnp.float32

    def chunks(t, d):
        return t.astype(f32).reshape(Bn, N, CHUNK, H, d).transpose(1, 0, 2, 3, 4)

    log_a = jax.nn.log_sigmoid((a_low @ w_decay + b_decay).astype(f32)) / GLA_TAU
    cum = jnp.cumsum(chunks(log_a, K), axis=2)
    qs = chunks(q, K) * (K ** -0.5)
    ks = chunks(k, K)
    vs = chunks(v, V)

    def step(state, inp):
        qc, kc, vc, cc = inp
        decay = jnp.exp(-jnp.abs(cc[:, :, None] - cc[:, None, :]))
        scores = jnp.einsum('bthk,btshk,bshk->bhts', qc, decay, kc)
        o_intra = jnp.einsum('bhts,bshv->bthv', scores, vc)
        o_inter = jnp.einsum('bthk,bhkv->bthv', qc * jnp.exp(cc), state)
        last = cc[:, -1]
        k_dec = kc * jnp.exp(last[:, None] - cc)
        state = state * jnp.exp(last)[..., None] + jnp.einsum('bshk,bshv->bhkv', k_dec, vc)
        return state, o_intra + o_inter

    state0 = jnp.zeros((Bn, H, K, V), f32)
    _, o = lax.scan(step, state0, (qs, ks, vs, cum))
    o = o.transpose(1, 0, 2, 3, 4).reshape(Bn, S, H, V)
    o = rmsnorm(o, out_g) * jax.nn.silu(g.astype(f32)).reshape(Bn, S, H, V)
    return o.reshape(Bn, S, H * V).astype(q.dtype)


def forgetting_attention(q, k, v, f_logit, q_g, k_g, b_f):
    Bn, S, _ = q.shape
    H, Dh = FOX_HEADS, FOX_HEAD_DIM
    q = rmsnorm(q.reshape(Bn, S, H, Dh), q_g)
    k = rmsnorm(k.reshape(Bn, S, H, Dh), k_g)
    v = v.reshape(Bn, S, H, Dh)
    log_f = jax.nn.log_sigmoid((f_logit + b_f).astype(jnp.float32))
    F = jnp.cumsum(log_f, axis=1).transpose(0, 2, 1)
    n_blk = S // Q_BLOCK
    q_blocks = q.reshape(Bn, n_blk, Q_BLOCK, H, Dh).transpose(1, 0, 2, 3, 4)
    F_blocks = F.reshape(Bn, H, n_blk, Q_BLOCK).transpose(2, 0, 1, 3)
    key_pos = jnp.arange(S)
    scale = Dh ** -0.5

    def attend_block(args):
        q_blk, F_blk, blk = args
        logits = jnp.einsum('bqhd,bshd->bhqs', q_blk, k).astype(jnp.float32) * scale
        logits = logits + F_blk[..., :, None] - F[..., None, :]
        q_pos = blk * Q_BLOCK + jnp.arange(Q_BLOCK)
        logits = jnp.where(key_pos[None, :] <= q_pos[:, None], logits, -jnp.inf)
        p = jax.nn.softmax(logits, axis=-1).astype(v.dtype)
        return jnp.einsum('bhqs,bshd->bqhd', p, v)

    out = lax.map(attend_block, (q_blocks, F_blocks, jnp.arange(n_blk)))
    return out.transpose(1, 0, 2, 3, 4).reshape(Bn, S, H * Dh)


def hybrid_mixer(u, w_in, conv_w, pool_w, pool_scale, gla_w_decay, gla_b_decay, gla_out_g,
                 fox_q_g, fox_k_g, fox_b_f, w_out):
    z = u @ w_in
    (cb, cc, ch, pu, gq, gk, gv, gg, ga, fq, fk, fv, ff) = jnp.split(z, _split_points(), axis=-1)
    y_a = short_gated_conv(cb, cc, ch, conv_w)
    y_b = multiscale_pool(pu, pool_w, pool_scale)
    y_c = gated_linear_attention(gq, gk, gv, gg, ga, gla_w_decay, gla_b_decay, gla_out_g)
    y_d = forgetting_attention(fq, fk, fv, ff, fox_q_g, fox_k_g, fox_b_f)
    y = jnp.concatenate([y_a.astype(u.dtype), y_b.astype(u.dtype),
                         y_c.astype(u.dtype), y_d.astype(u.dtype)], axis=-1)
    return y @ w_out


def swiglu_ffn(u, w_gate, w_up, w_down):
    return (jax.nn.silu(u @ w_gate) * (u @ w_up)) @ w_down


def setup_inputs(seed: int = 0) -> dict:
    key = jax.random.key(seed)
    ks = jax.random.split(key, 17)
    f32 = jnp.float32

    def nrm(k, shape, scale):
        return jax.random.normal(k, shape, f32) * scale

    G = GROUP_WIDTH
    return {
        'x': nrm(ks[0], (BATCH, SEQ, D_MODEL), 1.0),
        'norm_mix_g': 1.0 + nrm(ks[1], (DEPTH, D_MODEL), 0.02),
        'w_in': nrm(ks[2], (DEPTH, D_MODEL, IN_COLS), D_MODEL ** -0.5),
        'conv_w': nrm(ks[3], (DEPTH, CONV_WIDTH, 1, G), CONV_WIDTH ** -0.5),
        'pool_w': nrm(ks[4], (DEPTH, len(POOL_WINDOWS), POOL_GROUP_DIM, POOL_GROUP_DIM), POOL_GROUP_DIM ** -0.5),
        'pool_scale': 1.0 + nrm(ks[5], (DEPTH, G), 0.02),
        'gla_w_decay': nrm(ks[6], (DEPTH, GLA_RANK, GLA_HEADS * GLA_KEY_DIM), GLA_RANK ** -0.5),
        'gla_b_decay': nrm(ks[7], (DEPTH, GLA_HEADS * GLA_KEY_DIM), 0.1),
        'gla_out_g': 1.0 + nrm(ks[8], (DEPTH, GLA_VALUE_DIM), 0.02),
        'fox_q_g': 1.0 + nrm(ks[9], (DEPTH, FOX_HEAD_DIM), 0.02),
        'fox_k_g': 1.0 + nrm(ks[10], (DEPTH, FOX_HEAD_DIM), 0.02),
        'fox_b_f': FOX_GATE_BIAS + nrm(ks[11], (DEPTH, FOX_HEADS), 0.1),
        'w_out': nrm(ks[12], (DEPTH, MIX_WIDTH, D_MODEL), MIX_WIDTH ** -0.5),
        'norm_ffn_g': 1.0 + nrm(ks[13], (DEPTH, D_MODEL), 0.02),
        'w_gate': nrm(ks[14], (DEPTH, D_MODEL, D_FF), D_MODEL ** -0.5),
        'w_up': nrm(ks[15], (DEPTH, D_MODEL, D_FF), D_MODEL ** -0.5),
        'w_down': nrm(ks[16], (DEPTH, D_FF, D_MODEL), D_FF ** -0.5),
    }


def reference(x, norm_mix_g, w_in, conv_w, pool_w, pool_scale, gla_w_decay, gla_b_decay, gla_out_g,
              fox_q_g, fox_k_g, fox_b_f, w_out, norm_ffn_g, w_gate, w_up, w_down):
    h = x
    for l in range(DEPTH):
        u = rmsnorm(h, norm_mix_g[l])
        h = h + hybrid_mixer(u, w_in[l], conv_w[l], pool_w[l], pool_scale[l], gla_w_decay[l],
                             gla_b_decay[l], gla_out_g[l], fox_q_g[l], fox_k_g[l], fox_b_f[l], w_out[l])
        u = rmsnorm(h, norm_ffn_g[l])
        h = h + swiglu_ffn(u, w_gate[l], w_up[l], w_down[l])
    return h
```

```cpp
#include <hip/hip_runtime.h>
#include <cstdio>
#include <cstdint>
namespace pg8 {
#define PG8_LAS __attribute__((address_space(3)))
typedef unsigned short bf16_t;
typedef short bf16x8 __attribute__((ext_vector_type(8)));
typedef float f32x4 __attribute__((ext_vector_type(4)));
typedef unsigned u32x4 __attribute__((ext_vector_type(4)));
constexpr int BM = 256, BK = 64, HALF = 128, HTB = HALF * BK * 2  , STAGE_BYTES = 8 * HTB, NXCD = 8, WGM = 8;

__host__ __device__ __forceinline__ int lds_byte(int r, int c) { const int st = (r >> 4) * 2 + (c >> 5), rr = r & 15, cc = c & 31, ob = rr * 64 + cc * 2; return st * 1024 + (ob ^ (((ob >> 9) & 1) << 5)); }
__host__ __device__ __forceinline__ void stage_rc(int b, int& R, int& C) { const int st = b / 1024, sb = b % 1024, swz = sb ^ (((sb >> 9) & 1) << 5); R = (st >> 1) * 16 + swz / 64; C = (st & 1) * 32 + (swz % 64) / 2; }
__host__ __device__ __forceinline__ int perm32(int rho) { const int n = rho >> 4, i = rho & 15; return 8 * (i >> 2) + 4 * n + (i & 3); }

struct Unit { int pm, pn; };
struct Gemm { const bf16_t* A; const bf16_t* Bt; int M, N, K; };

struct StaticOrder {
    int nM, nN, nwg, G, c;
    __host__ __device__ void init(int M, int N, int G_, int c_) { nM = M / BM; nN = N / BM; nwg = nM * nN; G = G_; c = c_; }
    __host__ __device__ bool next(int i, Unit& u) const {
        const long L = (long)i * G + c; if (L >= nwg) return false;
        int wgid = (int)L; { const int q = nwg / NXCD, r = nwg % NXCD, xcd = wgid % NXCD, off = wgid / NXCD; wgid = (xcd < r ? xcd * (q + 1) : r * (q + 1) + (xcd - r) * q) + off; }
        const int nig = WGM * nN, gid = wgid / nig, fm = gid * WGM, gsz = (nM - fm) < WGM ? (nM - fm) : WGM;
        u.pm = fm + ((wgid % nig) % gsz); u.pn = (wgid % nig) / gsz; return true;
    }
    __device__ __forceinline__ void a_ready(const Unit&) const {}
    __device__ __forceinline__ void done(const Unit&) const {}
};

__device__ __forceinline__ unsigned cvt_pk_bf16(float lo, float hi) { unsigned r; asm volatile("v_cvt_pk_bf16_f32 %0, %1, %2" : "=v"(r) : "v"(lo), "v"(hi)); return r; }
typedef unsigned u32x2 __attribute__((ext_vector_type(2)));
__device__ __forceinline__ void load_rstd(const float* ssp, int row0, float (&rs)[2][4]) {
#pragma unroll
    for (int ai = 0; ai < 2; ++ai)
#pragma unroll
        for (int m = 0; m < 4; ++m) { const f32x4* p = (const f32x4*)(ssp + (size_t)(row0 + ai * HALF + m * 16) * 8); const f32x4 a = p[0], b = p[1];
            const float s = ((a[0] + a[1]) + (a[2] + a[3])) + ((b[0] + b[1]) + (b[2] + b[3])); rs[ai][m] = 1.0f / sqrtf(s * (1.0f / 2048.0f) + 1e-6f); }
}
struct EpiZ {
    static constexpr bool PERM = true, AFTER_DRAIN = false;
    bf16_t* Z; float* ZS; const float* ssp;
    __device__ __forceinline__ void operator()(const f32x4 (&acc)[2][2][4][2], const Unit& u, int wr, int wc, int fr, int fq) const {
        const int row0 = u.pm * BM + wr * 64 + fr; float rs[2][4]; load_rstd(ssp, row0, rs);
        if (u.pn < 20) {
            const int col0 = u.pn * BM + wc * 32 + 8 * fq;
#pragma unroll
            for (int ai = 0; ai < 2; ++ai)
#pragma unroll
                for (int m = 0; m < 4; ++m) { bf16_t* rowp = Z + (size_t)(row0 + ai * HALF + m * 16) * 5120 + col0; const float r = rs[ai][m];
#pragma unroll
                    for (int bj = 0; bj < 2; ++bj) { const f32x4 v0 = acc[ai][bj][m][0] * r, v1 = acc[ai][bj][m][1] * r;
                        u32x4 w; w.x = cvt_pk_bf16(v0[0], v0[1]); w.y = cvt_pk_bf16(v0[2], v0[3]); w.z = cvt_pk_bf16(v1[0], v1[1]); w.w = cvt_pk_bf16(v1[2], v1[3]);
                        *(u32x4*)(rowp + bj * HALF) = w; } }
        } else if (wc == 0 && fq < 3) {
#pragma unroll
            for (int ai = 0; ai < 2; ++ai)
#pragma unroll
                for (int m = 0; m < 4; ++m) { float* rp = ZS + (size_t)(row0 + ai * HALF + m * 16) * 32 + 8 * fq; const float r = rs[ai][m];
                    *(f32x4*)rp = acc[ai][0][m][0] * r; *(f32x4*)(rp + 4) = acc[ai][0][m][1] * r; }
        }
    }
};
struct EpiSwiglu {
    static constexpr bool PERM = true, AFTER_DRAIN = false;
    bf16_t* H; const float* ssp;
    __device__ __forceinline__ void operator()(const f32x4 (&acc)[2][2][4][2], const Unit& u, int wr, int wc, int fr, int fq) const {
        const int row0 = u.pm * BM + wr * 64 + fr; float rs[2][4]; load_rstd(ssp, row0, rs);
        const int col0 = u.pn * HALF + wc * 32 + 8 * fq;
#pragma unroll
        for (int ai = 0; ai < 2; ++ai)
#pragma unroll
            for (int m = 0; m < 4; ++m) { bf16_t* rowp = H + (size_t)(row0 + ai * HALF + m * 16) * 5632 + col0; const float r = rs[ai][m];
                float hv[8];
#pragma unroll
                for (int n = 0; n < 2; ++n)
#pragma unroll
                    for (int j = 0; j < 4; ++j) { const float g = acc[ai][0][m][n][j] * r, uu = acc[ai][1][m][n][j] * r;
                        hv[4 * n + j] = g * __builtin_amdgcn_rcpf(1.0f + __builtin_amdgcn_exp2f(-1.4426950408889634f * g)) * uu; }
                u32x4 w; w.x = cvt_pk_bf16(hv[0], hv[1]); w.y = cvt_pk_bf16(hv[2], hv[3]); w.z = cvt_pk_bf16(hv[4], hv[5]); w.w = cvt_pk_bf16(hv[6], hv[7]);
                *(u32x4*)rowp = w; }
    }
};
struct EpiRes {
    static constexpr bool PERM = false, AFTER_DRAIN = true;
    const float* base; float* out; bf16_t* xb; float* ssp; int stats;
    __device__ __forceinline__ void fused(f32x4 (&acc)[2][2][4][2], const Unit& u, int wr, int wc, int fr, int fq, PG8_LAS unsigned char* lds, int wid, int lane) const {
        PG8_LAS float* P = (PG8_LAS float*)lds;
        const int col0 = u.pn * BM + wc * 32 + 4 * fq;
#pragma unroll
        for (int ai = 0; ai < 2; ++ai)
#pragma unroll
            for (int m = 0; m < 4; ++m) { const int r = ai * HALF + wr * 64 + m * 16 + fr; const size_t off = (size_t)(u.pm * BM + r) * 2048 + col0; float s = 0.f;
#pragma unroll
                for (int bj = 0; bj < 2; ++bj)
#pragma unroll
                    for (int n = 0; n < 2; ++n) { const f32x4 bs = *(const f32x4*)(base + off + bj * HALF + n * 16); const f32x4 o = bs + acc[ai][bj][m][n];
                        *(f32x4*)(out + off + bj * HALF + n * 16) = o;
                        if (stats) { s += (o[0] * o[0] + o[1] * o[1]) + (o[2] * o[2] + o[3] * o[3]); u32x2 w; w.x = cvt_pk_bf16(o[0], o[1]); w.y = cvt_pk_bf16(o[2], o[3]); *(u32x2*)(xb + off + bj * HALF + n * 16) = w; } }
                if (stats) { s += __shfl_xor(s, 16); s += __shfl_xor(s, 32); if (fq == 0) P[r * 4 + wc] = s; }
                if (m & 1) asm volatile("" ::: "memory"); }
        if (stats) {
            asm volatile("s_waitcnt lgkmcnt(0)" ::: "memory"); __builtin_amdgcn_s_barrier(); asm volatile("" ::: "memory");
            const int tid = wid * 64 + lane;
            if (tid < 256) { const float s = (P[tid * 4 + 0] + P[tid * 4 + 1]) + (P[tid * 4 + 2] + P[tid * 4 + 3]); ssp[(size_t)(u.pm * BM + tid) * 8 + u.pn] = s; }
        }
    }
};
template <class Epi, class Sched, bool ALIGN_EPI = false, bool SP2 = false>
__device__ __forceinline__ void gemm_phase(PG8_LAS unsigned char* lds, const Gemm g, const Sched& S, const Epi& E) {
    int tid_ = threadIdx.x; asm volatile("" : "+v"(tid_));
    const int tid = tid_, wid = __builtin_amdgcn_readfirstlane(tid >> 6), lane = tid & 63, wr = wid >> 2, wc = wid & 3, fr = lane & 15, fq = lane >> 4;
    const int K = g.K, nt = K / BK;
    unsigned voffA[2], voffB[2];
#pragma unroll
    for (int i = 0; i < 2; ++i) { int R, C; stage_rc(tid * 16 + i * 8192, R, C); const int Rb = Epi::PERM ? ((R & ~31) + perm32(R & 31)) : R;
        voffA[i] = (unsigned)(R * K + C) * 2u; voffB[i] = (unsigned)(Rb * K + C) * 2u; }
    const size_t kstep = (size_t)(BK * 2);
    const size_t hstep = (size_t)HALF * K * 2;
    const size_t tstep = 2 * hstep;
    const unsigned ldsw = (unsigned)wid * 1024u;
    const int aoff = lds_byte(wr * 64 + fr, fq * 8), boff = lds_byte(wc * 32 + fr, fq * 8);
#define PG8_SA(b, h) (((b) * 2 + (h)) * HTB)
#define PG8_SB(b, h) ((4 + (b) * 2 + (h)) * HTB)
#define PG8_STAGE(bufoff, gbase, voff) do { _Pragma("unroll") for (int _i = 0; _i < 2; ++_i) \
        __builtin_amdgcn_global_load_lds((const unsigned*)((const char*)(gbase) + (voff)[_i]), (PG8_LAS unsigned*)(lds + (bufoff) + ldsw + _i * 8192), 16, 0, 0); } while (0)
#define PG8_LDA(dst, b, h) do { _Pragma("unroll") for (int m = 0; m < 4; ++m) _Pragma("unroll") for (int k = 0; k < 2; ++k) dst[m][k] = *(const PG8_LAS bf16x8*)(lds + PG8_SA(b, h) + aoff + m * 2048 + k * 1024); } while (0)
#define PG8_LDB(dst, b, h) do { _Pragma("unroll") for (int n = 0; n < 2; ++n) _Pragma("unroll") for (int k = 0; k < 2; ++k) dst[n][k] = *(const PG8_LAS bf16x8*)(lds + PG8_SB(b, h) + boff + n * 2048 + k * 1024); } while (0)
#define PG8_MMA(ai, bj, At, Bt) do { __builtin_amdgcn_s_setprio(1); _Pragma("unroll") for (int m = 0; m < 4; ++m) _Pragma("unroll") for (int n = 0; n < 2; ++n) _Pragma("unroll") for (int k = 0; k < 2; ++k) \
        acc[ai][bj][m][n] = __builtin_amdgcn_mfma_f32_16x16x32_bf16(Bt[n][k], At[m][k], acc[ai][bj][m][n], 0, 0, 0); __builtin_amdgcn_s_setprio(0); } while (0)
#define PG8_WAIT_V(n) asm volatile("s_waitcnt vmcnt(" #n ")" ::: "memory")
#define PG8_WAIT_L(n) asm volatile("s_waitcnt lgkmcnt(" #n ")" ::: "memory")
#define PG8_BAR __builtin_amdgcn_s_barrier()
#define PG8_SCHED __builtin_amdgcn_sched_barrier(0)
    Unit cur, nxt; int ui = 0;
    if (!S.next(0, cur)) return;
    f32x4 acc[2][2][4][2];
#pragma unroll
    for (int a = 0; a < 2; ++a)
#pragma unroll
        for (int b = 0; b < 2; ++b)
#pragma unroll
            for (int m = 0; m < 4; ++m)
#pragma unroll
                for (int n = 0; n < 2; ++n) acc[a][b][m][n] = (f32x4){0.f, 0.f, 0.f, 0.f};
    bf16x8 At[4][2], B0[2][2], B1[2][2];
    const char* cA = (const char*)g.A + (size_t)cur.pm * tstep; const char* cB = (const char*)g.Bt + (size_t)cur.pn * tstep;
    S.a_ready(cur);
    if constexpr (SP2) {
        PG8_STAGE(PG8_SB(0, 0), cB, voffB); PG8_STAGE(PG8_SB(0, 1), cB + hstep, voffB); PG8_STAGE(PG8_SA(0, 0), cA, voffA); PG8_STAGE(PG8_SA(0, 1), cA + hstep, voffA);
        if (wr == 1) PG8_BAR;
        PG8_WAIT_V(2); PG8_BAR;
        PG8_STAGE(PG8_SB(1, 0), cB + kstep, voffB); PG8_STAGE(PG8_SA(1, 0), cA + kstep, voffA); PG8_STAGE(PG8_SB(1, 1), cB + hstep + kstep, voffB);
        PG8_WAIT_V(6); PG8_BAR;
    } else {
        PG8_STAGE(PG8_SB(0, 0), cB, voffB); PG8_STAGE(PG8_SA(0, 0), cA, voffA); PG8_STAGE(PG8_SB(0, 1), cB + hstep, voffB); PG8_STAGE(PG8_SA(0, 1), cA + hstep, voffA);
        if (wr == 1) PG8_BAR;
        PG8_WAIT_V(4); PG8_BAR;
        PG8_STAGE(PG8_SB(1, 0), cB + kstep, voffB); PG8_STAGE(PG8_SA(1, 0), cA + kstep, voffA); PG8_STAGE(PG8_SB(1, 1), cB + hstep + kstep, voffB);
        PG8_WAIT_V(6); PG8_BAR;
    }
    for (;;) {
        const bool has_next = S.next(ui + 1, nxt);
        const char* nA = has_next ? (const char*)g.A + (size_t)nxt.pm * tstep : cA; const char* nB = has_next ? (const char*)g.Bt + (size_t)nxt.pn * tstep : cB;
        for (int t = 0; t < nt; t += 2) {
            const bool last = (t == nt - 2);
            const char* a1 = cA + (size_t)(t + 1) * kstep;
            const char* a2 = last ? nA : cA + (size_t)(t + 2) * kstep; const char* b2 = last ? nB : cB + (size_t)(t + 2) * kstep;
            const char* a3 = a2 + kstep; const char* b3 = b2 + kstep;
            if (last && has_next) S.a_ready(nxt);
            if constexpr (SP2) {
            PG8_LDB(B0, 0, 0); PG8_LDB(B1, 0, 1); PG8_SCHED; PG8_LDA(At, 0, 0); PG8_STAGE(PG8_SA(1, 1), a1 + hstep, voffA);
            PG8_WAIT_V(8); PG8_WAIT_L(0); PG8_BAR; PG8_MMA(0, 0, At, B0); PG8_MMA(0, 1, At, B1); PG8_BAR; PG8_SCHED;
            PG8_LDA(At, 0, 1); PG8_STAGE(PG8_SB(0, 0), b2, voffB); PG8_STAGE(PG8_SB(0, 1), b2 + hstep, voffB); PG8_STAGE(PG8_SA(0, 0), a2, voffA);
            PG8_WAIT_V(8); PG8_WAIT_L(0); PG8_BAR; PG8_MMA(1, 0, At, B0); PG8_MMA(1, 1, At, B1); PG8_BAR; PG8_SCHED;
            PG8_LDB(B0, 1, 0); PG8_LDB(B1, 1, 1); PG8_SCHED; PG8_LDA(At, 1, 0); PG8_STAGE(PG8_SA(0, 1), a2 + hstep, voffA);
            PG8_WAIT_V(8); PG8_WAIT_L(0); PG8_BAR; PG8_MMA(0, 0, At, B0); PG8_MMA(0, 1, At, B1); PG8_BAR; PG8_SCHED;
            PG8_LDA(At, 1, 1); PG8_STAGE(PG8_SB(1, 0), b3, voffB); PG8_STAGE(PG8_SB(1, 1), b3 + hstep, voffB); PG8_STAGE(PG8_SA(1, 0), a3, voffA);
            PG8_WAIT_V(8); PG8_WAIT_L(0); PG8_BAR; PG8_MMA(1, 0, At, B0); PG8_MMA(1, 1, At, B1); PG8_BAR; PG8_SCHED;
            } else {
            PG8_LDB(B0, 0, 0); PG8_SCHED; PG8_LDA(At, 0, 0); PG8_STAGE(PG8_SA(1, 1), a1 + hstep, voffA);
            PG8_WAIT_L(8); PG8_BAR; PG8_WAIT_L(0); PG8_MMA(0, 0, At, B0); PG8_BAR; PG8_SCHED;
            PG8_LDB(B1, 0, 1); PG8_STAGE(PG8_SB(0, 0), b2, voffB);
            PG8_BAR; PG8_WAIT_L(0); PG8_MMA(0, 1, At, B1); PG8_BAR;
            PG8_LDA(At, 0, 1); PG8_STAGE(PG8_SA(0, 0), a2, voffA);
            PG8_BAR; PG8_WAIT_L(0); PG8_MMA(1, 0, At, B0); PG8_BAR; PG8_SCHED;
            PG8_STAGE(PG8_SB(0, 1), b2 + hstep, voffB);
            PG8_WAIT_V(6); PG8_BAR; PG8_MMA(1, 1, At, B1); PG8_BAR;
            PG8_LDB(B0, 1, 0); PG8_SCHED; PG8_LDA(At, 1, 0); PG8_STAGE(PG8_SA(0, 1), a2 + hstep, voffA);
            PG8_WAIT_L(8); PG8_BAR; PG8_WAIT_L(0); PG8_MMA(0, 0, At, B0); PG8_BAR; PG8_SCHED;
            PG8_LDB(B1, 1, 1); PG8_STAGE(PG8_SB(1, 0), b3, voffB);
            PG8_BAR; PG8_WAIT_L(0); PG8_MMA(0, 1, At, B1); PG8_BAR;
            PG8_LDA(At, 1, 1); PG8_STAGE(PG8_SA(1, 0), a3, voffA);
            PG8_BAR; PG8_WAIT_L(0); PG8_MMA(1, 0, At, B0); PG8_BAR; PG8_SCHED;
            PG8_STAGE(PG8_SB(1, 1), b3 + hstep, voffB);
            PG8_WAIT_V(6); PG8_BAR; PG8_MMA(1, 1, At, B1); PG8_BAR;
            }
        }
        if constexpr (ALIGN_EPI) { if (wr == 0) PG8_BAR; }
        if constexpr (!Epi::AFTER_DRAIN) { E(acc, cur, wr, wc, fr, fq); S.done(cur); }
        if (!has_next) break;
#pragma unroll
        for (int a = 0; a < 2; ++a)
#pragma unroll
            for (int b = 0; b < 2; ++b)
#pragma unroll
                for (int m = 0; m < 4; ++m)
#pragma unroll
                    for (int n = 0; n < 2; ++n) acc[a][b][m][n] = (f32x4){0.f, 0.f, 0.f, 0.f};
        cur = nxt; cA = nA; cB = nB; ++ui;
        if constexpr (ALIGN_EPI) { if (wr == 1) PG8_BAR; }
    }
    PG8_WAIT_V(0);
    if constexpr (!ALIGN_EPI) { if (wr == 0) PG8_BAR; }
    PG8_BAR;
    if constexpr (Epi::AFTER_DRAIN) { E.fused(acc, cur, wr, wc, fr, fq, lds, wid, lane); S.done(cur); }
#undef PG8_SA
#undef PG8_SB
#undef PG8_STAGE
#undef PG8_LDA
#undef PG8_LDB
#undef PG8_MMA
#undef PG8_WAIT_V
#undef PG8_WAIT_L
#undef PG8_BAR
#undef PG8_SCHED
}
}
#define GAS __attribute__((address_space(1)))
#define LAS __attribute__((address_space(3)))
typedef unsigned short bf16;
typedef unsigned v4u __attribute__((ext_vector_type(4)));
typedef float f32x4 __attribute__((ext_vector_type(4)));
typedef short bf16x8 __attribute__((ext_vector_type(8)));
typedef GAS unsigned gu32;
typedef GAS unsigned long long gu64;
#define RLX_AGENT __ATOMIC_RELAXED, __HIP_MEMORY_SCOPE_AGENT
#define LDS_WAIT() asm volatile("s_waitcnt lgkmcnt(0)" ::: "memory")
#define VM_WAIT() asm volatile("s_waitcnt vmcnt(0)" ::: "memory")
__device__ __forceinline__ unsigned long long rt() { return __builtin_amdgcn_s_memrealtime(); }
__device__ __forceinline__ unsigned f2bf(float f) { unsigned u = __builtin_bit_cast(unsigned, f); return (u + 0x7fffu + ((u >> 16) & 1u)) >> 16; }
__device__ __forceinline__ unsigned pk2(float lo, float hi) { return f2bf(lo) | (f2bf(hi) << 16); }

#define XB_TMO      128
#define XB_XCNT(j)  (256  + 64 * (j))
#define XB_XSUB(j)  (1280 + 64 * (j))
#define XB_XGEN(j)  (2304 + 64 * (j))
#define XB_TOP      3328
#define XB_TOPGEN   3392
#define XCD_BAR_WORDS 3456
#define XB_SPIN_CAP (1u << 18)

__device__ __forceinline__ unsigned xb_ld(unsigned* p)              { return __hip_atomic_load(p, __ATOMIC_RELAXED, __HIP_MEMORY_SCOPE_AGENT); }
__device__ __forceinline__ unsigned xb_add(unsigned* p, unsigned v) { return __hip_atomic_fetch_add(p, v, __ATOMIC_RELAXED, __HIP_MEMORY_SCOPE_AGENT); }
__device__ __forceinline__ unsigned xb_xcc_id() { return (unsigned)__builtin_amdgcn_s_getreg((3 << 11) | 20) & 0xFu; }
#define XB_SPIN(cond, bar) do { unsigned _sp = 0; while (cond) { __builtin_amdgcn_s_sleep(1); \
    if ((++_sp & 255u) == 0u) { if (xb_ld(&(bar)[XB_TMO])) break; if (_sp > XB_SPIN_CAP) { atomicAdd(&(bar)[XB_TMO], 1u); break; } } } } while (0)

struct XcdBarrier {
    unsigned* bar; unsigned x;
    volatile LAS unsigned* st;
};

__device__ __forceinline__ XcdBarrier xcd_barrier_post(unsigned* bar, volatile LAS unsigned* st) {
    XcdBarrier b; b.bar = bar; b.x = xb_xcc_id(); b.st = st;
    if (threadIdx.x == 0) (void)xb_add(&bar[XB_XCNT(b.x)], 1u);
    return b;
}
__device__ __forceinline__ void xcd_barrier_complete(unsigned* bar, unsigned x, unsigned& nloc, unsigned& nx) {
    const unsigned G = gridDim.x * gridDim.y * gridDim.z;
    unsigned sum, cnt, mine, sp = 0u;
    for (;;) {
        sum = 0u; cnt = 0u; mine = 0u;
#pragma unroll
        for (unsigned j = 0; j < 16; ++j) { const unsigned c = xb_ld(&bar[XB_XCNT(j)]); sum += c; cnt += (c > 0u) ? 1u : 0u; mine = (j == x) ? c : mine; }
        if (sum == G) break;
        __builtin_amdgcn_s_sleep(1);
        if ((++sp & 255u) == 0u) { if (xb_ld(&bar[XB_TMO])) break; if (sp > XB_SPIN_CAP) { atomicAdd(&bar[XB_TMO], 1u); break; } }
    }
    nloc = mine > 0u ? mine : 1u; nx = cnt > 0u ? cnt : 1u;
}

__device__ __forceinline__ void xcd_barrier(const XcdBarrier& b) {
    asm volatile("s_waitcnt vmcnt(0)" ::: "memory");
    __syncthreads();
    if (threadIdx.x == 0) {
        unsigned* bar = b.bar; unsigned bx = b.x; asm volatile("" : "+s"(bar), "+s"(bx));
        __builtin_amdgcn_s_waitcnt(0);
        unsigned nloc = b.st[0], nx = b.st[1];
        if (nloc == 0u) { xcd_barrier_complete(bar, bx, nloc, nx); b.st[0] = nloc; b.st[1] = nx; }
        const unsigned old = xb_add(&bar[XB_XSUB(bx)], 1u);
        const unsigned gen = old / nloc;
        if (old + 1u == (gen + 1u) * nloc) {
            __builtin_amdgcn_fence(__ATOMIC_RELEASE, "agent");
            asm volatile("s_waitcnt vmcnt(0)" ::: "memory");
            const unsigned og = xb_add(&bar[XB_TOP], 1u);
            const unsigned tg = og / nx;
            if (og + 1u == (tg + 1u) * nx) xb_add(&bar[XB_TOPGEN], 1u);
            else XB_SPIN(xb_ld(&bar[XB_TOPGEN]) == tg, bar);
            __builtin_amdgcn_fence(__ATOMIC_ACQUIRE, "agent");
            xb_add(&bar[XB_XGEN(bx)], 1u);
            asm volatile("s_waitcnt vmcnt(0)" ::: "memory");
        } else {
            XB_SPIN(xb_ld(&bar[XB_XGEN(bx)]) == gen, bar);
            __builtin_amdgcn_fence(__ATOMIC_ACQUIRE, "agent");
            asm volatile("s_waitcnt vmcnt(0)" ::: "memory");
        }
    }
    __syncthreads();
}
constexpr int NWAVES = 8, NT = NWAVES * 64;
#ifndef MK_N_LAUNCHES
#define MK_N_LAUNCHES 15
#endif
constexpr int DM = 2048, NB = 4, SEQ = 2048, M = NB * SEQ, DEPTH = 2, INC = 5140, ZLD = 5120, ZN = 5376, DFF = 5632, GUN = 2 * DFF;
constexpr int Z_CB = 0, Z_CC = 512, Z_CH = 1024, Z_PU = 1536, Z_GQ = 2048, Z_GK = 2304, Z_GV = 2560, Z_GG = 3072, Z_FQ = 3584, Z_FK = 4096, Z_FV = 4608;
constexpr int Y_A = 0, Y_B = 512, Y_C = 1024, Y_D = 1536;
constexpr float EPS = 1e-6f, LOG2E = 1.4426950408889634f;
constexpr float QSCALE = 0.08838834764831845f * 1.4426950408889634f;
constexpr int NPHASE = 1 + 7 * DEPTH;
constexpr size_t MiB = 1u << 20;
constexpr size_t WS_CTL = 0, CTL_ZERO_BYTES = 1 * MiB;
constexpr size_t WS_WIN = 2 * MiB, WIN_BYTES = (size_t)ZN * DM * 2;
constexpr size_t WS_WOUT = 44 * MiB, WOUT_BYTES = (size_t)DM * DM * 2;
constexpr size_t WS_WGU = 60 * MiB, WGU_BYTES = (size_t)GUN * DM * 2;
constexpr size_t WS_WDN = 148 * MiB, WDN_BYTES = (size_t)DM * DFF * 2;
constexpr size_t WS_XB = 192 * MiB, WS_SSP = 224 * MiB, WS_ZS = 225 * MiB, WS_FB = 226 * MiB, WS_ELAST = 227 * MiB;
constexpr size_t WS_QN = 228 * MiB, WS_KN = 236 * MiB, WS_VT = 244 * MiB, WS_LOC = 252 * MiB, WS_SST = 268 * MiB;
constexpr size_t WS_Z = 284 * MiB, WS_Y = 364 * MiB, WS_H = 284 * MiB, WS_END = 396 * MiB;
static_assert(WS_WIN + 2 * WIN_BYTES <= WS_WOUT && WS_WOUT + 2 * WOUT_BYTES <= WS_WGU && WS_WGU + 2 * WGU_BYTES <= WS_WDN && WS_WDN + 2 * WDN_BYTES <= WS_XB, "weight map");
static_assert(WS_Z + (size_t)M * ZLD * 2 <= WS_Y && WS_Y + (size_t)M * DM * 2 <= WS_END && WS_H + (size_t)M * DFF * 2 <= WS_END, "activation map");
constexpr int CW_BAR = 4096;
constexpr int MISC_OFF = 0, SCR_OFF = 1024, LDS_BYTES = 147456;

struct Args { const float* in[17]; float* out; unsigned char* ws; int ph_lo, ph_hi; };
typedef const __attribute__((address_space(4))) Args* KArgs;
struct Ctx {
    KArgs ka; LAS unsigned char* scr; int tid, lane, wave, G, bid;
    __device__ __forceinline__ KArgs k() const { KArgs p = ka; asm volatile("" : "+s"(p)); return p; }
    __device__ __forceinline__ const float* inp(int i) const { return k()->in[i]; }
    __device__ __forceinline__ unsigned char* wsp() const { return k()->ws; }
    __device__ __forceinline__ float* outp() const { return k()->out; }
};
__device__ __forceinline__ float bf2f(unsigned h) { return __uint_as_float(h << 16); }
__device__ __forceinline__ void unpack8(const v4u w, float (&f)[8]) {
    f[0] = __uint_as_float(w.x << 16); f[1] = __uint_as_float(w.x & 0xffff0000u); f[2] = __uint_as_float(w.y << 16); f[3] = __uint_as_float(w.y & 0xffff0000u);
    f[4] = __uint_as_float(w.z << 16); f[5] = __uint_as_float(w.z & 0xffff0000u); f[6] = __uint_as_float(w.w << 16); f[7] = __uint_as_float(w.w & 0xffff0000u);
}
__device__ __forceinline__ v4u pack8(const float (&f)[8]) { v4u w; w.x = pk2(f[0], f[1]); w.y = pk2(f[2], f[3]); w.z = pk2(f[4], f[5]); w.w = pk2(f[6], f[7]); return w; }
__device__ __forceinline__ float log_sigmoid(float x) { return fminf(x, 0.f) - log1pf(expf(-fabsf(x))); }
__device__ __forceinline__ float silu(float g) { return g / (1.0f + expf(-g)); }

__device__ __forceinline__ void tr_item(const float* W, int N, int K, int k0, int ns0, bf16* WT, int nd0, const float* gain, LAS float* scr, int lane) {
#pragma unroll 4
    for (int i = 0; i < 16; ++i) { const int kk = i * 4 + (lane >> 4), c = (lane & 15) * 4;
        f32x4 v = *(const GAS f32x4*)(W + (size_t)(k0 + kk) * N + ns0 + c); const float g = gain ? gain[k0 + kk] : 1.0f;
        LAS float* s = scr + kk * 65 + c; s[0] = v.x * g; s[1] = v.y * g; s[2] = v.z * g; s[3] = v.w * g; }
    LDS_WAIT(); asm volatile("" ::: "memory");
    const int c = lane & 7;
#pragma unroll
    for (int j = 0; j < 8; ++j) { const int n = j * 8 + (lane >> 3); const LAS float* s = scr + (8 * c) * 65 + n;
        v4u o; o.x = pk2(s[0 * 65], s[1 * 65]); o.y = pk2(s[2 * 65], s[3 * 65]); o.z = pk2(s[4 * 65], s[5 * 65]); o.w = pk2(s[6 * 65], s[7 * 65]);
        *(GAS v4u*)(WT + (size_t)(nd0 + n) * K + k0 + 8 * c) = o; }
    LDS_WAIT(); asm volatile("" ::: "memory");
}
__device__ __forceinline__ void tr_item_tail(const float* W, int k0, bf16* WT, int nd0, const float* gain, int lane) {
    const int nd = nd0 + lane; const int src = nd < 5136 ? 3584 + (nd - 5120) : (nd < 5140 ? nd : -1);
#pragma unroll 1
    for (int c = 0; c < 8; ++c) { float f[8];
#pragma unroll
        for (int q = 0; q < 8; ++q) { const int k = k0 + 8 * c + q; f[q] = src >= 0 ? W[(size_t)k * INC + src] * gain[k] : 0.f; }
        *(GAS v4u*)(WT + (size_t)nd * DM + k0 + 8 * c) = pack8(f); }
}
__device__ __forceinline__ void pool_fold_item(const float* W, const float* pw, const float* psc, const float* gain, bf16* WT, int gi, int k0, LAS float* scr, int lane) {
#pragma unroll
    for (int i = 0; i < 8; ++i) { const int idx = i * 64 + lane, kk = idx >> 5, c4 = (idx & 31) * 4;
        const f32x4 v = *(const GAS f32x4*)(W + (size_t)(k0 + kk) * INC + Z_PU + gi * 128 + c4); *(LAS f32x4*)(scr + kk * 128 + c4) = v; }
    LDS_WAIT(); asm volatile("" ::: "memory");
    float a0[16], a1[16];
#pragma unroll
    for (int kk = 0; kk < 16; ++kk) { a0[kk] = 0.f; a1[kk] = 0.f; }
    const float* pwg = pw + (size_t)gi * 128 * 128 + 2 * lane;
#pragma unroll 4
    for (int c = 0; c < 128; ++c) { const float p0 = pwg[c * 128], p1 = pwg[c * 128 + 1];
#pragma unroll
        for (int kk = 0; kk < 16; ++kk) { const float w = scr[kk * 128 + c]; a0[kk] += w * p0; a1[kk] += w * p1; } }
    const float s0 = psc[gi * 128 + 2 * lane], s1 = psc[gi * 128 + 2 * lane + 1];
    float f[8];
#pragma unroll
    for (int hh = 0; hh < 2; ++hh) {
#pragma unroll
        for (int q = 0; q < 8; ++q) f[q] = a0[hh * 8 + q] * s0 * gain[k0 + hh * 8 + q];
        *(GAS v4u*)(WT + (size_t)(Z_PU + gi * 128 + 2 * lane) * DM + k0 + hh * 8) = pack8(f);
#pragma unroll
        for (int q = 0; q < 8; ++q) f[q] = a1[hh * 8 + q] * s1 * gain[k0 + hh * 8 + q];
        *(GAS v4u*)(WT + (size_t)(Z_PU + gi * 128 + 2 * lane + 1) * DM + k0 + hh * 8) = pack8(f);
    }
    LDS_WAIT(); asm volatile("" ::: "memory");
}
__device__ __forceinline__ float wave_sum(float v) {
#pragma unroll
    for (int o = 1; o < 64; o <<= 1) v += __shfl_xor(v, o);
    return v;
}
__device__ __forceinline__ void p0_prologue(Ctx& C) {
    LAS float* scr = (LAS float*)(C.scr + C.wave * 16896);
    const int gw = C.bid * NWAVES + C.wave, NGW = C.G * NWAVES;
    constexpr int I_IN = 80 * 32, I_TAIL = 4 * 32, I_POOL = 4 * 128, I_OUT = 32 * 32, I_GU = 176 * 32, I_DN = 32 * 88;
    constexpr int PER_LAYER = I_IN + I_TAIL + I_POOL + I_OUT + I_GU + I_DN;
    for (int it = gw; it < DEPTH * PER_LAYER; it += NGW) {
        const int l = it / PER_LAYER; int r = it % PER_LAYER;
        const float* g_mix = C.inp(1) + l * DM; const float* g_ffn = C.inp(13) + l * DM;
        const float* w_in = C.inp(2) + (size_t)l * DM * INC;
        bf16* win_t = (bf16*)(C.wsp() + WS_WIN + l * WIN_BYTES);
        if (r < I_IN) { const int nb = r / 32, kb = r % 32; const int nd0 = nb * 64;
            if (nd0 >= Z_PU && nd0 < Z_GQ) continue;
            const int ns0 = nd0 < 3584 ? nd0 : nd0 + 16;
            tr_item(w_in, INC, DM, kb * 64, ns0, win_t, nd0, g_mix, scr, C.lane); continue; }
        r -= I_IN;
        if (r < I_TAIL) { const int nb = r / 32, kb = r % 32; tr_item_tail(w_in, kb * 64, win_t, 5120 + nb * 64, g_mix, C.lane); continue; }
        r -= I_TAIL;
        if (r < I_POOL) { const int gi = r / 128, kb = r % 128;
            pool_fold_item(w_in, C.inp(4) + (size_t)l * 4 * 128 * 128, C.inp(5) + l * 512, g_mix, win_t, gi, kb * 16, scr, C.lane); continue; }
        r -= I_POOL;
        if (r < I_OUT) { const int nb = r / 32, kb = r % 32;
            tr_item(C.inp(12) + (size_t)l * DM * DM, DM, DM, kb * 64, nb * 64, (bf16*)(C.wsp() + WS_WOUT + l * WOUT_BYTES), nb * 64, nullptr, scr, C.lane); continue; }
        r -= I_OUT;
        if (r < I_GU) { const int nb = r / 32, kb = r % 32; const int nd0 = nb * 64, t = nd0 >> 8, j = nd0 & 255;
            const float* src = (j < 128 ? C.inp(14) : C.inp(15)) + (size_t)l * DM * DFF;
            tr_item(src, DFF, DM, kb * 64, t * 128 + (j & 127), (bf16*)(C.wsp() + WS_WGU + l * WGU_BYTES), nd0, g_ffn, scr, C.lane); continue; }
        r -= I_GU;
        { const int nb = r / 88, kb = r % 88;
            tr_item(C.inp(16) + (size_t)l * DFF * DM, DM, DFF, kb * 64, nb * 64, (bf16*)(C.wsp() + WS_WDN + l * WDN_BYTES), nb * 64, nullptr, scr, C.lane); }
    }
    bf16* XB = (bf16*)(C.wsp() + WS_XB); float* SSP = (float*)(C.wsp() + WS_SSP);
    for (int m = gw; m < M; m += NGW) {
        const GAS f32x4* xr = (const GAS f32x4*)(C.inp(0) + (size_t)m * DM) + C.lane; float s = 0.f;
        GAS unsigned long long* o8 = (GAS unsigned long long*)(XB + (size_t)m * DM) + C.lane;
#pragma unroll
        for (int j = 0; j < 8; ++j) { const f32x4 v = xr[64 * j]; s += (v.x * v.x + v.y * v.y) + (v.z * v.z + v.w * v.w);
            o8[64 * j] = (unsigned long long)pk2(v.x, v.y) | ((unsigned long long)pk2(v.z, v.w) << 32); }
        s = wave_sum(s);
        if (C.lane < 8) SSP[(size_t)m * 8 + C.lane] = C.lane == 0 ? s : 0.f;
    }
}

__device__ __forceinline__ void conv_item(Ctx& C, int l, int item) {
    const bf16* Z = (const bf16*)(C.wsp() + WS_Z); bf16* Y = (bf16*)(C.wsp() + WS_Y); const float* cw = C.inp(3) + l * 1536;
    const int c0 = C.lane * 8; float w0[8], w1[8], w2[8];
#pragma unroll
    for (int i = 0; i < 8; ++i) { w0[i] = cw[c0 + i]; w1[i] = cw[512 + c0 + i]; w2[i] = cw[1024 + c0 + i]; }
    for (int i = 0; i < 8; ++i) { const int t = item * 64 + i * 8 + C.wave, s = t & (SEQ - 1);
        float acc[8], a[8], b[8];
#pragma unroll
        for (int q = 0; q < 8; ++q) acc[q] = 0.f;
#pragma unroll
        for (int d = 0; d < 3; ++d) { if (s - d < 0) continue; const bf16* zr = Z + (size_t)(t - d) * ZLD + c0;
            unpack8(*(const GAS v4u*)(zr + Z_CC), a); unpack8(*(const GAS v4u*)(zr + Z_CH), b);
#pragma unroll
            for (int q = 0; q < 8; ++q) acc[q] += (d == 0 ? w2[q] : d == 1 ? w1[q] : w0[q]) * (a[q] * b[q]); }
        unpack8(*(const GAS v4u*)(Z + (size_t)t * ZLD + Z_CB + c0), a);
#pragma unroll
        for (int q = 0; q < 8; ++q) acc[q] *= a[q];
        *(GAS v4u*)(Y + (size_t)t * DM + Y_A + c0) = pack8(acc); }
}
__device__ __forceinline__ void pool_item(Ctx& C, int item) {
    const bf16* Z = (const bf16*)(C.wsp() + WS_Z); bf16* Y = (bf16*)(C.wsp() + WS_Y);
    const int c0 = C.lane * 8, win = 2 << (c0 >> 7);
    for (int i = 0; i < 8; ++i) { const int t = item * 64 + i * 8 + C.wave, s = t & (SEQ - 1); const int cnt = (s + 1) < win ? (s + 1) : win;
        float acc[8], a[8], p0[8];
#pragma unroll
        for (int q = 0; q < 8; ++q) acc[q] = 0.f;
        unpack8(*(const GAS v4u*)(Z + (size_t)t * ZLD + Z_PU + c0), p0);
        for (int d = 0; d < 16; ++d) { if (d < cnt) { unpack8(*(const GAS v4u*)(Z + (size_t)(t - d) * ZLD + Z_PU + c0), a);
#pragma unroll
            for (int q = 0; q < 8; ++q) acc[q] += a[q]; } }
        const float inv = 1.0f / (float)cnt;
#pragma unroll
        for (int q = 0; q < 8; ++q) acc[q] = acc[q] * inv - p0[q];
        *(GAS v4u*)(Y + (size_t)t * DM + Y_B + c0) = pack8(acc); }
}
__device__ __forceinline__ void foxprep_item(Ctx& C, int l, int item) {
    const bf16* Z = (const bf16*)(C.wsp() + WS_Z); bf16* QN = (bf16*)(C.wsp() + WS_QN); bf16* KN = (bf16*)(C.wsp() + WS_KN);
    const int d0 = (C.lane & 15) * 8; float gq[8], gk[8];
#pragma unroll
    for (int q = 0; q < 8; ++q) { gq[q] = C.inp(9)[l * 128 + d0 + q] * QSCALE; gk[q] = C.inp(10)[l * 128 + d0 + q]; }
    for (int i = 0; i < 8; ++i) { const int t = item * 64 + i * 8 + C.wave; float a[8];
#pragma unroll
        for (int which = 0; which < 2; ++which) {
            unpack8(*(const GAS v4u*)(Z + (size_t)t * ZLD + (which ? Z_FK : Z_FQ) + C.lane * 8), a);
            float ss = 0.f;
#pragma unroll
            for (int q = 0; q < 8; ++q) ss += a[q] * a[q];
            ss += __shfl_xor(ss, 1); ss += __shfl_xor(ss, 2); ss += __shfl_xor(ss, 4); ss += __shfl_xor(ss, 8);
            const float rstd = 1.0f / sqrtf(ss * (1.0f / 128.0f) + EPS);
#pragma unroll
            for (int q = 0; q < 8; ++q) a[q] = a[q] * rstd * (which ? gk[q] : gq[q]);
            *(GAS v4u*)((which ? KN : QN) + (size_t)t * 512 + C.lane * 8) = pack8(a); } }
}
__device__ __forceinline__ void fscan_item(Ctx& C, int l, int item) {
    if (C.wave != 0) return;
    const float* ZS = (const float*)(C.wsp() + WS_ZS); float* FB = (float*)(C.wsp() + WS_FB);
    const int b = item >> 2, h = item & 3; const float bf = C.inp(11)[l * 4 + h];
    float v[32]; float run = 0.f; const int s0 = C.lane * 32;
#pragma unroll
    for (int j = 0; j < 32; ++j) { const float x = ZS[(size_t)(b * SEQ + s0 + j) * 32 + 16 + h] + bf; run += log_sigmoid(x); v[j] = run; }
    float inc = run;
#pragma unroll
    for (int o = 1; o < 64; o <<= 1) { const float nb = __shfl_up(inc, o); if (C.lane >= o) inc += nb; }
    const float excl = inc - run;
#pragma unroll
    for (int j = 0; j < 32; ++j) FB[(size_t)item * SEQ + s0 + j] = -(v[j] + excl) * LOG2E;
}
__device__ __forceinline__ void gla_cc(Ctx& C, int l, int b, int n, int h, LAS float* cc, LAS float* tmp) {
    const float* ZS = (const float*)(C.wsp() + WS_ZS); const int t0 = b * SEQ + n * 64;
    LAS float* ga = tmp; LAS float* wd = tmp + 1024; LAS float* bd = tmp + 2048;
    for (int i = C.tid; i < 1024; i += NT) { ga[i] = ZS[(size_t)(t0 + (i >> 4)) * 32 + (i & 15)]; wd[i] = C.inp(6)[l * 4096 + (i >> 6) * 256 + h * 64 + (i & 63)]; }
    if (C.tid < 64) bd[C.tid] = C.inp(7)[l * 256 + h * 64 + C.tid];
    __syncthreads();
#pragma unroll
    for (int i = 0; i < 8; ++i) { const int p = C.tid + NT * i, t = p >> 6, k = p & 63; float x = bd[k];
#pragma unroll
        for (int r = 0; r < 16; ++r) x += ga[t * 16 + r] * wd[r * 64 + k];
        cc[t * 65 + k] = log_sigmoid(x) * (1.0f / 16.0f); }
    __syncthreads();
    if (C.tid < 64) { float run = 0.f;
        for (int t = 0; t < 64; ++t) { run += cc[t * 65 + C.tid]; cc[t * 65 + C.tid] = run; } }
    __syncthreads();
}
__device__ __forceinline__ void gla1_item(Ctx& C, int l, int unit) {
    const bf16* Z = (const bf16*)(C.wsp() + WS_Z); float* LOC = (float*)(C.wsp() + WS_LOC); float* EL = (float*)(C.wsp() + WS_ELAST);
    const int h = unit & 3, n = (unit >> 2) & 31, b = unit >> 7, t0 = b * SEQ + n * 64;
    LAS float* cc = (LAS float*)C.scr; LAS float* kd = cc + 64 * 65; LAS float* vv = kd + 64 * 65; LAS float* tmp = vv + 64 * 128;
    gla_cc(C, l, b, n, h, cc, tmp);
#pragma unroll
    for (int i = 0; i < 8; ++i) { const int p = C.tid + NT * i, t = p >> 6, k = p & 63;
        kd[t * 65 + k] = bf2f(Z[(size_t)(t0 + t) * ZLD + Z_GK + h * 64 + k]) * expf(cc[63 * 65 + k] - cc[t * 65 + k]); }
#pragma unroll
    for (int i = 0; i < 16; ++i) { const int p = C.tid + NT * i, t = p >> 7, v = p & 127; vv[t * 128 + v] = bf2f(Z[(size_t)(t0 + t) * ZLD + Z_GV + h * 128 + v]); }
    if (C.tid < 64) EL[unit * 64 + C.tid] = expf(cc[63 * 65 + C.tid]);
    __syncthreads();
    const int k = C.tid >> 3, v0 = (C.tid & 7) * 16; float acc[16];
#pragma unroll
    for (int j = 0; j < 16; ++j) acc[j] = 0.f;
    for (int t = 0; t < 64; ++t) { const float kk = kd[t * 65 + k];
#pragma unroll
        for (int j4 = 0; j4 < 4; ++j4) { const f32x4 vq = *(const LAS f32x4*)(vv + t * 128 + v0 + 4 * j4);
            acc[4 * j4 + 0] += kk * vq.x; acc[4 * j4 + 1] += kk * vq.y; acc[4 * j4 + 2] += kk * vq.z; acc[4 * j4 + 3] += kk * vq.w; } }
    float* o = LOC + ((size_t)unit * 64 + k) * 128 + v0;
#pragma unroll
    for (int j4 = 0; j4 < 4; ++j4) *(GAS f32x4*)(o + 4 * j4) = (f32x4){acc[4 * j4], acc[4 * j4 + 1], acc[4 * j4 + 2], acc[4 * j4 + 3]};
    __syncthreads();
}
__device__ __forceinline__ void gla_scan_item(Ctx& C, int item) {
    const float* LOC = (const float*)(C.wsp() + WS_LOC); const float* EL = (const float*)(C.wsp() + WS_ELAST); float* SST = (float*)(C.wsp() + WS_SST);
    const int c = item * NT + C.tid, bh = c >> 13, kv = c & 8191, k = kv >> 7, b = bh >> 2, h = bh & 3;
    float st = 0.f;
#pragma unroll 8
    for (int n = 0; n < 32; ++n) { const int unit = (b * 32 + n) * 4 + h; const size_t idx = (size_t)unit * 8192 + kv;
        SST[idx] = st; st = st * EL[unit * 64 + k] + LOC[idx]; }
}
__device__ __forceinline__ void fox_unit(Ctx& C, int b, int h, int j) {
    const bf16* Z = (const bf16*)(C.wsp() + WS_Z); const bf16* QN = (const bf16*)(C.wsp() + WS_QN); const bf16* KN = (const bf16*)(C.wsp() + WS_KN);
    const float* FB = (const float*)(C.wsp() + WS_FB) + (size_t)(b * 4 + h) * SEQ; bf16* Y = (bf16*)(C.wsp() + WS_Y);
    LAS float* qf = (LAS float*)C.scr; LAS float* kf = qf + 64 * 132; LAS float* vf = kf + 64 * 132; LAS float* P = vf + 64 * 128;
    const int tq0 = b * SEQ + j * 64;
#pragma unroll
    for (int i = 0; i < 2; ++i) { const int ch = C.tid + NT * i, r = ch >> 4, d8 = (ch & 15) * 8; float a[8];
        unpack8(*(const GAS v4u*)(QN + (size_t)(tq0 + r) * 512 + h * 128 + d8), a);
        *(LAS f32x4*)(qf + r * 132 + d8) = (f32x4){a[0], a[1], a[2], a[3]}; *(LAS f32x4*)(qf + r * 132 + d8 + 4) = (f32x4){a[4], a[5], a[6], a[7]}; }
    const int qr = C.tid >> 3, v0 = (C.tid & 7) * 16, s8 = C.tid & 7;
    const int qa = C.tid >> 4, ka = C.tid & 15;
    float mrow = -1e30f, lrow = 0.f, o[16];
#pragma unroll
    for (int q = 0; q < 16; ++q) o[q] = 0.f;
    for (int kt = 0; kt <= j; ++kt) {
        const int tk0 = b * SEQ + kt * 64;
        __syncthreads();
#pragma unroll
        for (int i = 0; i < 2; ++i) { const int ch = C.tid + NT * i, r = ch >> 4, d8 = (ch & 15) * 8; float a[8];
            unpack8(*(const GAS v4u*)(KN + (size_t)(tk0 + r) * 512 + h * 128 + d8), a);
            *(LAS f32x4*)(kf + r * 132 + d8) = (f32x4){a[0], a[1], a[2], a[3]}; *(LAS f32x4*)(kf + r * 132 + d8 + 4) = (f32x4){a[4], a[5], a[6], a[7]};
            unpack8(*(const GAS v4u*)(Z + (size_t)(tk0 + r) * ZLD + Z_FV + h * 128 + d8), a);
            *(LAS f32x4*)(vf + r * 128 + d8) = (f32x4){a[0], a[1], a[2], a[3]}; *(LAS f32x4*)(vf + r * 128 + d8 + 4) = (f32x4){a[4], a[5], a[6], a[7]}; }
        __syncthreads();
        float sacc[2][4];
#pragma unroll
        for (int a = 0; a < 2; ++a)
#pragma unroll
            for (int i = 0; i < 4; ++i) sacc[a][i] = 0.f;
#pragma unroll 4
        for (int d4 = 0; d4 < 32; ++d4) { const f32x4 q0 = *(const LAS f32x4*)(qf + qa * 132 + 4 * d4), q1 = *(const LAS f32x4*)(qf + (qa + 32) * 132 + 4 * d4);
#pragma unroll
            for (int i = 0; i < 4; ++i) { const f32x4 kq = *(const LAS f32x4*)(kf + (ka + 16 * i) * 132 + 4 * d4);
                sacc[0][i] += (q0.x * kq.x + q0.y * kq.y) + (q0.z * kq.z + q0.w * kq.w); sacc[1][i] += (q1.x * kq.x + q1.y * kq.y) + (q1.z * kq.z + q1.w * kq.w); } }
#pragma unroll
        for (int i = 0; i < 4; ++i) { P[qa * 65 + ka + 16 * i] = sacc[0][i]; P[(qa + 32) * 65 + ka + 16 * i] = sacc[1][i]; }
        __syncthreads();
        float x[8]; float mx = -1e30f;
#pragma unroll
        for (int i = 0; i < 8; ++i) { const int s = s8 + 8 * i; x[i] = P[qr * 65 + s] + FB[kt * 64 + s]; if (kt == j && s > qr) x[i] = -1e30f; mx = fmaxf(mx, x[i]); }
        mx = fmaxf(mx, __shfl_xor(mx, 1)); mx = fmaxf(mx, __shfl_xor(mx, 2)); mx = fmaxf(mx, __shfl_xor(mx, 4));
        const float mnew = fmaxf(mrow, mx), f = exp2f(mrow - mnew); float rsum = 0.f;
#pragma unroll
        for (int i = 0; i < 8; ++i) { const float p = exp2f(x[i] - mnew); rsum += p; P[qr * 65 + s8 + 8 * i] = p; }
        rsum += __shfl_xor(rsum, 1); rsum += __shfl_xor(rsum, 2); rsum += __shfl_xor(rsum, 4);
        lrow = lrow * f + rsum; mrow = mnew;
#pragma unroll
        for (int q = 0; q < 16; ++q) o[q] *= f;
        __syncthreads();
        for (int s = 0; s < 64; ++s) { const float p = P[qr * 65 + s];
#pragma unroll
            for (int j4 = 0; j4 < 4; ++j4) { const f32x4 vq = *(const LAS f32x4*)(vf + s * 128 + v0 + 4 * j4);
                o[4 * j4 + 0] += p * vq.x; o[4 * j4 + 1] += p * vq.y; o[4 * j4 + 2] += p * vq.z; o[4 * j4 + 3] += p * vq.w; } }
    }
    const float inv = 1.0f / lrow; float f8[8];
    bf16* yo = Y + (size_t)(tq0 + qr) * DM + Y_D + h * 128 + v0;
#pragma unroll
    for (int hh = 0; hh < 2; ++hh) {
#pragma unroll
        for (int q = 0; q < 8; ++q) f8[q] = o[hh * 8 + q] * inv;
        *(GAS v4u*)(yo + hh * 8) = pack8(f8); }
    __syncthreads();
}
__device__ __forceinline__ void gla3_item(Ctx& C, int l, int unit) {
    const bf16* Z = (const bf16*)(C.wsp() + WS_Z); const float* SST = (const float*)(C.wsp() + WS_SST); bf16* Y = (bf16*)(C.wsp() + WS_Y);
    const int h = unit & 3, n = (unit >> 2) & 31, b = unit >> 7, t0 = b * SEQ + n * 64;
    LAS float* cc = (LAS float*)C.scr; LAS float* qs = cc + 64 * 65; LAS float* kk = qs + 64 * 65; LAS float* sc = kk + 64 * 65; LAS float* vv = sc + 64 * 65; LAS float* st = vv + 64 * 128;
    gla_cc(C, l, b, n, h, cc, sc);
#pragma unroll
    for (int i = 0; i < 8; ++i) { const int p = C.tid + NT * i, t = p >> 6, k = p & 63; const bf16* zr = Z + (size_t)(t0 + t) * ZLD + h * 64 + k;
        qs[t * 65 + k] = bf2f(zr[Z_GQ]) * 0.125f; kk[t * 65 + k] = bf2f(zr[Z_GK]); }
#pragma unroll
    for (int i = 0; i < 16; ++i) { const int p = C.tid + NT * i, t = p >> 7, v = p & 127; vv[t * 128 + v] = bf2f(Z[(size_t)(t0 + t) * ZLD + Z_GV + h * 128 + v]); st[p] = SST[(size_t)unit * 8192 + p]; }
    __syncthreads();
    const int t = C.tid >> 3, s8 = C.tid & 7, v0 = s8 * 16;
    { float a[8];
#pragma unroll
        for (int i = 0; i < 8; ++i) a[i] = 0.f;
        for (int k = 0; k < 64; ++k) { const float qv = qs[t * 65 + k], ct = cc[t * 65 + k];
#pragma unroll
            for (int i = 0; i < 8; ++i) { const int s = s8 + 8 * i; a[i] += qv * kk[s * 65 + k] * exp2f(-LOG2E * fabsf(ct - cc[s * 65 + k])); } }
        __syncthreads();
#pragma unroll
        for (int i = 0; i < 8; ++i) sc[t * 65 + s8 + 8 * i] = a[i]; }
    __syncthreads();
#pragma unroll
    for (int i = 0; i < 8; ++i) { const int p = C.tid + NT * i, tt = p >> 6, k = p & 63; qs[tt * 65 + k] *= expf(cc[tt * 65 + k]); }
    __syncthreads();
    float o[16];
#pragma unroll
    for (int q = 0; q < 16; ++q) o[q] = 0.f;
    for (int s = 0; s < 64; ++s) { const float p = sc[t * 65 + s];
#pragma unroll
        for (int j4 = 0; j4 < 4; ++j4) { const f32x4 vq = *(const LAS f32x4*)(vv + s * 128 + v0 + 4 * j4);
            o[4 * j4 + 0] += p * vq.x; o[4 * j4 + 1] += p * vq.y; o[4 * j4 + 2] += p * vq.z; o[4 * j4 + 3] += p * vq.w; } }
    for (int k = 0; k < 64; ++k) { const float p = qs[t * 65 + k];
#pragma unroll
        for (int j4 = 0; j4 < 4; ++j4) { const f32x4 vq = *(const LAS f32x4*)(st + k * 128 + v0 + 4 * j4);
            o[4 * j4 + 0] += p * vq.x; o[4 * j4 + 1] += p * vq.y; o[4 * j4 + 2] += p * vq.z; o[4 * j4 + 3] += p * vq.w; } }
    float ss = 0.f;
#pragma unroll
    for (int q = 0; q < 16; ++q) ss += o[q] * o[q];
    ss += __shfl_xor(ss, 1); ss += __shfl_xor(ss, 2); ss += __shfl_xor(ss, 4);
    const float rstd = 1.0f / sqrtf(ss * (1.0f / 128.0f) + EPS);
    const bf16* gr = Z + (size_t)(t0 + t) * ZLD + Z_GG + h * 128 + v0; bf16* yo = Y + (size_t)(t0 + t) * DM + Y_C + h * 128 + v0; const float* og = C.inp(8) + l * 128 + v0;
#pragma unroll
    for (int hh = 0; hh < 2; ++hh) { float g[8], f8[8]; unpack8(*(const GAS v4u*)(gr + hh * 8), g);
#pragma unroll
        for (int q = 0; q < 8; ++q) f8[q] = o[hh * 8 + q] * rstd * og[hh * 8 + q] * silu(g[q]);
        *(GAS v4u*)(yo + hh * 8) = pack8(f8); }
    __syncthreads();
}
__device__ __forceinline__ Ctx mk_ctx(LAS unsigned char* ldsbase) {
    Ctx C; KArgs ka = (KArgs)__builtin_amdgcn_kernarg_segment_ptr(); asm volatile("" : "+s"(ka)); C.ka = ka;
    int tid = threadIdx.x; asm volatile("" : "+v"(tid)); int G = gridDim.x, bid = blockIdx.x; asm volatile("" : "+s"(G), "+s"(bid));
    C.scr = ldsbase + SCR_OFF; C.tid = tid; C.lane = tid & 63; C.wave = __builtin_amdgcn_readfirstlane(tid >> 6); C.G = G; C.bid = bid; return C;
}
__global__ void __launch_bounds__(NT, 2) trunk_fwd(Args args_unused) {
    extern __shared__ __attribute__((aligned(16))) unsigned char lds[];
    volatile LAS unsigned* MISC = (volatile LAS unsigned*)((LAS unsigned char*)lds + MISC_OFF);
    for (int u = threadIdx.x; u < SCR_OFF / 4; u += NT) MISC[u] = 0u;
    __syncthreads();
    int ph_lo, ph_hi; XcdBarrier bar;
    { Ctx C = mk_ctx((LAS unsigned char*)lds); ph_lo = C.k()->ph_lo; ph_hi = C.k()->ph_hi;
      bar.bar = (unsigned*)((gu32*)(C.wsp() + WS_CTL) + CW_BAR); bar.x = 0; bar.st = nullptr;
      if (ph_hi - ph_lo > 1) bar = xcd_barrier_post((unsigned*)((gu32*)(C.wsp() + WS_CTL) + CW_BAR), MISC + 8); }
    PG8_LAS unsigned char* ring = (PG8_LAS unsigned char*)lds + SCR_OFF;

    for (int ph = ph_lo; ph < ph_hi; ++ph) {
        int l = (ph - 1) / 7, sub = ph == 0 ? -1 : (ph - 1) % 7; asm volatile("" : "+s"(l), "+s"(sub));
        Ctx C = mk_ctx((LAS unsigned char*)lds);
        if (sub < 0) {
            p0_prologue(C);
        } else if (sub == 0) {
            unsigned char* ws = C.wsp();
            pg8::Gemm g{(const bf16*)(ws + WS_XB), (const bf16*)(ws + WS_WIN + l * WIN_BYTES), M, ZN, DM}; pg8::StaticOrder S; S.init(M, ZN, C.G, C.bid);
            pg8::EpiZ E{(bf16*)(ws + WS_Z), (float*)(ws + WS_ZS), (const float*)(ws + WS_SSP)};
            pg8::gemm_phase<pg8::EpiZ, pg8::StaticOrder, true, true>(ring, g, S, E);
        } else if (sub == 1) {
            for (int it = C.bid; it < 912; it += C.G) {
                if (it < 512) gla1_item(C, l, it);
                else if (it < 640) conv_item(C, l, it - 512);
                else if (it < 768) pool_item(C, it - 640);
                else if (it < 896) foxprep_item(C, l, it - 768);
                else fscan_item(C, l, it - 896);
            }
        } else if (sub == 2) {
            for (int it = C.bid; it < 512; it += C.G) {
                if (it < 256) { const int bh = it >> 4, jj = it & 15; fox_unit(C, bh >> 2, bh & 3, 31 - jj); fox_unit(C, bh >> 2, bh & 3, jj); }
                else gla_scan_item(C, it - 256);
            }
        } else if (sub == 3) {
            for (int it = C.bid; it < 512; it += C.G) gla3_item(C, l, it);
        } else if (sub == 5) {
            unsigned char* ws = C.wsp();
            pg8::Gemm g{(const bf16*)(ws + WS_XB), (const bf16*)(ws + WS_WGU + l * WGU_BYTES), M, GUN, DM}; pg8::StaticOrder S; S.init(M, GUN, C.G, C.bid);
            pg8::EpiSwiglu E{(bf16*)(ws + WS_H), (const float*)(ws + WS_SSP)};
            pg8::gemm_phase<pg8::EpiSwiglu, pg8::StaticOrder, true, true>(ring, g, S, E);
        } else {
            unsigned char* ws = C.wsp(); const bool dn = sub == 6;
            pg8::Gemm g{(const bf16*)(ws + (dn ? WS_H : WS_Y)), (const bf16*)(ws + (dn ? WS_WDN + l * WDN_BYTES : WS_WOUT + l * WOUT_BYTES)), M, DM, dn ? DFF : DM};
            pg8::StaticOrder S; S.init(M, DM, C.G, C.bid);
            pg8::EpiRes E{(!dn && l == 0) ? C.inp(0) : (const float*)C.outp(), C.outp(), (bf16*)(ws + WS_XB), (float*)(ws + WS_SSP), (dn && l + 1 == DEPTH) ? 0 : 1};
            pg8::gemm_phase<pg8::EpiRes, pg8::StaticOrder, false, true>(ring, g, S, E);
        }
        if (ph + 1 < ph_hi) xcd_barrier(bar);
    }
}

extern "C" void kernel_launch(void* const* d_in, const int* in_sizes, int n_in, void* d_out, int out_size, void* d_ws, size_t ws_size, hipStream_t stream) {
    static int grid = 0;
    if (grid == 0) {
        if (n_in != 17 || in_sizes[0] != M * DM || out_size != M * DM || ws_size < WS_END) { fprintf(stderr, "kernel_launch: unexpected shapes (n_in %d, in0 %d, out %d, ws %zu); nothing launched\n", n_in, n_in > 0 ? in_sizes[0] : -1, out_size, ws_size); grid = -1; return; }
        int dev = 0, cus = 0, per_cu = 0;
        if (hipGetDevice(&dev) != hipSuccess || hipDeviceGetAttribute(&cus, hipDeviceAttributeMultiprocessorCount, dev) != hipSuccess) { fprintf(stderr, "kernel_launch: device query failed\n"); grid = -1; return; }
        if (hipFuncSetAttribute((const void*)trunk_fwd, hipFuncAttributeMaxDynamicSharedMemorySize, LDS_BYTES) != hipSuccess) { fprintf(stderr, "kernel_launch: hipFuncSetAttribute failed\n"); grid = -1; return; }
        if (hipOccupancyMaxActiveBlocksPerMultiprocessor(&per_cu, (const void*)trunk_fwd, NT, LDS_BYTES) != hipSuccess || per_cu < 1) { fprintf(stderr, "kernel_launch: occupancy query reports %d workgroups per CU\n", per_cu); }
        (void)hipGetLastError();
        grid = cus;
        if (grid != 256) { fprintf(stderr, "kernel_launch: built for a 256-CU device, found %d CUs; nothing launched\n", cus); grid = -1; return; }
    }
    if (grid < 0) return;
    if (hipMemsetAsync((char*)d_ws + WS_CTL, 0, CTL_ZERO_BYTES, stream) != hipSuccess) { fprintf(stderr, "kernel_launch: hipMemsetAsync failed\n"); return; }
    Args a{};
    for (int i = 0; i < 17; ++i) a.in[i] = (const float*)d_in[i];
    a.out = (float*)d_out; a.ws = (unsigned char*)d_ws;
    if (MK_N_LAUNCHES == 1) { a.ph_lo = 0; a.ph_hi = NPHASE; hipLaunchKernelGGL(trunk_fwd, dim3(grid), dim3(NT), LDS_BYTES, stream, a); }
    else for (int p = 0; p < NPHASE; ++p) { a.ph_lo = p; a.ph_hi = p + 1; hipLaunchKernelGGL(trunk_fwd, dim3(grid), dim3(NT), LDS_BYTES, stream, a); }
    const hipError_t le = hipPeekAtLastError();
    if (le != hipSuccess) fprintf(stderr, "kernel_launch: launch failed: %s\n", hipGetErrorName(le));
}
```

```cpp
#include <hip/hip_runtime.h>
#include <cstdio>
#include <cstdint>
#define PF_TILES 6
namespace pg8 {
#define PG8_LAS __attribute__((address_space(3)))
typedef unsigned short bf16_t;
typedef short bf16x8 __attribute__((ext_vector_type(8)));
typedef float f32x4 __attribute__((ext_vector_type(4)));
typedef unsigned u32x4 __attribute__((ext_vector_type(4)));
constexpr int BM = 256, BK = 64, HALF = 128, HTB = HALF * BK * 2  , STAGE_BYTES = 8 * HTB, NXCD = 8, WGM = 8;

__host__ __device__ __forceinline__ int lds_byte(int r, int c) { const int st = (r >> 4) * 2 + (c >> 5), rr = r & 15, cc = c & 31, ob = rr * 64 + cc * 2; return st * 1024 + (ob ^ (((ob >> 9) & 1) << 5)); }
__host__ __device__ __forceinline__ void stage_rc(int b, int& R, int& C) { const int st = b / 1024, sb = b % 1024, swz = sb ^ (((sb >> 9) & 1) << 5); R = (st >> 1) * 16 + swz / 64; C = (st & 1) * 32 + (swz % 64) / 2; }
__host__ __device__ __forceinline__ int perm32(int rho) { const int n = rho >> 4, i = rho & 15; return 8 * (i >> 2) + 4 * n + (i & 3); }

struct Unit { int pm, pn; };
struct Gemm { const bf16_t* A; const bf16_t* Bt; int M, N, K; };

struct StaticOrder {
    int nM, nN, nwg, G, c, wgm;
    __host__ __device__ void init(int M, int N, int G_, int c_, int wgm_) { nM = M / BM; nN = N / BM; nwg = nM * nN; G = G_; c = c_; wgm = wgm_; }
    __host__ __device__ bool next(int i, Unit& u) const {
        const long L = (long)i * G + c; if (L >= nwg) return false;
        int wgid = (int)L; { const int q = nwg / NXCD, r = nwg % NXCD, xcd = wgid % NXCD, off = wgid / NXCD; wgid = (xcd < r ? xcd * (q + 1) : r * (q + 1) + (xcd - r) * q) + off; }
        const int nig = wgm * nN, gid = wgid / nig, fm = gid * wgm, gsz = (nM - fm) < wgm ? (nM - fm) : wgm;
        u.pm = fm + ((wgid % nig) % gsz); u.pn = (wgid % nig) / gsz; return true;
    }
    __device__ __forceinline__ void a_ready(const Unit&) const {}
    __device__ __forceinline__ void done(const Unit&) const {}
};

__device__ __forceinline__ unsigned cvt_pk_bf16(float lo, float hi) { unsigned r; asm volatile("v_cvt_pk_bf16_f32 %0, %1, %2" : "=v"(r) : "v"(lo), "v"(hi)); return r; }
typedef unsigned u32x2 __attribute__((ext_vector_type(2)));
__device__ __forceinline__ void load_rstd(const unsigned long long* ssq, int row0, float (&rs)[2][4]) {
    unsigned long long v[2][4];
#pragma unroll
    for (int ai = 0; ai < 2; ++ai)
#pragma unroll
        for (int m = 0; m < 4; ++m) v[ai][m] = ssq[row0 + ai * HALF + m * 16];
#pragma unroll
    for (int ai = 0; ai < 2; ++ai)
#pragma unroll
        for (int m = 0; m < 4; ++m) { const float s = (float)(unsigned)(v[ai][m] >> 32) * 4294967296.0f + (float)(unsigned)v[ai][m];
            rs[ai][m] = __builtin_amdgcn_rsqf(s * (1.0f / (16777216.0f * 2048.0f)) + 1e-6f); }
}
struct EpiZ {
    static constexpr bool PERM = true, AFTER_DRAIN = false;
    bf16_t* Z; float* ZS; const PG8_LAS float* rst;
    __device__ __forceinline__ void operator()(const f32x4 (&acc)[2][2][4][2], const Unit& u, int wr, int wc, int fr, int fq) const {
        const int row0 = u.pm * BM + wr * 64 + fr; float rs[2][4];
#pragma unroll
        for (int ai = 0; ai < 2; ++ai)
#pragma unroll
            for (int m = 0; m < 4; ++m) rs[ai][m] = rst[(u.pm & 3) * BM + ai * HALF + wr * 64 + m * 16 + fr];
        if (u.pn < 20) {
            const int col0 = u.pn * BM + wc * 32 + 8 * fq;
#pragma unroll
            for (int ai = 0; ai < 2; ++ai)
#pragma unroll
                for (int m = 0; m < 4; ++m) { bf16_t* rowp = Z + (size_t)(row0 + ai * HALF + m * 16) * 5120 + col0; const float r = rs[ai][m];
#pragma unroll
                    for (int bj = 0; bj < 2; ++bj) { const f32x4 v0 = acc[ai][bj][m][0] * r, v1 = acc[ai][bj][m][1] * r;
                        u32x4 w; w.x = cvt_pk_bf16(v0[0], v0[1]); w.y = cvt_pk_bf16(v0[2], v0[3]); w.z = cvt_pk_bf16(v1[0], v1[1]); w.w = cvt_pk_bf16(v1[2], v1[3]);
                        *(u32x4*)(rowp + bj * HALF) = w; } }
        } else if (wc == 0 && fq < 3) {
#pragma unroll
            for (int ai = 0; ai < 2; ++ai)
#pragma unroll
                for (int m = 0; m < 4; ++m) { float* rp = ZS + (size_t)(row0 + ai * HALF + m * 16) * 32 + 8 * fq; const float r = rs[ai][m];
                    *(f32x4*)rp = acc[ai][0][m][0] * r; *(f32x4*)(rp + 4) = acc[ai][0][m][1] * r; }
        }
    }
};
struct EpiSwiglu {
    static constexpr bool PERM = true, AFTER_DRAIN = false;
    bf16_t* H; const PG8_LAS float* rst;
    __device__ __forceinline__ void operator()(const f32x4 (&acc)[2][2][4][2], const Unit& u, int wr, int wc, int fr, int fq) const {
        const int row0 = u.pm * BM + wr * 64 + fr; float rs[2][4];
#pragma unroll
        for (int ai = 0; ai < 2; ++ai)
#pragma unroll
            for (int m = 0; m < 4; ++m) rs[ai][m] = rst[(u.pm & 3) * BM + ai * HALF + wr * 64 + m * 16 + fr];
        const int col0 = u.pn * HALF + wc * 32 + 8 * fq;
#pragma unroll
        for (int ai = 0; ai < 2; ++ai)
#pragma unroll
            for (int m = 0; m < 4; ++m) { bf16_t* rowp = H + (size_t)(row0 + ai * HALF + m * 16) * 5632 + col0; const float r = rs[ai][m];
                float hv[8];
#pragma unroll
                for (int n = 0; n < 2; ++n)
#pragma unroll
                    for (int j = 0; j < 4; ++j) { const float g = acc[ai][0][m][n][j] * r, uu = acc[ai][1][m][n][j] * r;
                        hv[4 * n + j] = g * __builtin_amdgcn_rcpf(1.0f + __builtin_amdgcn_exp2f(-1.4426950408889634f * g)) * uu; }
                u32x4 w; w.x = cvt_pk_bf16(hv[0], hv[1]); w.y = cvt_pk_bf16(hv[2], hv[3]); w.z = cvt_pk_bf16(hv[4], hv[5]); w.w = cvt_pk_bf16(hv[6], hv[7]);
                *(u32x4*)rowp = w; }
    }
};
struct EpiRes {
    static constexpr bool PERM = false, AFTER_DRAIN = true;
    float* out; bf16_t* xb; unsigned long long* ssp; int stats; int final; PG8_LAS unsigned char* sink;
    __device__ __forceinline__ void prefetch(const Unit& u, int tid, int wid) const {
        const bf16_t* p = xb + (size_t)(u.pm * BM + (tid >> 1)) * 2048 + u.pn * BM + (tid & 1) * 128;
        PG8_LAS unsigned* s = (PG8_LAS unsigned*)(sink + wid * 512);
        __builtin_amdgcn_global_load_lds((const unsigned*)p, s, 4, 0, 0); __builtin_amdgcn_global_load_lds((const unsigned*)(p + 64), s + 64, 4, 0, 0);
    }
    __device__ __forceinline__ void fused(f32x4 (&acc)[2][2][4][2], const Unit& u, int wr, int wc, int fr, int fq, PG8_LAS unsigned char* lds, int wid, int lane) const {
        PG8_LAS float* P = (PG8_LAS float*)lds;
        const int col0 = u.pn * BM + wc * 32 + 4 * fq;
        u32x2 pre[8][2][2];
#pragma unroll
        for (int gi = 0; gi < 8; ++gi) { const size_t off = (size_t)(u.pm * BM + (gi >> 2) * HALF + wr * 64 + (gi & 3) * 16 + fr) * 2048 + col0;
#pragma unroll
            for (int bj = 0; bj < 2; ++bj)
#pragma unroll
                for (int n = 0; n < 2; ++n) pre[gi][bj][n] = *(const u32x2*)(xb + off + bj * HALF + n * 16); }
#pragma unroll
        for (int gi = 0; gi < 8; ++gi) { const int ai = gi >> 2, m = gi & 3; const int r = ai * HALF + wr * 64 + m * 16 + fr; const size_t off = (size_t)(u.pm * BM + r) * 2048 + col0; float s = 0.f;
#pragma unroll
            for (int bj = 0; bj < 2; ++bj)
#pragma unroll
                for (int n = 0; n < 2; ++n) { const u32x2 b = pre[gi][bj][n];
                    const f32x4 bs = {__uint_as_float(b.x << 16), __uint_as_float(b.x & 0xffff0000u), __uint_as_float(b.y << 16), __uint_as_float(b.y & 0xffff0000u)};
                    const f32x4 o = bs + acc[ai][bj][m][n];
                    if (final) *(f32x4*)(out + off + bj * HALF + n * 16) = o;
                    if (stats) { s += (o[0] * o[0] + o[1] * o[1]) + (o[2] * o[2] + o[3] * o[3]); u32x2 w; w.x = cvt_pk_bf16(o[0], o[1]); w.y = cvt_pk_bf16(o[2], o[3]); *(u32x2*)(xb + off + bj * HALF + n * 16) = w; } }
            if (stats) { s += __shfl_xor(s, 16); s += __shfl_xor(s, 32); if (fq == 0) P[r * 4 + wc] = s; }
        }
        if (stats) {
            asm volatile("s_waitcnt lgkmcnt(0)" ::: "memory"); __builtin_amdgcn_s_barrier(); asm volatile("" ::: "memory");
            const int tid = wid * 64 + lane;
            if (tid < 256) { const float s = (P[tid * 4 + 0] + P[tid * 4 + 1]) + (P[tid * 4 + 2] + P[tid * 4 + 3]); atomicAdd(ssp + (u.pm * BM + tid), (unsigned long long)(s * 16777216.0f)); }
        }
    }
};
template <class Epi, class Sched, bool ALIGN_EPI = false, bool SP2 = false>
__device__ __forceinline__ void gemm_phase(PG8_LAS unsigned char* lds, const Gemm g, const Sched& S, const Epi& E) {
    int tid_ = threadIdx.x; asm volatile("" : "+v"(tid_));
    const int tid = tid_, wid = __builtin_amdgcn_readfirstlane(tid >> 6), lane = tid & 63, wr = wid >> 2, wc = wid & 3, fr = lane & 15, fq = lane >> 4;
    const int K = g.K, nt = K / BK;
    unsigned voffA[2], voffB[2];
#pragma unroll
    for (int i = 0; i < 2; ++i) { int R, C; stage_rc(tid * 16 + i * 8192, R, C); const int Rb = Epi::PERM ? ((R & ~31) + perm32(R & 31)) : R;
        voffA[i] = (unsigned)(R * K + C) * 2u; voffB[i] = (unsigned)(Rb * K + C) * 2u; }
    const size_t kstep = (size_t)(BK * 2);
    const size_t hstep = (size_t)HALF * K * 2;
    const size_t tstep = 2 * hstep;
    const unsigned ldsw = (unsigned)wid * 1024u;
    const int aoff = lds_byte(wr * 64 + fr, fq * 8), boff = lds_byte(wc * 32 + fr, fq * 8);
#define PG8_SA(b, h) (((b) * 2 + (h)) * HTB)
#define PG8_SB(b, h) ((4 + (b) * 2 + (h)) * HTB)
#define PG8_STAGE(bufoff, gbase, voff) do { _Pragma("unroll") for (int _i = 0; _i < 2; ++_i) \
        __builtin_amdgcn_global_load_lds((const unsigned*)((const char*)(gbase) + (voff)[_i]), (PG8_LAS unsigned*)(lds + (bufoff) + ldsw + _i * 8192), 16, 0, 0); } while (0)
#define PG8_LDA(dst, b, h) do { _Pragma("unroll") for (int m = 0; m < 4; ++m) _Pragma("unroll") for (int k = 0; k < 2; ++k) dst[m][k] = *(const PG8_LAS bf16x8*)(lds + PG8_SA(b, h) + aoff + m * 2048 + k * 1024); } while (0)
#define PG8_LDB(dst, b, h) do { _Pragma("unroll") for (int n = 0; n < 2; ++n) _Pragma("unroll") for (int k = 0; k < 2; ++k) dst[n][k] = *(const PG8_LAS bf16x8*)(lds + PG8_SB(b, h) + boff + n * 2048 + k * 1024); } while (0)
#define PG8_MMA(ai, bj, At, Bt) do { __builtin_amdgcn_s_setprio(1); _Pragma("unroll") for (int m = 0; m < 4; ++m) _Pragma("unroll") for (int n = 0; n < 2; ++n) _Pragma("unroll") for (int k = 0; k < 2; ++k) \
        acc[ai][bj][m][n] = __builtin_amdgcn_mfma_f32_16x16x32_bf16(Bt[n][k], At[m][k], acc[ai][bj][m][n], 0, 0, 0); __builtin_amdgcn_s_setprio(0); } while (0)
#define PG8_WAIT_V(n) asm volatile("s_waitcnt vmcnt(" #n ")" ::: "memory")
#define PG8_WAIT_L(n) asm volatile("s_waitcnt lgkmcnt(" #n ")" ::: "memory")
#define PG8_BAR __builtin_amdgcn_s_barrier()
#define PG8_SCHED __builtin_amdgcn_sched_barrier(0)
    Unit cur, nxt; int ui = 0;
    if (!S.next(0, cur)) return;
    f32x4 acc[2][2][4][2];
#pragma unroll
    for (int a = 0; a < 2; ++a)
#pragma unroll
        for (int b = 0; b < 2; ++b)
#pragma unroll
            for (int m = 0; m < 4; ++m)
#pragma unroll
                for (int n = 0; n < 2; ++n) acc[a][b][m][n] = (f32x4){0.f, 0.f, 0.f, 0.f};
    bf16x8 At[4][2], B0[2][2], B1[2][2];
    const char* cA = (const char*)g.A + (size_t)cur.pm * tstep; const char* cB = (const char*)g.Bt + (size_t)cur.pn * tstep;
    S.a_ready(cur);
    if constexpr (SP2) {
        PG8_STAGE(PG8_SB(0, 0), cB, voffB); PG8_STAGE(PG8_SB(0, 1), cB + hstep, voffB); PG8_STAGE(PG8_SA(0, 0), cA, voffA); PG8_STAGE(PG8_SA(0, 1), cA + hstep, voffA);
        if (wr == 1) PG8_BAR;
        PG8_WAIT_V(2); PG8_BAR;
        PG8_STAGE(PG8_SB(1, 0), cB + kstep, voffB); PG8_STAGE(PG8_SA(1, 0), cA + kstep, voffA); PG8_STAGE(PG8_SB(1, 1), cB + hstep + kstep, voffB);
        PG8_WAIT_V(6); PG8_BAR;
    } else {
        PG8_STAGE(PG8_SB(0, 0), cB, voffB); PG8_STAGE(PG8_SA(0, 0), cA, voffA); PG8_STAGE(PG8_SB(0, 1), cB + hstep, voffB); PG8_STAGE(PG8_SA(0, 1), cA + hstep, voffA);
        if (wr == 1) PG8_BAR;
        PG8_WAIT_V(4); PG8_BAR;
        PG8_STAGE(PG8_SB(1, 0), cB + kstep, voffB); PG8_STAGE(PG8_SA(1, 0), cA + kstep, voffA); PG8_STAGE(PG8_SB(1, 1), cB + hstep + kstep, voffB);
        PG8_WAIT_V(6); PG8_BAR;
    }
    for (;;) {
        const bool has_next = S.next(ui + 1, nxt);
        const char* nA = has_next ? (const char*)g.A + (size_t)nxt.pm * tstep : cA; const char* nB = has_next ? (const char*)g.Bt + (size_t)nxt.pn * tstep : cB;
        for (int t = 0; t < nt; t += 2) {
            const bool last = (t == nt - 2);
            const char* a1 = cA + (size_t)(t + 1) * kstep;
            const char* a2 = last ? nA : cA + (size_t)(t + 2) * kstep; const char* b2 = last ? nB : cB + (size_t)(t + 2) * kstep;
            const char* a3 = a2 + kstep; const char* b3 = b2 + kstep;
            if (last && has_next) S.a_ready(nxt);
            if constexpr (Epi::AFTER_DRAIN) { if (t == nt - PF_TILES) E.prefetch(cur, tid, wid); }
            if constexpr (SP2) {
            PG8_LDB(B0, 0, 0); PG8_LDB(B1, 0, 1); PG8_SCHED; PG8_LDA(At, 0, 0); PG8_STAGE(PG8_SA(1, 1), a1 + hstep, voffA);
            PG8_WAIT_V(8); PG8_WAIT_L(0); PG8_BAR; PG8_MMA(0, 0, At, B0); PG8_MMA(0, 1, At, B1); PG8_BAR; PG8_SCHED;
            PG8_LDA(At, 0, 1); PG8_STAGE(PG8_SB(0, 0), b2, voffB); PG8_STAGE(PG8_SB(0, 1), b2 + hstep, voffB); PG8_STAGE(PG8_SA(0, 0), a2, voffA);
            PG8_WAIT_V(8); PG8_WAIT_L(0); PG8_BAR; PG8_MMA(1, 0, At, B0); PG8_MMA(1, 1, At, B1); PG8_BAR; PG8_SCHED;
            PG8_LDB(B0, 1, 0); PG8_LDB(B1, 1, 1); PG8_SCHED; PG8_LDA(At, 1, 0); PG8_STAGE(PG8_SA(0, 1), a2 + hstep, voffA);
            PG8_WAIT_V(8); PG8_WAIT_L(0); PG8_BAR; PG8_MMA(0, 0, At, B0); PG8_MMA(0, 1, At, B1); PG8_BAR; PG8_SCHED;
            PG8_LDA(At, 1, 1); PG8_STAGE(PG8_SB(1, 0), b3, voffB); PG8_STAGE(PG8_SB(1, 1), b3 + hstep, voffB); PG8_STAGE(PG8_SA(1, 0), a3, voffA);
            PG8_WAIT_V(8); PG8_WAIT_L(0); PG8_BAR; PG8_MMA(1, 0, At, B0); PG8_MMA(1, 1, At, B1); PG8_BAR; PG8_SCHED;
            } else {
            PG8_LDB(B0, 0, 0); PG8_SCHED; PG8_LDA(At, 0, 0); PG8_STAGE(PG8_SA(1, 1), a1 + hstep, voffA);
            PG8_WAIT_L(8); PG8_BAR; PG8_WAIT_L(0); PG8_MMA(0, 0, At, B0); PG8_BAR; PG8_SCHED;
            PG8_LDB(B1, 0, 1); PG8_STAGE(PG8_SB(0, 0), b2, voffB);
            PG8_BAR; PG8_WAIT_L(0); PG8_MMA(0, 1, At, B1); PG8_BAR;
            PG8_LDA(At, 0, 1); PG8_STAGE(PG8_SA(0, 0), a2, voffA);
            PG8_BAR; PG8_WAIT_L(0); PG8_MMA(1, 0, At, B0); PG8_BAR; PG8_SCHED;
            PG8_STAGE(PG8_SB(0, 1), b2 + hstep, voffB);
            PG8_WAIT_V(6); PG8_BAR; PG8_MMA(1, 1, At, B1); PG8_BAR;
            PG8_LDB(B0, 1, 0); PG8_SCHED; PG8_LDA(At, 1, 0); PG8_STAGE(PG8_SA(0, 1), a2 + hstep, voffA);
            PG8_WAIT_L(8); PG8_BAR; PG8_WAIT_L(0); PG8_MMA(0, 0, At, B0); PG8_BAR; PG8_SCHED;
            PG8_LDB(B1, 1, 1); PG8_STAGE(PG8_SB(1, 0), b3, voffB);
            PG8_BAR; PG8_WAIT_L(0); PG8_MMA(0, 1, At, B1); PG8_BAR;
            PG8_LDA(At, 1, 1); PG8_STAGE(PG8_SA(1, 0), a3, voffA);
            PG8_BAR; PG8_WAIT_L(0); PG8_MMA(1, 0, At, B0); PG8_BAR; PG8_SCHED;
            PG8_STAGE(PG8_SB(1, 1), b3 + hstep, voffB);
            PG8_WAIT_V(6); PG8_BAR; PG8_MMA(1, 1, At, B1); PG8_BAR;
            }
        }
        if constexpr (ALIGN_EPI) { if (wr == 0) PG8_BAR; }
        if constexpr (!Epi::AFTER_DRAIN) { E(acc, cur, wr, wc, fr, fq); S.done(cur); }
        if (!has_next) break;
#pragma unroll
        for (int a = 0; a < 2; ++a)
#pragma unroll
            for (int b = 0; b < 2; ++b)
#pragma unroll
                for (int m = 0; m < 4; ++m)
#pragma unroll
                    for (int n = 0; n < 2; ++n) acc[a][b][m][n] = (f32x4){0.f, 0.f, 0.f, 0.f};
        cur = nxt; cA = nA; cB = nB; ++ui;
        if constexpr (ALIGN_EPI) { if (wr == 1) PG8_BAR; }
    }
    PG8_WAIT_V(0);
    if constexpr (!ALIGN_EPI) { if (wr == 0) PG8_BAR; }
    PG8_BAR;
    if constexpr (Epi::AFTER_DRAIN) { E.fused(acc, cur, wr, wc, fr, fq, lds, wid, lane); S.done(cur); }
#undef PG8_SA
#undef PG8_SB
#undef PG8_STAGE
#undef PG8_LDA
#undef PG8_LDB
#undef PG8_MMA
#undef PG8_WAIT_V
#undef PG8_WAIT_L
#undef PG8_BAR
#undef PG8_SCHED
}
}
#define GAS __attribute__((address_space(1)))
#define LAS __attribute__((address_space(3)))
typedef unsigned short bf16;
typedef unsigned v4u __attribute__((ext_vector_type(4)));
typedef float f32x4 __attribute__((ext_vector_type(4)));
typedef short bf16x8 __attribute__((ext_vector_type(8)));
typedef GAS unsigned gu32;
typedef GAS unsigned long long gu64;
#define RLX_AGENT __ATOMIC_RELAXED, __HIP_MEMORY_SCOPE_AGENT
#define LDS_WAIT() asm volatile("s_waitcnt lgkmcnt(0)" ::: "memory")
#define VM_WAIT() asm volatile("s_waitcnt vmcnt(0)" ::: "memory")
__device__ __forceinline__ unsigned long long rt() { return __builtin_amdgcn_s_memrealtime(); }
__device__ __forceinline__ unsigned f2bf(float f) { unsigned u = __builtin_bit_cast(unsigned, f); return (u + 0x7fffu + ((u >> 16) & 1u)) >> 16; }
__device__ __forceinline__ unsigned pk2(float lo, float hi) { return f2bf(lo) | (f2bf(hi) << 16); }

#define XB_TMO      128
#define XB_XCNT(j)  (256  + 64 * (j))
#define XB_XSUB(j)  (1280 + 64 * (j))
#define XB_XGEN(j)  (2304 + 64 * (j))
#define XB_TOP      3328
#define XB_TOPGEN   3392
#define XCD_BAR_WORDS 3456
#define XB_SPIN_CAP (1u << 18)

__device__ __forceinline__ unsigned xb_ld(unsigned* p)              { return __hip_atomic_load(p, __ATOMIC_RELAXED, __HIP_MEMORY_SCOPE_AGENT); }
__device__ __forceinline__ unsigned xb_add(unsigned* p, unsigned v) { return __hip_atomic_fetch_add(p, v, __ATOMIC_RELAXED, __HIP_MEMORY_SCOPE_AGENT); }
__device__ __forceinline__ unsigned xb_xcc_id() { return (unsigned)__builtin_amdgcn_s_getreg((3 << 11) | 20) & 0xFu; }
#define XB_SPIN(cond, bar) do { unsigned _sp = 0; while (cond) { __builtin_amdgcn_s_sleep(1); \
    if ((++_sp & 255u) == 0u) { if (xb_ld(&(bar)[XB_TMO])) break; if (_sp > XB_SPIN_CAP) { atomicAdd(&(bar)[XB_TMO], 1u); break; } } } } while (0)

struct XcdBarrier {
    unsigned* bar; unsigned x;
    volatile LAS unsigned* st;
};

__device__ __forceinline__ XcdBarrier xcd_barrier_post(unsigned* bar, volatile LAS unsigned* st) {
    XcdBarrier b; b.bar = bar; b.x = xb_xcc_id(); b.st = st;
    if (threadIdx.x == 0) (void)xb_add(&bar[XB_XCNT(b.x)], 1u);
    return b;
}
__device__ __forceinline__ void xcd_barrier_complete(unsigned* bar, unsigned x, unsigned& nloc, unsigned& nx) {
    const unsigned G = gridDim.x * gridDim.y * gridDim.z;
    unsigned sum, cnt, mine, sp = 0u;
    for (;;) {
        sum = 0u; cnt = 0u; mine = 0u;
#pragma unroll
        for (unsigned j = 0; j < 16; ++j) { const unsigned c = xb_ld(&bar[XB_XCNT(j)]); sum += c; cnt += (c > 0u) ? 1u : 0u; mine = (j == x) ? c : mine; }
        if (sum == G) break;
        __builtin_amdgcn_s_sleep(1);
        if ((++sp & 255u) == 0u) { if (xb_ld(&bar[XB_TMO])) break; if (sp > XB_SPIN_CAP) { atomicAdd(&bar[XB_TMO], 1u); break; } }
    }
    nloc = mine > 0u ? mine : 1u; nx = cnt > 0u ? cnt : 1u;
}

__device__ __forceinline__ void xcd_barrier(const XcdBarrier& b) {
    asm volatile("s_waitcnt vmcnt(0)" ::: "memory");
    __syncthreads();
    if (threadIdx.x == 0) {
        unsigned* bar = b.bar; unsigned bx = b.x; asm volatile("" : "+s"(bar), "+s"(bx));
        __builtin_amdgcn_s_waitcnt(0);
        unsigned nloc = b.st[0], nx = b.st[1];
        if (nloc == 0u) { xcd_barrier_complete(bar, bx, nloc, nx); b.st[0] = nloc; b.st[1] = nx; }
        const unsigned old = xb_add(&bar[XB_XSUB(bx)], 1u);
        const unsigned gen = old / nloc;
        if (old + 1u == (gen + 1u) * nloc) {
            __builtin_amdgcn_fence(__ATOMIC_RELEASE, "agent");
            asm volatile("s_waitcnt vmcnt(0)" ::: "memory");
            const unsigned og = xb_add(&bar[XB_TOP], 1u);
            const unsigned tg = og / nx;
            if (og + 1u == (tg + 1u) * nx) xb_add(&bar[XB_TOPGEN], 1u);
            else XB_SPIN(xb_ld(&bar[XB_TOPGEN]) == tg, bar);
            xb_add(&bar[XB_XGEN(bx)], 1u);
            __builtin_amdgcn_fence(__ATOMIC_ACQUIRE, "agent");
            asm volatile("s_waitcnt vmcnt(0)" ::: "memory");
        } else {
            XB_SPIN(xb_ld(&bar[XB_XGEN(bx)]) == gen, bar);
            __builtin_amdgcn_fence(__ATOMIC_ACQUIRE, "agent");
            asm volatile("s_waitcnt vmcnt(0)" ::: "memory");
        }
    }
    __syncthreads();
}
constexpr int NWAVES = 8, NT = NWAVES * 64;
#ifndef MK_N_LAUNCHES
#define MK_N_LAUNCHES 1
#endif
constexpr int DM = 2048, NB = 4, SEQ = 2048, M = NB * SEQ, DEPTH = 2, INC = 5140, ZLD = 5120, ZN = 5376, DFF = 5632, GUN = 2 * DFF;
constexpr int Z_CB = 0, Z_CC = 512, Z_CH = 1024, Z_PU = 1536, Z_GQ = 2048, Z_GK = 2304, Z_GV = 2560, Z_GG = 3072, Z_FQ = 3584, Z_FK = 4096, Z_FV = 4608;
constexpr int Y_A = 0, Y_B = 512, Y_C = 1024, Y_D = 1536;
constexpr float EPS = 1e-6f, LOG2E = 1.4426950408889634f;
constexpr float QSCALE = 0.08838834764831845f * 1.4426950408889634f;
constexpr int NPHASE = 1 + 7 * DEPTH;
constexpr size_t MiB = 1u << 20;
constexpr size_t WS_CTL = 0, CTL_ZERO_BYTES = 1 * MiB;
constexpr size_t WS_WIN = 2 * MiB, WIN_BYTES = (size_t)ZN * DM * 2;
constexpr size_t WS_WOUT = 44 * MiB, WOUT_BYTES = (size_t)DM * DM * 2;
constexpr size_t WS_WGU = 60 * MiB, WGU_BYTES = (size_t)GUN * DM * 2;
constexpr size_t WS_WDN = 148 * MiB, WDN_BYTES = (size_t)DM * DFF * 2;
constexpr size_t WS_XB = 192 * MiB, WS_SSP = 224 * MiB, WS_ZS = 225 * MiB, WS_FB = 226 * MiB, WS_ELAST = 227 * MiB;
constexpr size_t WS_CC = 396 * MiB;
constexpr size_t WS_QN = 228 * MiB, WS_KN = 236 * MiB, WS_VT = 244 * MiB, WS_LOC = 252 * MiB, WS_SST = 268 * MiB;
constexpr size_t WS_Z = 284 * MiB, WS_Y = 364 * MiB, WS_H = 284 * MiB, WS_END = 404 * MiB;
static_assert(WS_WIN + 2 * WIN_BYTES <= WS_WOUT && WS_WOUT + 2 * WOUT_BYTES <= WS_WGU && WS_WGU + 2 * WGU_BYTES <= WS_WDN && WS_WDN + 2 * WDN_BYTES <= WS_XB, "weight map");
static_assert(WS_Z + (size_t)M * ZLD * 2 <= WS_Y && WS_Y + (size_t)M * DM * 2 <= WS_CC && WS_H + (size_t)M * DFF * 2 <= WS_CC, "activation map");
constexpr int CW_BAR = 4096;
constexpr int CW_SCAN = 16384;
constexpr size_t WS_SSQ = 256 * 1024;
constexpr int RST_OFF = 1024 + 131072;
constexpr int MISC_OFF = 0, SCR_OFF = 1024, LDS_BYTES = 147456;

struct Args { const float* in[17]; float* out; unsigned char* ws; int ph_lo, ph_hi; };
typedef const __attribute__((address_space(4))) Args* KArgs;
typedef unsigned u32x4v __attribute__((ext_vector_type(4)));
struct Ctx {
    KArgs ka; LAS unsigned char* scr; int tid, lane, wave, G, bid;
    __device__ __forceinline__ KArgs k() const { KArgs p = ka; asm volatile("" : "+s"(p)); return p; }
    __device__ __forceinline__ const float* inp(int i) const { return k()->in[i]; }
    __device__ __forceinline__ unsigned char* wsp() const { return k()->ws; }
    __device__ __forceinline__ float* outp() const { return k()->out; }
};
__device__ __forceinline__ float bf2f(unsigned h) { return __uint_as_float(h << 16); }
__device__ __forceinline__ void unpack8(const v4u w, float (&f)[8]) {
    f[0] = __uint_as_float(w.x << 16); f[1] = __uint_as_float(w.x & 0xffff0000u); f[2] = __uint_as_float(w.y << 16); f[3] = __uint_as_float(w.y & 0xffff0000u);
    f[4] = __uint_as_float(w.z << 16); f[5] = __uint_as_float(w.z & 0xffff0000u); f[6] = __uint_as_float(w.w << 16); f[7] = __uint_as_float(w.w & 0xffff0000u);
}
__device__ __forceinline__ v4u pack8(const float (&f)[8]) { v4u w; w.x = pk2(f[0], f[1]); w.y = pk2(f[2], f[3]); w.z = pk2(f[4], f[5]); w.w = pk2(f[6], f[7]); return w; }
__device__ __forceinline__ void st16_wt(void* p, v4u v) { asm volatile("global_store_dwordx4 %0, %1, off sc1\n\ts_nop 1" :: "v"(p), "v"(v) : "memory"); }
__device__ __forceinline__ float log_sigmoid(float x) { return fminf(x, 0.f) - log1pf(expf(-fabsf(x))); }
__device__ __forceinline__ float silu(float g) { return g / (1.0f + expf(-g)); }

__device__ __forceinline__ void tr_item(const float* W, int N, int K, int k0, int ns0, bf16* WT, int nd0, const float* gain, LAS float* scr, int lane) {
    f32x4 v[16]; float g[16];
#pragma unroll
    for (int i = 0; i < 16; ++i) { const int kk = i * 4 + (lane >> 4), c = (lane & 15) * 4;
        v[i] = *(const GAS f32x4*)(W + (size_t)(k0 + kk) * N + ns0 + c); g[i] = gain ? gain[k0 + kk] : 1.0f; }
#pragma unroll
    for (int i = 0; i < 16; ++i) { const int kk = i * 4 + (lane >> 4), c = (lane & 15) * 4;
        LAS float* s = scr + kk * 65 + c; s[0] = v[i].x * g[i]; s[1] = v[i].y * g[i]; s[2] = v[i].z * g[i]; s[3] = v[i].w * g[i]; }
    LDS_WAIT(); asm volatile("" ::: "memory");
    const int c = lane & 7;
#pragma unroll
    for (int j = 0; j < 8; ++j) { const int n = j * 8 + (lane >> 3); const LAS float* s = scr + (8 * c) * 65 + n;
        v4u o; o.x = pk2(s[0 * 65], s[1 * 65]); o.y = pk2(s[2 * 65], s[3 * 65]); o.z = pk2(s[4 * 65], s[5 * 65]); o.w = pk2(s[6 * 65], s[7 * 65]);
        *(GAS v4u*)(WT + (size_t)(nd0 + n) * K + k0 + 8 * c) = o; }
    LDS_WAIT(); asm volatile("" ::: "memory");
}
__device__ __forceinline__ void tr_item_tail(const float* W, int k0, bf16* WT, const float* gain, int lane) {
    const float* wr = W + (size_t)(k0 + lane) * INC; const float g = gain[k0 + lane]; float v[20];
#pragma unroll
    for (int q = 0; q < 4; ++q) { const f32x4 a = *(const GAS f32x4*)(wr + 3584 + 4 * q); v[4 * q] = a.x * g; v[4 * q + 1] = a.y * g; v[4 * q + 2] = a.z * g; v[4 * q + 3] = a.w * g; }
    { const f32x4 a = *(const GAS f32x4*)(wr + 5136); v[16] = a.x * g; v[17] = a.y * g; v[18] = a.z * g; v[19] = a.w * g; }
#pragma unroll
    for (int j = 0; j < 20; ++j) WT[(size_t)(5120 + j) * DM + k0 + lane] = (bf16)f2bf(v[j]);
    const v4u z = {0u, 0u, 0u, 0u};
    for (int i = 0; i < 30; ++i) { const int row = 5140 + i * 8 + (lane >> 3); if (row < ZN) *(GAS v4u*)(WT + (size_t)row * DM + k0 + (lane & 7) * 8) = z; }
}
typedef float f32x16p __attribute__((ext_vector_type(16)));
__device__ __forceinline__ void pool_fold_item(const float* W, const float* pw, const float* psc, const float* gain, bf16* WT, int gi, int k0, int dq, LAS float* scr, int lane) {
#pragma unroll 4
    for (int i = 0; i < 16; ++i) { const int idx = i * 64 + lane, kk = idx >> 5, c4 = (idx & 31) * 4;
        const f32x4 v = *(const GAS f32x4*)(W + (size_t)(k0 + kk) * INC + Z_PU + gi * 128 + c4); LAS float* s = scr + kk * 129 + c4; s[0] = v.x; s[1] = v.y; s[2] = v.z; s[3] = v.w; }
    LDS_WAIT(); asm volatile("" ::: "memory");
    const int r32 = lane & 31, hi = lane >> 5;
    const float* pwg = pw + (size_t)gi * 128 * 128 + dq * 32 + r32;
    f32x16p acc;
#pragma unroll
    for (int r = 0; r < 16; ++r) acc[r] = 0.f;
#pragma unroll 8
    for (int s = 0; s < 64; ++s) { const int c = 2 * s + hi; acc = __builtin_amdgcn_mfma_f32_32x32x2f32(scr[r32 * 129 + c], pwg[c * 128], acc, 0, 0, 0); }
    const float sc = psc[gi * 128 + dq * 32 + r32];
    bf16* o = WT + (size_t)(Z_PU + gi * 128 + dq * 32 + r32) * DM + k0 + 4 * hi;
#pragma unroll
    for (int g4 = 0; g4 < 4; ++g4) { const f32x4 gk = *(const GAS f32x4*)(gain + k0 + 8 * g4 + 4 * hi);
        const unsigned lo = pk2(acc[4 * g4] * sc * gk.x, acc[4 * g4 + 1] * sc * gk.y), hi2 = pk2(acc[4 * g4 + 2] * sc * gk.z, acc[4 * g4 + 3] * sc * gk.w);
        *(GAS unsigned long long*)(o + 8 * g4) = (unsigned long long)lo | ((unsigned long long)hi2 << 32); }
    LDS_WAIT(); asm volatile("" ::: "memory");
}
__device__ __forceinline__ float wave_sum(float v) {
#pragma unroll
    for (int o = 1; o < 64; o <<= 1) v += __shfl_xor(v, o);
    return v;
}
constexpr int I_IN = 80 * 32, I_TAIL = 32, I_POOL = 4 * 64 * 4, I_OUT = 32 * 32, I_GU = 176 * 32, I_DN = 32 * 88;
constexpr int CV_PER_LAYER = I_IN + I_TAIL + I_POOL + I_OUT + I_GU + I_DN, CV_FIRST = I_IN + I_TAIL + I_POOL + I_OUT;
__device__ __forceinline__ void convert_range(Ctx& C, int lo, int hi, int slot, int nslots) {
    LAS float* scr = (LAS float*)(C.scr + C.wave * 16896);
    for (int it = lo + slot; it < hi; it += nslots) {
        const int l = it / CV_PER_LAYER; int r = it % CV_PER_LAYER;
        const float* g_mix = C.inp(1) + l * DM; const float* g_ffn = C.inp(13) + l * DM;
        const float* w_in = C.inp(2) + (size_t)l * DM * INC;
        bf16* win_t = (bf16*)(C.wsp() + WS_WIN + l * WIN_BYTES);
        if (r < I_IN) { const int nb = r / 32, kb = r % 32; const int nd0 = nb * 64;
            if (nd0 >= Z_PU && nd0 < Z_GQ) continue;
            const int ns0 = nd0 < 3584 ? nd0 : nd0 + 16;
            tr_item(w_in, INC, DM, kb * 64, ns0, win_t, nd0, g_mix, scr, C.lane); continue; }
        r -= I_IN;
        if (r < I_TAIL) { tr_item_tail(w_in, r * 64, win_t, g_mix, C.lane); continue; }
        r -= I_TAIL;
        if (r < I_POOL) { const int gi = r >> 8, kb = (r >> 2) & 63, dq = r & 3;
            pool_fold_item(w_in, C.inp(4) + (size_t)l * 4 * 128 * 128, C.inp(5) + l * 512, g_mix, win_t, gi, kb * 32, dq, scr, C.lane); continue; }
        r -= I_POOL;
        if (r < I_OUT) { const int nb = r / 32, kb = r % 32;
            tr_item(C.inp(12) + (size_t)l * DM * DM, DM, DM, kb * 64, nb * 64, (bf16*)(C.wsp() + WS_WOUT + l * WOUT_BYTES), nb * 64, nullptr, scr, C.lane); continue; }
        r -= I_OUT;
        if (r < I_GU) { const int nb = r / 32, kb = r % 32; const int nd0 = nb * 64, t = nd0 >> 8, j = nd0 & 255;
            const float* src = (j < 128 ? C.inp(14) : C.inp(15)) + (size_t)l * DM * DFF;
            tr_item(src, DFF, DM, kb * 64, t * 128 + (j & 127), (bf16*)(C.wsp() + WS_WGU + l * WGU_BYTES), nd0, g_ffn, scr, C.lane); continue; }
        r -= I_GU;
        { const int nb = r / 88, kb = r % 88;
            tr_item(C.inp(16) + (size_t)l * DFF * DM, DM, DFF, kb * 64, nb * 64, (bf16*)(C.wsp() + WS_WDN + l * WDN_BYTES), nb * 64, nullptr, scr, C.lane); }
    }
}
__device__ __forceinline__ void convert_in_tail(Ctx& C, int nunits, int lo, int hi) {
    const int rem = nunits % C.G; if (rem == 0 || C.bid < rem || lo >= hi) return;
    convert_range(C, lo, hi, (C.bid - rem) * NWAVES + C.wave, (C.G - rem) * NWAVES);
    __syncthreads();
}
__device__ __forceinline__ void rstd_table(Ctx& C, const unsigned long long* ssq) {
    LAS float* rst = (LAS float*)(C.scr - SCR_OFF + RST_OFF); const int row0 = (C.bid & 7) * 1024;
#pragma unroll
    for (int i = 0; i < 2; ++i) { const int r = C.tid + NT * i; const unsigned long long v = ssq[row0 + r];
        const float s = (float)(unsigned)(v >> 32) * 4294967296.0f + (float)(unsigned)v; rst[r] = __builtin_amdgcn_rsqf(s * (1.0f / (16777216.0f * 2048.0f)) + 1e-6f); }
    __syncthreads();
}
__device__ __forceinline__ void warm_in_tail(Ctx& C, int nunits, const void* p, size_t bytes) {
    const int rem = nunits % C.G; if (rem == 0 || C.bid < rem) return;
    const size_t nlines = bytes >> 7, slot = (size_t)(C.bid - rem) * NT + C.tid, nslots = (size_t)(C.G - rem) * NT; unsigned acc = 0u;
#pragma unroll 8
    for (size_t i = slot; i < nlines; i += nslots) acc += *(const GAS unsigned*)((const char*)p + (i << 7));
    asm volatile("" :: "v"(acc));
}
__device__ __forceinline__ void p0_prologue(Ctx& C) {
    const int gw = C.bid * NWAVES + C.wave, NGW = C.G * NWAVES;
#ifndef CV_ALL_IN_PROLOGUE
    convert_range(C, 0, CV_FIRST + I_GU, gw, NGW);
    convert_range(C, CV_PER_LAYER + I_IN + I_TAIL + I_POOL, CV_PER_LAYER + CV_FIRST + I_GU, gw, NGW);
#else
    convert_range(C, 0, DEPTH * CV_PER_LAYER, gw, NGW);
#endif
    bf16* XB = (bf16*)(C.wsp() + WS_XB); unsigned long long* SSQ = (unsigned long long*)(C.wsp() + WS_SSQ);
    for (int m = gw; m < M; m += NGW) {
        const GAS f32x4* xr = (const GAS f32x4*)(C.inp(0) + (size_t)m * DM) + C.lane; float s = 0.f;
        GAS unsigned long long* o8 = (GAS unsigned long long*)(XB + (size_t)m * DM) + C.lane;
#pragma unroll
        for (int j = 0; j < 8; ++j) { const f32x4 v = xr[64 * j]; s += (v.x * v.x + v.y * v.y) + (v.z * v.z + v.w * v.w);
            o8[64 * j] = (unsigned long long)pk2(v.x, v.y) | ((unsigned long long)pk2(v.z, v.w) << 32); }
        s = wave_sum(s);
        if (C.lane == 0) SSQ[m] = (unsigned long long)(s * 16777216.0f);
    }
}

__device__ __forceinline__ void conv_item(Ctx& C, int l, int item) {
    const bf16* Z = (const bf16*)(C.wsp() + WS_Z); bf16* Y = (bf16*)(C.wsp() + WS_Y); const float* cw = C.inp(3) + l * 1536;
    const int c0 = C.lane * 8; float w0[8], w1[8], w2[8];
#pragma unroll
    for (int i = 0; i < 8; ++i) { w0[i] = cw[c0 + i]; w1[i] = cw[512 + c0 + i]; w2[i] = cw[1024 + c0 + i]; }
    const int t0 = item * 64 + C.wave * 8, s0 = t0 & (SEQ - 1);
    v4u rc[10], rh[10], rb[8];
#pragma unroll
    for (int r = 0; r < 10; ++r) { const bool ok = s0 + r - 2 >= 0; const bf16* zr = Z + (size_t)(t0 + (ok ? r - 2 : 0)) * ZLD + c0;
        rc[r] = *(const GAS v4u*)(zr + Z_CC); rh[r] = *(const GAS v4u*)(zr + Z_CH); if (!ok) { rc[r] = (v4u){0u, 0u, 0u, 0u}; } }
#pragma unroll
    for (int i = 0; i < 8; ++i) rb[i] = *(const GAS v4u*)(Z + (size_t)(t0 + i) * ZLD + Z_CB + c0);
    float u0[8], u1[8], u2[8], a[8], b[8];
    unpack8(rc[0], a); unpack8(rh[0], b);
#pragma unroll
    for (int q = 0; q < 8; ++q) u0[q] = a[q] * b[q];
    unpack8(rc[1], a); unpack8(rh[1], b);
#pragma unroll
    for (int q = 0; q < 8; ++q) u1[q] = a[q] * b[q];
#pragma unroll
    for (int i = 0; i < 8; ++i) { unpack8(rc[i + 2], a); unpack8(rh[i + 2], b);
#pragma unroll
        for (int q = 0; q < 8; ++q) u2[q] = a[q] * b[q];
        unpack8(rb[i], a); float o[8];
#pragma unroll
        for (int q = 0; q < 8; ++q) { o[q] = a[q] * (w0[q] * u0[q] + w1[q] * u1[q] + w2[q] * u2[q]); u0[q] = u1[q]; u1[q] = u2[q]; }
        *(GAS v4u*)(Y + (size_t)(t0 + i) * DM + Y_A + c0) = pack8(o); }
}
template <int WIN> __device__ __forceinline__ void pool_wave(const bf16* Z, bf16* Y, int tfirst, int c0) {
    const int s0 = tfirst & (SEQ - 1);
    v4u rp[WIN + 7];
#pragma unroll
    for (int r = 0; r < WIN + 7; ++r) { const bool ok = s0 + r - (WIN - 1) >= 0; rp[r] = *(const GAS v4u*)(Z + (size_t)(tfirst + (ok ? r - (WIN - 1) : 0)) * ZLD + Z_PU + c0); if (!ok) rp[r] = (v4u){0u, 0u, 0u, 0u}; }
    float acc[8], a[8], b[8];
#pragma unroll
    for (int q = 0; q < 8; ++q) acc[q] = 0.f;
#pragma unroll
    for (int r = 0; r < WIN - 1; ++r) { unpack8(rp[r], a);
#pragma unroll
        for (int q = 0; q < 8; ++q) acc[q] += a[q]; }
#pragma unroll
    for (int i = 0; i < 8; ++i) { unpack8(rp[i + WIN - 1], a);
#pragma unroll
        for (int q = 0; q < 8; ++q) acc[q] += a[q];
        const int cnt = (s0 + i + 1) < WIN ? (s0 + i + 1) : WIN; const float inv = 1.0f / (float)cnt; float o[8];
#pragma unroll
        for (int q = 0; q < 8; ++q) o[q] = acc[q] * inv - a[q];
        *(GAS v4u*)(Y + (size_t)(tfirst + i) * DM + Y_B + c0) = pack8(o);
        unpack8(rp[i], b);
#pragma unroll
        for (int q = 0; q < 8; ++q) acc[q] -= b[q]; }
}
__device__ __forceinline__ void pool_item(Ctx& C, int item) {
    const bf16* Z = (const bf16*)(C.wsp() + WS_Z); bf16* Y = (bf16*)(C.wsp() + WS_Y);
    const int g = C.wave & 3, c0 = g * 128 + (C.lane & 15) * 8, tfirst = item * 64 + (C.wave >> 2) * 32 + (C.lane >> 4) * 8;
    if (g == 0) pool_wave<2>(Z, Y, tfirst, c0); else if (g == 1) pool_wave<4>(Z, Y, tfirst, c0); else if (g == 2) pool_wave<8>(Z, Y, tfirst, c0); else pool_wave<16>(Z, Y, tfirst, c0);
}
__device__ __forceinline__ void foxprep_item(Ctx& C, int l, int item) {
    const bf16* Z = (const bf16*)(C.wsp() + WS_Z); bf16* QN = (bf16*)(C.wsp() + WS_QN); bf16* KN = (bf16*)(C.wsp() + WS_KN);
    LAS unsigned short* T = (LAS unsigned short*)C.scr;
    const int t0 = item * 64, b = t0 >> 11, s0 = t0 & (SEQ - 1);
    const int d0 = (C.lane & 15) * 8; float gq[8], gk[8];
#pragma unroll
    for (int q = 0; q < 8; ++q) { gq[q] = C.inp(9)[l * 128 + d0 + q] * QSCALE; gk[q] = C.inp(10)[l * 128 + d0 + q]; }
    v4u rq[8], rk[8];
#pragma unroll
    for (int i = 0; i < 8; ++i) { const int ch = C.tid + NT * i, tok = ch >> 6, c8 = (ch & 63) * 8; const bf16* zr = Z + (size_t)(t0 + tok) * ZLD + c8;
        rq[i] = *(const GAS v4u*)(zr + Z_FQ); rk[i] = *(const GAS v4u*)(zr + Z_FK); }
#pragma unroll
    for (int i = 0; i < 8; ++i) { const int ch = C.tid + NT * i, tok = ch >> 6, c8 = (ch & 63) * 8; float a[8];
#pragma unroll
        for (int which = 0; which < 2; ++which) {
            unpack8(which ? rk[i] : rq[i], a);
            float ss = 0.f;
#pragma unroll
            for (int q = 0; q < 8; ++q) ss += a[q] * a[q];
            ss += __shfl_xor(ss, 1); ss += __shfl_xor(ss, 2); ss += __shfl_xor(ss, 4); ss += __shfl_xor(ss, 8);
            const float rstd = 1.0f / sqrtf(ss * (1.0f / 128.0f) + EPS);
#pragma unroll
            for (int q = 0; q < 8; ++q) a[q] = a[q] * rstd * (which ? gk[q] : gq[q]);
            if (which) *(LAS v4u*)(T + tok * 520 + c8) = pack8(a); else *(GAS v4u*)(QN + (size_t)(t0 + tok) * 512 + c8) = pack8(a); } }
    __syncthreads();
#pragma unroll
    for (int i = 0; i < 8; ++i) { const int oc = C.tid + NT * i, ln = oc & 63, ds = (oc >> 6) & 7, blk = (oc >> 9) & 1, h = oc >> 10;
        const v4u w = *(const LAS v4u*)(T + (blk * 32 + (ln & 31)) * 520 + h * 128 + ds * 16 + (ln >> 5) * 8);
        *(GAS v4u*)(KN + ((((size_t)(b * 4 + h) * 64 + (s0 >> 5) + blk) * 8 + ds) * 64 + ln) * 8) = w; }
    __syncthreads();
}
__device__ __forceinline__ float fls(float x) { const float e = __builtin_amdgcn_exp2f(-fabsf(x) * LOG2E); return fminf(x, 0.f) - 0.6931471805599453f * __builtin_amdgcn_logf(1.0f + e); }
__device__ __forceinline__ void fscan_item(Ctx& C, int l, int item) {
    const float* ZS = (const float*)(C.wsp() + WS_ZS); float* FB = (float*)(C.wsp() + WS_FB); LAS float* WTOT = (LAS float*)C.scr;
    const int b = item >> 2, h = item & 3; const float bf = C.inp(11)[l * 4 + h];
    const int s0 = C.tid * 4; float v[4]; float run = 0.f;
#pragma unroll
    for (int j = 0; j < 4; ++j) { run += fls(ZS[(size_t)(b * SEQ + s0 + j) * 32 + 16 + h] + bf); v[j] = run; }
    float inc = run;
#pragma unroll
    for (int o = 1; o < 64; o <<= 1) { const float nb = __shfl_up(inc, o); if (C.lane >= o) inc += nb; }
    if (C.lane == 63) WTOT[C.wave] = inc;
    __syncthreads();
    float excl = inc - run;
    for (int w = 0; w < C.wave; ++w) excl += WTOT[w];
    *(GAS f32x4*)(FB + (size_t)item * SEQ + s0) = (f32x4){-(v[0] + excl) * LOG2E, -(v[1] + excl) * LOG2E, -(v[2] + excl) * LOG2E, -(v[3] + excl) * LOG2E};
    __syncthreads();
}
__device__ __forceinline__ void gla_scan_item(Ctx& C, int item) {
    if (C.tid >= 128) return;
    const float* LOC = (const float*)(C.wsp() + WS_LOC); const float* EL = (const float*)(C.wsp() + WS_ELAST); float* SST = (float*)(C.wsp() + WS_SST);
    const int c = (item * 128 + C.tid) * 4, bh = c >> 13, kv = c & 8191, k = kv >> 7, b = bh >> 2, h = bh & 3;
    f32x4 st = {0.f, 0.f, 0.f, 0.f};
#pragma unroll
    for (int n0 = 0; n0 < 32; n0 += 16) {
        f32x4 lo[16]; float e[16];
#pragma unroll
        for (int n = 0; n < 16; ++n) { const int unit = (b * 32 + n0 + n) * 4 + h; lo[n] = *(const GAS f32x4*)(LOC + (size_t)unit * 8192 + kv); e[n] = EL[unit * 64 + k]; }
#pragma unroll
        for (int n = 0; n < 16; ++n) { const int unit = (b * 32 + n0 + n) * 4 + h; st16_wt(SST + (size_t)unit * 8192 + kv, __builtin_bit_cast(v4u, st)); st = st * e[n] + lo[n]; }
    }
}
typedef float f32x16 __attribute__((ext_vector_type(16)));
__device__ __forceinline__ void vtprep_item(Ctx& C, int item) {
    const bf16* Z = (const bf16*)(C.wsp() + WS_Z); bf16* VF = (bf16*)(C.wsp() + WS_VT);
    LAS unsigned short* T = (LAS unsigned short*)C.scr;
    const int t0 = item * 64, b = t0 >> 11, kt = (t0 & (SEQ - 1)) >> 6;
#pragma unroll
    for (int i = 0; i < 8; ++i) { const int ch = C.tid + NT * i, tok = ch >> 6, c8 = (ch & 63) * 8;
        *(LAS v4u*)(T + tok * 520 + c8) = *(const GAS v4u*)(Z + (size_t)(t0 + tok) * ZLD + Z_FV + c8); }
    __syncthreads();
#pragma unroll
    for (int i = 0; i < 8; ++i) { const int ch = C.tid + NT * i, ln = ch & 63, s = (ch >> 6) & 3, dblk = (ch >> 8) & 3, h = ch >> 10, hx = ln >> 5, li = ln & 15;
        const LAS unsigned short* p = T + (16 * s + 4 * hx + (li >> 2)) * 520 + h * 128 + dblk * 32 + 16 * ((ln >> 4) & 1) + 4 * (li & 3);
        typedef short v4s_t __attribute__((ext_vector_type(4)));
        const v4s_t lo = __builtin_amdgcn_ds_read_tr16_b64_v4i16((LAS v4s_t*)p), hi2 = __builtin_amdgcn_ds_read_tr16_b64_v4i16((LAS v4s_t*)(p + 8 * 520));
        v4u w; w.x = (unsigned short)lo[0] | ((unsigned)(unsigned short)lo[1] << 16); w.y = (unsigned short)lo[2] | ((unsigned)(unsigned short)lo[3] << 16);
        w.z = (unsigned short)hi2[0] | ((unsigned)(unsigned short)hi2[1] << 16); w.w = (unsigned short)hi2[2] | ((unsigned)(unsigned short)hi2[3] << 16);
        *(GAS v4u*)(VF + ((((size_t)(b * 4 + h) * 32 + kt) * 16 + dblk * 4 + s) * 64 + ln) * 8) = w; }
    __syncthreads();
}
__device__ __forceinline__ unsigned cvtpk(float lo, float hi) { typedef float f2 __attribute__((ext_vector_type(2))); typedef __bf16 b2 __attribute__((ext_vector_type(2))); f2 v = {lo, hi}; b2 r = __builtin_convertvector(v, b2); return __builtin_bit_cast(unsigned, r); }
typedef float f32x4m __attribute__((ext_vector_type(4)));
__device__ __forceinline__ float fast_log_sigmoid(float x) { const float e = __builtin_amdgcn_exp2f(-fabsf(x) * LOG2E); return fminf(x, 0.f) - 0.6931471805599453f * __builtin_amdgcn_logf(1.0f + e); }
__device__ __forceinline__ float ex2(float x) { return __builtin_amdgcn_exp2f(x); }
__device__ __forceinline__ void gla_stage_wd(Ctx& C, int l, int h) {
    LAS float* wd = (LAS float*)(C.scr - SCR_OFF + RST_OFF);
    for (int i = C.tid; i < 1024; i += NT) wd[i] = C.inp(6)[l * 4096 + (i >> 6) * 256 + h * 64 + (i & 63)];
    if (C.tid < 64) wd[1024 + C.tid] = C.inp(7)[l * 256 + h * 64 + C.tid];
    __syncthreads();
}
__device__ __forceinline__ void gla_cc8(Ctx& C, int l, int t0, int h, float (&cc)[8], LAS float* WT) {
    const int t = C.tid >> 3, k0 = (C.tid & 7) * 8;
    const float* zs = (const float*)(C.wsp() + WS_ZS) + (size_t)(t0 + t) * 32; const LAS float* wd = (const LAS float*)(C.scr - SCR_OFF + RST_OFF) + k0; const LAS float* bd = wd + 1024;
    float ga[16], x[8];
#pragma unroll
    for (int i = 0; i < 4; ++i) { const f32x4 v = *(const GAS f32x4*)(zs + 4 * i); ga[4 * i] = v.x; ga[4 * i + 1] = v.y; ga[4 * i + 2] = v.z; ga[4 * i + 3] = v.w; }
    { const f32x4 a = *(const LAS f32x4*)bd, b = *(const LAS f32x4*)(bd + 4); x[0] = a.x; x[1] = a.y; x[2] = a.z; x[3] = a.w; x[4] = b.x; x[5] = b.y; x[6] = b.z; x[7] = b.w; }
#pragma unroll
    for (int r = 0; r < 16; ++r) { const f32x4 a = *(const LAS f32x4*)(wd + r * 64), b = *(const LAS f32x4*)(wd + r * 64 + 4);
        x[0] += ga[r] * a.x; x[1] += ga[r] * a.y; x[2] += ga[r] * a.z; x[3] += ga[r] * a.w; x[4] += ga[r] * b.x; x[5] += ga[r] * b.y; x[6] += ga[r] * b.z; x[7] += ga[r] * b.w; }
#pragma unroll
    for (int q = 0; q < 8; ++q) cc[q] = fast_log_sigmoid(x[q]) * (1.0f / 16.0f);
#pragma unroll
    for (int off = 8; off < 64; off <<= 1)
#pragma unroll
        for (int q = 0; q < 8; ++q) { const float nb = __shfl_up(cc[q], off); if (C.lane >= off) cc[q] += nb; }
    if (C.lane >= 56) { *(LAS f32x4*)(WT + C.wave * 64 + k0) = (f32x4){cc[0], cc[1], cc[2], cc[3]}; *(LAS f32x4*)(WT + C.wave * 64 + k0 + 4) = (f32x4){cc[4], cc[5], cc[6], cc[7]}; }
    __syncthreads();
    for (int w = 0; w < C.wave; ++w) { const f32x4 a = *(const LAS f32x4*)(WT + w * 64 + k0), b = *(const LAS f32x4*)(WT + w * 64 + k0 + 4);
        cc[0] += a.x; cc[1] += a.y; cc[2] += a.z; cc[3] += a.w; cc[4] += b.x; cc[5] += b.y; cc[6] += b.z; cc[7] += b.w; }
}
__device__ __forceinline__ void wt_prefix(const LAS float* WT, int k0, int nw, float (&s)[8]) {
#pragma unroll
    for (int q = 0; q < 8; ++q) s[q] = 0.f;
    for (int w = 0; w < nw; ++w) { const f32x4 a = *(const LAS f32x4*)(WT + w * 64 + k0), b = *(const LAS f32x4*)(WT + w * 64 + k0 + 4);
        s[0] += a.x; s[1] += a.y; s[2] += a.z; s[3] += a.w; s[4] += b.x; s[5] += b.y; s[6] += b.z; s[7] += b.w; }
}
__device__ __forceinline__ void gla_load_v(Ctx& C, const bf16* Z, int t0, int h, v4u (&w)[2]) {
#pragma unroll
    for (int i = 0; i < 2; ++i) { const int ch = C.tid + NT * i, t = ch >> 4, v8 = (ch & 15) * 8; w[i] = *(const GAS v4u*)(Z + (size_t)(t0 + t) * ZLD + Z_GV + h * 128 + v8); }
}
__device__ __forceinline__ void gla_write_v(Ctx& C, const v4u (&wv)[2], LAS unsigned short* V) {
#pragma unroll
    for (int i = 0; i < 2; ++i) { const int ch = C.tid + NT * i, t = ch >> 4, v8 = (ch & 15) * 8; *(LAS v4u*)(V + t * 136 + v8) = wv[i]; }
}
typedef short v4i16_t __attribute__((ext_vector_type(4)));
__device__ __forceinline__ bf16x8 tr_frag(const LAS unsigned short* T, int stride, int kbase, int n0, int lane) {
    const int kg = lane >> 4, i = lane & 15;
    const LAS unsigned short* p = T + (kbase + 8 * kg + (i >> 2)) * stride + n0 + 4 * (i & 3);
    const v4i16_t lo = __builtin_amdgcn_ds_read_tr16_b64_v4i16((LAS v4i16_t*)p), hi = __builtin_amdgcn_ds_read_tr16_b64_v4i16((LAS v4i16_t*)(p + 4 * stride));
    return (bf16x8){lo[0], lo[1], lo[2], lo[3], hi[0], hi[1], hi[2], hi[3]};
}
#define GLA_MFMA(a, b, c) __builtin_amdgcn_mfma_f32_16x16x32_bf16(a, b, c, 0, 0, 0)
#define GLA_FRAG(base, row, ks) (*(const LAS bf16x8*)((base) + (row) * 72 + (ks) * 32 + 8 * (C.lane >> 4)))
__device__ __forceinline__ void gla1_mfma_item(Ctx& C, int l, int unit) {
    const bf16* Z = (const bf16*)(C.wsp() + WS_Z); float* LOC = (float*)(C.wsp() + WS_LOC); float* EL = (float*)(C.wsp() + WS_ELAST);
    const int h = unit & 3, n = (unit >> 2) & 31, b = unit >> 7, t0 = b * SEQ + n * 64;
    LAS float* WT = (LAS float*)C.scr; LAS unsigned short* KMD = (LAS unsigned short*)(C.scr + 4096); LAS unsigned short* VV = (LAS unsigned short*)(C.scr + 13312);
    const int t = C.tid >> 3, k0 = (C.tid & 7) * 8;
    float cc[8], last[8], kf[8];
    const v4u kraw = *(const GAS v4u*)(Z + (size_t)(t0 + t) * ZLD + Z_GK + h * 64 + k0); v4u vraw[2]; gla_load_v(C, Z, t0, h, vraw);
    gla_cc8(C, l, t0, h, cc, WT);
    wt_prefix(WT, k0, 8, last);
    unpack8(kraw, kf);
#pragma unroll
    for (int q = 0; q < 8; ++q) kf[q] *= ex2((last[q] - cc[q]) * LOG2E);
    *(LAS v4u*)(KMD + t * 72 + k0) = pack8(kf);
    if (t == 0) { float* e = EL + unit * 64 + k0;
#pragma unroll
        for (int q = 0; q < 8; ++q) e[q] = ex2(last[q] * LOG2E); }
    { float* cs = (float*)(C.wsp() + WS_CC) + ((size_t)unit * 64 + t) * 64 + k0;
        *(GAS f32x4*)cs = (f32x4){cc[0], cc[1], cc[2], cc[3]}; *(GAS f32x4*)(cs + 4) = (f32x4){cc[4], cc[5], cc[6], cc[7]}; }
    gla_write_v(C, vraw, VV);
    __syncthreads();
    const int tm = C.wave >> 1, fr = C.lane & 15, fq = C.lane >> 4;
    const bf16x8 a0 = tr_frag(KMD, 72, 0, 16 * tm, C.lane), a1 = tr_frag(KMD, 72, 32, 16 * tm, C.lane);
#pragma unroll
    for (int i = 0; i < 4; ++i) { const int tn = 4 * (C.wave & 1) + i; f32x4 acc = {0.f, 0.f, 0.f, 0.f};
        acc = GLA_MFMA(a0, tr_frag(VV, 136, 0, 16 * tn, C.lane), acc); acc = GLA_MFMA(a1, tr_frag(VV, 136, 32, 16 * tn, C.lane), acc);
        float* o = LOC + ((size_t)unit * 64 + 16 * tm + 4 * fq) * 128 + 16 * tn + fr;
        o[0] = acc.x; o[128] = acc.y; o[256] = acc.z; o[384] = acc.w; }
    __syncthreads();
}
__device__ __forceinline__ void gla3_mfma_item(Ctx& C, int l, int unit) {
    const bf16* Z = (const bf16*)(C.wsp() + WS_Z); const float* SST = (const float*)(C.wsp() + WS_SST) + (size_t)unit * 8192; bf16* Y = (bf16*)(C.wsp() + WS_Y);
    const int h = unit & 3, n = (unit >> 2) & 31, b = unit >> 7, t0 = b * SEQ + n * 64;
    LAS float* RS = (LAS float*)(C.scr + 2048);
    LAS unsigned short* QP = (LAS unsigned short*)(C.scr + 4096); LAS unsigned short* KM = QP + 4608; LAS unsigned short* QM = KM + 4608; LAS unsigned short* KP = QM + 4608;
    LAS unsigned short* PP = KP + 4608; LAS unsigned short* VV = PP + 4608; LAS unsigned short* STD = VV + 8704; LAS float* OUT = (LAS float*)(C.scr + 84992);
    const int t = C.tid >> 3, k0 = (C.tid & 7) * 8;
    const v4u qraw = *(const GAS v4u*)(Z + (size_t)(t0 + t) * ZLD + Z_GQ + h * 64 + k0), kraw = *(const GAS v4u*)(Z + (size_t)(t0 + t) * ZLD + Z_GK + h * 64 + k0);
    v4u vraw[2]; gla_load_v(C, Z, t0, h, vraw);
    f32x4 sraw[4];
#pragma unroll
    for (int i = 0; i < 4; ++i) { const int ch = C.tid + NT * i; sraw[i] = *(const GAS f32x4*)(SST + (ch >> 5) * 128 + (ch & 31) * 4); }
    v4u graw[2];
    { const bf16* gr = Z + (size_t)(t0 + t) * ZLD + Z_GG + h * 128 + (C.tid & 7) * 16; graw[0] = *(const GAS v4u*)gr; graw[1] = *(const GAS v4u*)(gr + 8); }
    const float* CCu = (const float*)(C.wsp() + WS_CC) + (size_t)unit * 4096;
    f32x4 ccr[2], c0r[2]; float c0s[4];
    ccr[0] = *(const GAS f32x4*)(CCu + t * 64 + k0); ccr[1] = *(const GAS f32x4*)(CCu + t * 64 + k0 + 4); c0r[0] = *(const GAS f32x4*)(CCu + 31 * 64 + k0); c0r[1] = *(const GAS f32x4*)(CCu + 31 * 64 + k0 + 4);
#pragma unroll
    for (int i = 0; i < 4; ++i) c0s[i] = CCu[31 * 64 + ((C.tid + NT * i) >> 5)];
    { float qf[8], kf[8], a[8];
        const float cc[8] = {ccr[0].x, ccr[0].y, ccr[0].z, ccr[0].w, ccr[1].x, ccr[1].y, ccr[1].z, ccr[1].w}, c0[8] = {c0r[0].x, c0r[0].y, c0r[0].z, c0r[0].w, c0r[1].x, c0r[1].y, c0r[1].z, c0r[1].w};
        unpack8(qraw, qf); unpack8(kraw, kf);
        float ep[8], em[8];
#pragma unroll
        for (int q = 0; q < 8; ++q) { ep[q] = ex2((cc[q] - c0[q]) * LOG2E); em[q] = ex2((c0[q] - cc[q]) * LOG2E); qf[q] *= 0.125f; }
#pragma unroll
        for (int q = 0; q < 8; ++q) a[q] = qf[q] * ep[q];
        *(LAS v4u*)(QP + t * 72 + k0) = pack8(a);
#pragma unroll
        for (int q = 0; q < 8; ++q) a[q] = qf[q] * em[q];
        *(LAS v4u*)(QM + t * 72 + k0) = pack8(a);
#pragma unroll
        for (int q = 0; q < 8; ++q) a[q] = kf[q] * em[q];
        *(LAS v4u*)(KM + t * 72 + k0) = pack8(a);
#pragma unroll
        for (int q = 0; q < 8; ++q) a[q] = kf[q] * ep[q];
        *(LAS v4u*)(KP + t * 72 + k0) = pack8(a); }
    gla_write_v(C, vraw, VV);
#pragma unroll
    for (int i = 0; i < 4; ++i) { const int ch = C.tid + NT * i, k = ch >> 5, v4 = (ch & 31) * 4; const f32x4 s = sraw[i];
        const float e = ex2(c0s[i] * LOG2E);
        *(LAS unsigned long long*)(STD + k * 136 + v4) = (unsigned long long)pk2(s.x * e, s.y * e) | ((unsigned long long)pk2(s.z * e, s.w * e) << 32); }
    __syncthreads();
    const int tm = C.wave >> 1, fr = C.lane & 15, fq = C.lane >> 4;
    const bf16x8 qp0 = GLA_FRAG(QP, 16 * tm + fr, 0), qp1 = GLA_FRAG(QP, 16 * tm + fr, 1);
    { const bf16x8 qm0 = GLA_FRAG(QM, 16 * tm + fr, 0), qm1 = GLA_FRAG(QM, 16 * tm + fr, 1);
#pragma unroll
        for (int i = 0; i < 2; ++i) { const int tn = 2 * (C.wave & 1) + i; f32x4 s1 = {0.f, 0.f, 0.f, 0.f}, s2 = {0.f, 0.f, 0.f, 0.f};
            s1 = GLA_MFMA(qp0, GLA_FRAG(KM, 16 * tn + fr, 0), s1); s1 = GLA_MFMA(qp1, GLA_FRAG(KM, 16 * tn + fr, 1), s1);
            s2 = GLA_MFMA(qm0, GLA_FRAG(KP, 16 * tn + fr, 0), s2); s2 = GLA_MFMA(qm1, GLA_FRAG(KP, 16 * tn + fr, 1), s2);
            const int s = 16 * tn + fr;
#pragma unroll
            for (int r = 0; r < 4; ++r) { const int tt = 16 * tm + 4 * fq + r; PP[tt * 72 + s] = (unsigned short)f2bf(s <= tt ? s1[r] : s2[r]); } } }
    __syncthreads();
    f32x4 acc[4];
    { const bf16x8 p0 = GLA_FRAG(PP, 16 * tm + fr, 0), p1 = GLA_FRAG(PP, 16 * tm + fr, 1);
#pragma unroll
        for (int i = 0; i < 4; ++i) { const int tn = 4 * (C.wave & 1) + i; f32x4 a = {0.f, 0.f, 0.f, 0.f};
            a = GLA_MFMA(p0, tr_frag(VV, 136, 0, 16 * tn, C.lane), a); a = GLA_MFMA(p1, tr_frag(VV, 136, 32, 16 * tn, C.lane), a);
            a = GLA_MFMA(qp0, tr_frag(STD, 136, 0, 16 * tn, C.lane), a); a = GLA_MFMA(qp1, tr_frag(STD, 136, 32, 16 * tn, C.lane), a); acc[i] = a; } }
#pragma unroll
    for (int r = 0; r < 4; ++r) { float ss = (acc[0][r] * acc[0][r] + acc[1][r] * acc[1][r]) + (acc[2][r] * acc[2][r] + acc[3][r] * acc[3][r]);
        ss += __shfl_xor(ss, 1); ss += __shfl_xor(ss, 2); ss += __shfl_xor(ss, 4); ss += __shfl_xor(ss, 8);
        if (fr == 0) RS[(16 * tm + 4 * fq + r) * 2 + (C.wave & 1)] = ss; }
    __syncthreads();
#pragma unroll
    for (int r = 0; r < 4; ++r) { const int tt = 16 * tm + 4 * fq + r; const float rstd = 1.0f / sqrtf((RS[tt * 2] + RS[tt * 2 + 1]) * (1.0f / 128.0f) + EPS);
#pragma unroll
        for (int i = 0; i < 4; ++i) OUT[tt * 132 + 16 * (4 * (C.wave & 1) + i) + fr] = acc[i][r] * rstd; }
    __syncthreads();
    { const int v0 = (C.tid & 7) * 16; bf16* yo = Y + (size_t)(t0 + t) * DM + Y_C + h * 128 + v0; const float* og = C.inp(8) + l * 128 + v0;
#pragma unroll
        for (int hh = 0; hh < 2; ++hh) { float g[8], f8[8]; unpack8(graw[hh], g);
            const f32x4 o0 = *(const LAS f32x4*)(OUT + t * 132 + v0 + hh * 8), o1 = *(const LAS f32x4*)(OUT + t * 132 + v0 + hh * 8 + 4);
            const float ov[8] = {o0.x, o0.y, o0.z, o0.w, o1.x, o1.y, o1.z, o1.w};
#pragma unroll
            for (int q = 0; q < 8; ++q) f8[q] = ov[q] * og[hh * 8 + q] * (g[q] * __builtin_amdgcn_rcpf(1.0f + ex2(-LOG2E * g[q])));
            *(GAS v4u*)(yo + hh * 8) = pack8(f8); } }
    __syncthreads();
}
constexpr int FOX_SLOT = 33024;
constexpr size_t WS_PO = 404 * MiB, WS_ML = 420 * MiB, WS_END2 = 421 * MiB;
__device__ __forceinline__ void glds16(const void* gsrc, unsigned lds_dst) { unsigned keep;
    asm volatile("s_mov_b32 %0, m0\n\ts_mov_b32 m0, %2\n\ts_nop 0\n\tglobal_load_lds_dwordx4 %1, off\n\ts_mov_b32 m0, %0" : "=&s"(keep) : "v"(gsrc), "s"(lds_dst) : "memory"); }
__device__ __forceinline__ void glds4(const void* gsrc, unsigned lds_dst) { unsigned keep;
    asm volatile("s_mov_b32 %0, m0\n\ts_mov_b32 m0, %2\n\ts_nop 0\n\tglobal_load_lds_dword %1, off\n\ts_mov_b32 m0, %0" : "=&s"(keep) : "v"(gsrc), "s"(lds_dst) : "memory"); }
#define FOX_WAIT_BAR(N) asm volatile("s_waitcnt vmcnt(" #N ") lgkmcnt(0)\n\ts_barrier" ::: "memory")
__device__ __forceinline__ void fox_dma(const char* kf, const char* vf, const char* fb, int t, unsigned slot_lds, int wave, int lane) {
    const char* kt = kf + (size_t)t * 16384 + lane * 16; const char* vt = vf + (size_t)t * 16384 + lane * 16;
    glds16(kt + wave * 1024, (unsigned)__builtin_amdgcn_readfirstlane(slot_lds + wave * 1024));
    glds16(kt + (wave + 8) * 1024, (unsigned)__builtin_amdgcn_readfirstlane(slot_lds + (wave + 8) * 1024));
    glds16(vt + wave * 1024, (unsigned)__builtin_amdgcn_readfirstlane(slot_lds + 16384 + wave * 1024));
    glds16(vt + (wave + 8) * 1024, (unsigned)__builtin_amdgcn_readfirstlane(slot_lds + 16384 + (wave + 8) * 1024));
    glds4(fb + (size_t)t * 256 + lane * 4, (unsigned)__builtin_amdgcn_readfirstlane(slot_lds + 32768));
}
__device__ __forceinline__ void fox_seg(Ctx& C, int b, int h, int qb, int t0, int t1, int pidx) {
    const bf16* QN = (const bf16*)(C.wsp() + WS_QN); const int bh = b * 4 + h;
    const char* kf = (const char*)(C.wsp() + WS_KN) + (size_t)bh * 64 * 8192; const char* vf = (const char*)(C.wsp() + WS_VT) + (size_t)bh * 32 * 16384;
    const char* fb = (const char*)((const float*)(C.wsp() + WS_FB) + (size_t)bh * SEQ);
    const int lane = C.lane, r32 = lane & 31, hi = lane >> 5, w = C.wave, n = t1 - t0;
    LAS unsigned char* ring = C.scr; const unsigned ring_lds = (unsigned)(uintptr_t)ring;
    LAS float* WSF = (LAS float*)(ring + 3 * FOX_SLOT) + w * 32;
    const int tq0 = b * SEQ + qb * 256 + w * 32;
    bf16x8 qf[8];
#pragma unroll
    for (int ds = 0; ds < 8; ++ds) qf[ds] = *(const GAS bf16x8*)(QN + (size_t)(tq0 + r32) * 512 + h * 128 + ds * 16 + hi * 8);
    asm volatile("" ::: "memory");
    fox_dma(kf, vf, fb, t0, ring_lds, w, lane);
    if (n > 1) fox_dma(kf, vf, fb, t0 + 1, ring_lds + FOX_SLOT, w, lane);
    f32x16 o[4];
#pragma unroll
    for (int d = 0; d < 4; ++d)
#pragma unroll
        for (int r = 0; r < 16; ++r) o[d][r] = 0.f;
    float m = -1e30f, lsum = 0.f;
    const int kmax = 4 * qb + (w >> 1);
    int sc = 0;
    for (int i = 0; i < n; ++i) {
        if (i + 1 < n) FOX_WAIT_BAR(5); else FOX_WAIT_BAR(0);
        if (i + 2 < n) fox_dma(kf, vf, fb, t0 + i + 2, ring_lds + (unsigned)((sc + 2) % 3) * FOX_SLOT, w, lane);
        const int kt = t0 + i;
        if (kt <= kmax) {
            const LAS unsigned char* slot = ring + sc * FOX_SLOT + lane * 16; const LAS float* fbs = (const LAS float*)(ring + sc * FOX_SLOT + 32768);
            bf16x8 kfr[16];
#pragma unroll
            for (int ds = 0; ds < 8; ++ds) { kfr[2 * ds] = *(const LAS bf16x8*)(slot + ds * 1024); kfr[2 * ds + 1] = *(const LAS bf16x8*)(slot + (8 + ds) * 1024); }
            f32x16 p0, p1;
#pragma unroll
            for (int g4 = 0; g4 < 4; ++g4) { const f32x4 a = *(const LAS f32x4*)(fbs + 8 * g4 + 4 * hi), bq = *(const LAS f32x4*)(fbs + 32 + 8 * g4 + 4 * hi);
                p0[4 * g4] = a.x; p0[4 * g4 + 1] = a.y; p0[4 * g4 + 2] = a.z; p0[4 * g4 + 3] = a.w; p1[4 * g4] = bq.x; p1[4 * g4 + 1] = bq.y; p1[4 * g4 + 2] = bq.z; p1[4 * g4 + 3] = bq.w; }
            __builtin_amdgcn_sched_barrier(0);
#pragma unroll
            for (int ds = 0; ds < 8; ++ds) { p0 = __builtin_amdgcn_mfma_f32_32x32x16_bf16(kfr[2 * ds], qf[ds], p0, 0, 0, 0); p1 = __builtin_amdgcn_mfma_f32_32x32x16_bf16(kfr[2 * ds + 1], qf[ds], p1, 0, 0, 0); }
            __builtin_amdgcn_sched_barrier(0);
            bf16x8 va[8], vb[8];
#pragma unroll
            for (int q = 0; q < 8; ++q) va[q] = *(const LAS bf16x8*)(slot + 16384 + q * 1024);
            __builtin_amdgcn_sched_barrier(0);
            if (kt == kmax) { const int qrel = (w & 1) * 32 + r32;
#pragma unroll
                for (int r = 0; r < 16; ++r) { const int kr = (r & 3) + 8 * (r >> 2) + 4 * hi; if (kr > qrel) p0[r] = -1e30f; if (kr + 32 > qrel) p1[r] = -1e30f; } }
            float mx = fmaxf(p0[0], p1[0]);
#pragma unroll
            for (int r = 1; r < 16; ++r) mx = fmaxf(mx, fmaxf(p0[r], p1[r]));
            mx = fmaxf(mx, __shfl_xor(mx, 32));
            const float mnew = fmaxf(m, mx), f = __builtin_amdgcn_exp2f(m - mnew); m = mnew;
            float rs = 0.f;
#pragma unroll
            for (int r = 0; r < 16; ++r) { p0[r] = __builtin_amdgcn_exp2f(p0[r] - mnew); p1[r] = __builtin_amdgcn_exp2f(p1[r] - mnew); rs += p0[r] + p1[r]; }
            lsum = lsum * f + rs;
            if (!__all(f == 1.0f)) {
                if (hi == 0) WSF[r32] = f;
#pragma unroll
                for (int g4 = 0; g4 < 4; ++g4) { const f32x4 ff = *(const LAS f32x4*)(WSF + 8 * g4 + 4 * hi);
#pragma unroll
                    for (int d = 0; d < 4; ++d) { o[d][4 * g4] *= ff.x; o[d][4 * g4 + 1] *= ff.y; o[d][4 * g4 + 2] *= ff.z; o[d][4 * g4 + 3] *= ff.w; } }
            }
            u32x4v pa[4];
#pragma unroll
            for (int q = 0; q < 4; ++q) { pa[0][q] = cvtpk(p0[2 * q], p0[2 * q + 1]); pa[1][q] = cvtpk(p0[8 + 2 * q], p0[9 + 2 * q]); pa[2][q] = cvtpk(p1[2 * q], p1[2 * q + 1]); pa[3][q] = cvtpk(p1[8 + 2 * q], p1[9 + 2 * q]); }
            __builtin_amdgcn_sched_barrier(0);
#pragma unroll
            for (int q = 0; q < 8; ++q) vb[q] = *(const LAS bf16x8*)(slot + 16384 + (8 + q) * 1024);
            __builtin_amdgcn_sched_barrier(0);
#pragma unroll
            for (int d = 0; d < 2; ++d)
#pragma unroll
                for (int s = 0; s < 4; ++s) o[d] = __builtin_amdgcn_mfma_f32_32x32x16_bf16(__builtin_bit_cast(bf16x8, pa[s]), va[d * 4 + s], o[d], 0, 0, 0);
#pragma unroll
            for (int d = 0; d < 2; ++d)
#pragma unroll
                for (int s = 0; s < 4; ++s) o[d + 2] = __builtin_amdgcn_mfma_f32_32x32x16_bf16(__builtin_bit_cast(bf16x8, pa[s]), vb[d * 4 + s], o[d + 2], 0, 0, 0);
        }
        sc = (sc == 2) ? 0 : sc + 1;
    }
    lsum += __shfl_xor(lsum, 32);
    FOX_WAIT_BAR(0);
    { const float inv = lsum > 0.f ? 1.0f / lsum : 0.f; if (hi == 0) WSF[r32] = inv; }
    LAS unsigned short* stg = (LAS unsigned short*)(ring + w * 8192);
#pragma unroll
    for (int g4 = 0; g4 < 4; ++g4) { const f32x4 ww = *(const LAS f32x4*)(WSF + 8 * g4 + 4 * hi);
#pragma unroll
        for (int i = 0; i < 4; ++i) { const int q = 8 * g4 + 4 * hi + i; const float wq = i == 0 ? ww.x : i == 1 ? ww.y : i == 2 ? ww.z : ww.w;
#pragma unroll
            for (int d = 0; d < 4; ++d) stg[q * 128 + d * 32 + r32] = (unsigned short)f2bf(o[d][4 * g4 + i] * wq); } }
    bf16* dst; size_t ld;
    if (pidx < 0) { dst = (bf16*)(C.wsp() + WS_Y) + (size_t)tq0 * DM + Y_D + h * 128; ld = DM; }
    else { dst = (bf16*)(C.wsp() + WS_PO) + ((size_t)(bh * 16 + pidx) * 256 + w * 32) * 128; ld = 128;
        if (hi == 0) { float* ml = (float*)(C.wsp() + WS_ML) + ((size_t)(bh * 16 + pidx) * 256 + w * 32 + r32) * 2; __hip_atomic_store((unsigned long long*)ml, (unsigned long long)__float_as_uint(m) | ((unsigned long long)__float_as_uint(lsum) << 32), __ATOMIC_RELAXED, __HIP_MEMORY_SCOPE_AGENT); } }
#pragma unroll
    for (int i = 0; i < 8; ++i) { const int row = i * 4 + (lane >> 4), ch = lane & 15; const v4u vv = *(const LAS v4u*)(stg + row * 128 + ch * 8);
        if (pidx < 0) *(GAS v4u*)(dst + (size_t)row * ld + ch * 8) = vv; else st16_wt(dst + (size_t)row * ld + ch * 8, vv); }
    FOX_WAIT_BAR(0);
}
__device__ __forceinline__ void fox_wg(Ctx& C, int b, int h, int i) {
    const int nseg = (i == 13 || i == 15) ? 2 : 1;
    for (int s = 0; s < nseg; ++s) {
        int qb, t0, t1, pidx = i;
        if (s == 1) { qb = i == 13 ? 0 : 1; t0 = 0; t1 = i == 13 ? 4 : 8; pidx = -1; }
        else if (i < 4) { qb = 7; t0 = 8 * i; t1 = t0 + 8; }
        else if (i < 7) { qb = 6; t0 = i == 4 ? 0 : i == 5 ? 10 : 19; t1 = i == 4 ? 10 : i == 5 ? 19 : 28; }
        else if (i < 10) { qb = 5; t0 = 8 * (i - 7); t1 = t0 + 8; }
        else if (i < 12) { qb = 4; t0 = 10 * (i - 10); t1 = t0 + 10; }
        else if (i < 14) { qb = 3; t0 = i == 12 ? 0 : 10; t1 = i == 12 ? 10 : 16; }
        else { qb = 2; t0 = i == 14 ? 0 : 10; t1 = i == 14 ? 10 : 12; }
        fox_seg(C, b, h, qb, t0, t1, pidx);
    }
}
__device__ __forceinline__ void fox_combine_item(Ctx& C, int item) {
    const int bh = item / 24, r = item % 24, ui = r >> 2, chunk = r & 3, qb = 2 + ui;
    const int pb = ui == 0 ? 14 : ui == 1 ? 12 : ui == 2 ? 10 : ui == 3 ? 7 : ui == 4 ? 4 : 0, np = ui < 3 ? 2 : ui < 5 ? 3 : 4;
    const bf16* PO = (const bf16*)(C.wsp() + WS_PO); const float* ML = (const float*)(C.wsp() + WS_ML); bf16* Y = (bf16*)(C.wsp() + WS_Y);
    const int row = chunk * 64 + (C.tid >> 3), col0 = (C.tid & 7) * 16;
    float mm[4], ll[4], ms = -1e30f;
#pragma unroll
    for (int p = 0; p < 4; ++p) { if (p < np) { const float* ml = ML + ((size_t)(bh * 16 + pb + p) * 256 + row) * 2; mm[p] = ml[0]; ll[p] = ml[1]; } else { mm[p] = -1e30f; ll[p] = 0.f; } ms = fmaxf(ms, mm[p]); }
    float L = 0.f;
#pragma unroll
    for (int p = 0; p < 4; ++p) { ll[p] *= __builtin_amdgcn_exp2f(mm[p] - ms); L += ll[p]; }
    const float invL = 1.0f / L; float acc[16];
#pragma unroll
    for (int q = 0; q < 16; ++q) acc[q] = 0.f;
#pragma unroll
    for (int p = 0; p < 4; ++p) { if (p < np) { const bf16* po = PO + ((size_t)(bh * 16 + pb + p) * 256 + row) * 128 + col0; const float wgt = ll[p] * invL; float a[8], bq[8];
        unpack8(*(const GAS v4u*)po, a); unpack8(*(const GAS v4u*)(po + 8), bq);
#pragma unroll
        for (int q = 0; q < 8; ++q) { acc[q] += wgt * a[q]; acc[8 + q] += wgt * bq[q]; } } }
    bf16* yo = Y + (size_t)((bh >> 2) * SEQ + qb * 256 + row) * DM + Y_D + (bh & 3) * 128 + col0; float f8[8];
#pragma unroll
    for (int hh = 0; hh < 2; ++hh) {
#pragma unroll
        for (int q = 0; q < 8; ++q) f8[q] = acc[hh * 8 + q];
        *(GAS v4u*)(yo + hh * 8) = pack8(f8); }
}
#define FOX_UNIT fox_mfma_unit
#define GLA1_ITEM gla1_mfma_item
#define GLA3_ITEM gla3_mfma_item
#ifndef WGM_IN
#define WGM_IN 2
#endif
#ifndef WGM_GU
#define WGM_GU 2
#endif
#ifndef WGM_OUT
#define WGM_OUT 2
#endif
#ifndef WGM_DN
#define WGM_DN 2
#endif
#define ITEM_CTX() do { int t_ = C.tid; asm volatile("" : "+v"(t_)); C.tid = t_; C.lane = t_ & 63; } while (0)
__device__ __forceinline__ Ctx mk_ctx(LAS unsigned char* ldsbase) {
    Ctx C; KArgs ka = (KArgs)__builtin_amdgcn_kernarg_segment_ptr(); asm volatile("" : "+s"(ka)); C.ka = ka;
    int tid = threadIdx.x; asm volatile("" : "+v"(tid)); int G = gridDim.x, bid = blockIdx.x; asm volatile("" : "+s"(G), "+s"(bid));
    C.scr = ldsbase + SCR_OFF; C.tid = tid; C.lane = tid & 63; C.wave = __builtin_amdgcn_readfirstlane(tid >> 6); C.G = G; C.bid = bid; return C;
}
__global__ void __launch_bounds__(NT, 2) trunk_fwd(Args args_unused) {
    extern __shared__ __attribute__((aligned(16))) unsigned char lds[];
    volatile LAS unsigned* MISC = (volatile LAS unsigned*)((LAS unsigned char*)lds + MISC_OFF);
    for (int u = threadIdx.x; u < SCR_OFF / 4; u += NT) MISC[u] = 0u;
    __syncthreads();
    int ph_lo, ph_hi; XcdBarrier bar;
    { Ctx C = mk_ctx((LAS unsigned char*)lds); ph_lo = C.k()->ph_lo; ph_hi = C.k()->ph_hi;
      bar.bar = (unsigned*)((gu32*)(C.wsp() + WS_CTL) + CW_BAR); bar.x = 0; bar.st = nullptr;
      if (ph_hi - ph_lo > 1) bar = xcd_barrier_post((unsigned*)((gu32*)(C.wsp() + WS_CTL) + CW_BAR), MISC + 8); }
    PG8_LAS unsigned char* ring = (PG8_LAS unsigned char*)lds + SCR_OFF;

#ifndef REP_MASK
#define REP_MASK 0
#endif
    for (int ph = ph_lo; ph < ph_hi; ++ph)
    for (int rep = 0; rep < (REP_MASK != 0 && ((REP_MASK >> (ph == 0 ? 0 : 1 + (ph - 1) % 7)) & 1) ? 2 : 1); ++rep) {
        if (ph > 0 && (ph - 1) % 7 == 3) continue;
        int l = (ph - 1) / 7, sub = ph == 0 ? -1 : (ph - 1) % 7; asm volatile("" : "+s"(l), "+s"(sub));
        Ctx C = mk_ctx((LAS unsigned char*)lds);
        if (sub < 0) {
            p0_prologue(C);
        } else if (sub == 0) {
            unsigned char* ws = C.wsp();
            pg8::Gemm g{(const bf16*)(ws + WS_XB), (const bf16*)(ws + WS_WIN + l * WIN_BYTES), M, ZN, DM}; pg8::StaticOrder S; S.init(M, ZN, C.G, C.bid, WGM_IN);
            rstd_table(C, (const unsigned long long*)(ws + WS_SSQ) + (size_t)(2 * l) * M);
            pg8::EpiZ E{(bf16*)(ws + WS_Z), (float*)(ws + WS_ZS), (const PG8_LAS float*)((PG8_LAS unsigned char*)lds + RST_OFF)};
            pg8::gemm_phase<pg8::EpiZ, pg8::StaticOrder, true, true>(ring, g, S, E);
#ifndef CV_ALL_IN_PROLOGUE
            if (l == 0) convert_in_tail(C, (M / 256) * (ZN / 256), CV_FIRST + I_GU, CV_PER_LAYER);
            else convert_in_tail(C, (M / 256) * (ZN / 256), CV_PER_LAYER + CV_FIRST + I_GU, 2 * CV_PER_LAYER);
#endif
        } else if (sub == 1) {
            gla_stage_wd(C, l, C.bid & 3);
            for (int it = C.bid; it < 1040; it += C.G) {
                ITEM_CTX();
                if (it < 512) GLA1_ITEM(C, l, it);
                else if (it < 640) conv_item(C, l, it - 512);
                else if (it < 768) pool_item(C, it - 640);
                else if (it < 896) vtprep_item(C, it - 768);
                else if (it < 1024) foxprep_item(C, l, it - 896);
                else fscan_item(C, l, it - 1024);
            }
        } else if (sub == 2) {
            gu32* scan_cnt = (gu32*)(C.wsp() + WS_CTL) + CW_SCAN + 64 * l;
            for (int it = C.bid; it < 256; it += C.G) { ITEM_CTX(); gla_scan_item(C, it); }
            asm volatile("s_waitcnt vmcnt(0)" ::: "memory"); __syncthreads();
            if (C.tid == 0) __hip_atomic_fetch_add(scan_cnt, 1u, __ATOMIC_RELAXED, __HIP_MEMORY_SCOPE_AGENT);
            for (int it = C.bid; it < 256; it += C.G) { ITEM_CTX(); const int v = (it & 7) * 32 + (it >> 3), bh = v >> 4; fox_wg(C, bh >> 2, bh & 3, v & 15); }
            gu32* fox_cnt = (gu32*)(C.wsp() + WS_CTL) + CW_SCAN + 1024 + 64 * l;
            asm volatile("s_waitcnt vmcnt(0)" ::: "memory"); __syncthreads();
            if (C.tid == 0) __hip_atomic_fetch_add(fox_cnt, 1u, __ATOMIC_RELAXED, __HIP_MEMORY_SCOPE_AGENT);
            if (C.tid == 0) { unsigned sp = 0;
                while (__hip_atomic_load(scan_cnt, __ATOMIC_RELAXED, __HIP_MEMORY_SCOPE_AGENT) < (unsigned)(C.G < 256 ? C.G : 256)) { __builtin_amdgcn_s_sleep(2); if (++sp > (1u << 22)) break; }
                __builtin_amdgcn_fence(__ATOMIC_ACQUIRE, "agent"); asm volatile("s_waitcnt vmcnt(0)" ::: "memory"); }
            __syncthreads();
            for (int it = C.bid; it < 512; it += C.G) { ITEM_CTX(); GLA3_ITEM(C, l, it); }
            if (C.tid == 0) { unsigned sp = 0;
                while (__hip_atomic_load(fox_cnt, __ATOMIC_RELAXED, __HIP_MEMORY_SCOPE_AGENT) < (unsigned)(C.G < 256 ? C.G : 256)) { __builtin_amdgcn_s_sleep(2); if (++sp > (1u << 22)) break; }
                __builtin_amdgcn_fence(__ATOMIC_ACQUIRE, "agent"); asm volatile("s_waitcnt vmcnt(0)" ::: "memory"); }
            __syncthreads();
            for (int it = C.bid; it < 384; it += C.G) { ITEM_CTX(); fox_combine_item(C, it); }
        } else if (sub == 3) {
        } else if (sub == 5) {
            unsigned char* ws = C.wsp();
            pg8::Gemm g{(const bf16*)(ws + WS_XB), (const bf16*)(ws + WS_WGU + l * WGU_BYTES), M, GUN, DM}; pg8::StaticOrder S; S.init(M, GUN, C.G, C.bid, WGM_GU);
            rstd_table(C, (const unsigned long long*)(ws + WS_SSQ) + (size_t)(2 * l + 1) * M);
            pg8::EpiSwiglu E{(bf16*)(ws + WS_H), (const PG8_LAS float*)((PG8_LAS unsigned char*)lds + RST_OFF)};
            pg8::gemm_phase<pg8::EpiSwiglu, pg8::StaticOrder, true, true>(ring, g, S, E);
            warm_in_tail(C, (M / 256) * (GUN / 256), C.wsp() + WS_WDN + l * WDN_BYTES, WDN_BYTES);
#ifndef CV_ALL_IN_PROLOGUE
            if (l == 0) convert_in_tail(C, (M / 256) * (GUN / 256), CV_PER_LAYER, CV_PER_LAYER + I_IN + I_TAIL + I_POOL);
#endif
        } else {
            unsigned char* ws = C.wsp(); const bool dn = sub == 6;
            pg8::Gemm g{(const bf16*)(ws + (dn ? WS_H : WS_Y)), (const bf16*)(ws + (dn ? WS_WDN + l * WDN_BYTES : WS_WOUT + l * WOUT_BYTES)), M, DM, dn ? DFF : DM};
            pg8::StaticOrder S; S.init(M, DM, C.G, C.bid, dn ? WGM_DN : WGM_OUT);
            const int fin = (dn && l + 1 == DEPTH) ? 1 : 0;
            pg8::EpiRes E{C.outp(), (bf16*)(ws + WS_XB), (unsigned long long*)(ws + WS_SSQ) + (size_t)(dn ? 2 * l + 2 : 2 * l + 1) * M, fin ? 0 : 1, fin, (PG8_LAS unsigned char*)lds + RST_OFF};
            pg8::gemm_phase<pg8::EpiRes, pg8::StaticOrder, false, true>(ring, g, S, E);
        }
        if (ph + 1 < ph_hi || rep == 0 && REP_MASK != 0) xcd_barrier(bar);
    }
}

extern "C" void kernel_launch(void* const* d_in, const int* in_sizes, int n_in, void* d_out, int out_size, void* d_ws, size_t ws_size, hipStream_t stream) {
    static int grid = 0;
    if (grid == 0) {
        if (n_in != 17 || in_sizes[0] != M * DM || out_size != M * DM || ws_size < WS_END2) { fprintf(stderr, "kernel_launch: unexpected shapes (n_in %d, in0 %d, out %d, ws %zu); nothing launched\n", n_in, n_in > 0 ? in_sizes[0] : -1, out_size, ws_size); grid = -1; return; }
        int dev = 0, cus = 0, per_cu = 0;
        if (hipGetDevice(&dev) != hipSuccess || hipDeviceGetAttribute(&cus, hipDeviceAttributeMultiprocessorCount, dev) != hipSuccess) { fprintf(stderr, "kernel_launch: device query failed\n"); grid = -1; return; }
        if (hipFuncSetAttribute((const void*)trunk_fwd, hipFuncAttributeMaxDynamicSharedMemorySize, LDS_BYTES) != hipSuccess) { fprintf(stderr, "kernel_launch: hipFuncSetAttribute failed\n"); grid = -1; return; }
        if (hipOccupancyMaxActiveBlocksPerMultiprocessor(&per_cu, (const void*)trunk_fwd, NT, LDS_BYTES) != hipSuccess || per_cu < 1) { fprintf(stderr, "kernel_launch: occupancy query reports %d workgroups per CU\n", per_cu); }
        (void)hipGetLastError();
        grid = cus;
        if (grid != 256) { fprintf(stderr, "kernel_launch: built for a 256-CU device, found %d CUs; nothing launched\n", cus); grid = -1; return; }
    }
    if (grid < 0) return;
    if (hipMemsetAsync((char*)d_ws + WS_CTL, 0, CTL_ZERO_BYTES, stream) != hipSuccess) { fprintf(stderr, "kernel_launch: hipMemsetAsync failed\n"); return; }
    Args a{};
    for (int i = 0; i < 17; ++i) a.in[i] = (const float*)d_in[i];
    a.out = (float*)d_out; a.ws = (unsigned char*)d_ws;
    if (MK_N_LAUNCHES == 1) { a.ph_lo = 0; a.ph_hi = NPHASE; hipLaunchKernelGGL(trunk_fwd, dim3(grid), dim3(NT), LDS_BYTES, stream, a); }
    else for (int p = 0; p < NPHASE; ++p) { a.ph_lo = p; a.ph_hi = p + 1; hipLaunchKernelGGL(trunk_fwd, dim3(grid), dim3(NT), LDS_BYTES, stream, a); }
    const hipError_t le = hipPeekAtLastError();
    if (le != hipSuccess) fprintf(stderr, "kernel_launch: launch failed: %s\n", hipGetErrorName(le));
}
```

```cpp
#include <hip/hip_runtime.h>
#include <cstdio>
#include <cstdint>
namespace pg8 {
#define PG8_LAS __attribute__((address_space(3)))
typedef unsigned short bf16_t;
typedef short bf16x8 __attribute__((ext_vector_type(8)));
typedef float f32x4 __attribute__((ext_vector_type(4)));
typedef unsigned u32x4 __attribute__((ext_vector_type(4)));
constexpr int BM = 256, BK = 64, HALF = 128, HTB = HALF * BK * 2  , STAGE_BYTES = 8 * HTB, NXCD = 8, WGM = 8;

__host__ __device__ __forceinline__ int lds_byte(int r, int c) { const int st = (r >> 4) * 2 + (c >> 5), rr = r & 15, cc = c & 31, ob = rr * 64 + cc * 2; return st * 1024 + (ob ^ (((ob >> 9) & 1) << 5)); }
__host__ __device__ __forceinline__ void stage_rc(int b, int& R, int& C) { const int st = b / 1024, sb = b % 1024, swz = sb ^ (((sb >> 9) & 1) << 5); R = (st >> 1) * 16 + swz / 64; C = (st & 1) * 32 + (swz % 64) / 2; }
__host__ __device__ __forceinline__ int perm32(int rho) { const int n = rho >> 4, i = rho & 15; return 8 * (i >> 2) + 4 * n + (i & 3); }

struct Unit { int pm, pn; };
struct Gemm { const bf16_t* A; const bf16_t* Bt; int M, N, K; };

struct StaticOrder {
    int nM, nN, nwg, G, c, wgm;
    __host__ __device__ void init(int M, int N, int G_, int c_, int wgm_) { nM = M / BM; nN = N / BM; nwg = nM * nN; G = G_; c = c_; wgm = wgm_; }
    __host__ __device__ bool next(int i, Unit& u) const {
        const long L = (long)i * G + c; if (L >= nwg) return false;
        int wgid = (int)L; { const int q = nwg / NXCD, r = nwg % NXCD, xcd = wgid % NXCD, off = wgid / NXCD; wgid = (xcd < r ? xcd * (q + 1) : r * (q + 1) + (xcd - r) * q) + off; }
        const int nig = wgm * nN, gid = wgid / nig, fm = gid * wgm, gsz = (nM - fm) < wgm ? (nM - fm) : wgm;
        u.pm = fm + ((wgid % nig) % gsz); u.pn = (wgid % nig) / gsz; return true;
    }
    __device__ __forceinline__ void a_ready(const Unit&) const {}
    __device__ __forceinline__ void done(const Unit&) const {}
};

__device__ __forceinline__ unsigned cvt_pk_bf16(float lo, float hi) { unsigned r; asm volatile("v_cvt_pk_bf16_f32 %0, %1, %2" : "=v"(r) : "v"(lo), "v"(hi)); return r; }
typedef unsigned u32x2 __attribute__((ext_vector_type(2)));
__device__ __forceinline__ void load_rstd(const unsigned long long* ssq, int row0, float (&rs)[2][4]) {
    unsigned long long v[2][4];
#pragma unroll
    for (int ai = 0; ai < 2; ++ai)
#pragma unroll
        for (int m = 0; m < 4; ++m) v[ai][m] = ssq[row0 + ai * HALF + m * 16];
#pragma unroll
    for (int ai = 0; ai < 2; ++ai)
#pragma unroll
        for (int m = 0; m < 4; ++m) { const float s = (float)(unsigned)(v[ai][m] >> 32) * 4294967296.0f + (float)(unsigned)v[ai][m];
            rs[ai][m] = __builtin_amdgcn_rsqf(s * (1.0f / (16777216.0f * 2048.0f)) + 1e-6f); }
}
struct EpiZ {
    static constexpr bool PERM = true, AFTER_DRAIN = false;
    bf16_t* Z; float* ZS; const PG8_LAS float* rst;
    __device__ __forceinline__ void operator()(const f32x4 (&acc)[2][2][4][2], const Unit& u, int wr, int wc, int fr, int fq) const {
        const int row0 = u.pm * BM + wr * 64 + fr; float rs[2][4];
#pragma unroll
        for (int ai = 0; ai < 2; ++ai)
#pragma unroll
            for (int m = 0; m < 4; ++m) rs[ai][m] = rst[(u.pm & 3) * BM + ai * HALF + wr * 64 + m * 16 + fr];
        if (u.pn < 20) {
            const int col0 = u.pn * BM + wc * 32 + 8 * fq;
#pragma unroll
            for (int ai = 0; ai < 2; ++ai)
#pragma unroll
                for (int m = 0; m < 4; ++m) { bf16_t* rowp = Z + (size_t)(row0 + ai * HALF + m * 16) * 5120 + col0; const float r = rs[ai][m];
#pragma unroll
                    for (int bj = 0; bj < 2; ++bj) { const f32x4 v0 = acc[ai][bj][m][0] * r, v1 = acc[ai][bj][m][1] * r;
                        u32x4 w; w.x = cvt_pk_bf16(v0[0], v0[1]); w.y = cvt_pk_bf16(v0[2], v0[3]); w.z = cvt_pk_bf16(v1[0], v1[1]); w.w = cvt_pk_bf16(v1[2], v1[3]);
                        *(u32x4*)(rowp + bj * HALF) = w; } }
        } else if (wc == 0 && fq < 3) {
#pragma unroll
            for (int ai = 0; ai < 2; ++ai)
#pragma unroll
                for (int m = 0; m < 4; ++m) { float* rp = ZS + (size_t)(row0 + ai * HALF + m * 16) * 32 + 8 * fq; const float r = rs[ai][m];
                    *(f32x4*)rp = acc[ai][0][m][0] * r; *(f32x4*)(rp + 4) = acc[ai][0][m][1] * r; }
        }
    }
};
struct EpiSwiglu {
    static constexpr bool PERM = true, AFTER_DRAIN = false;
    bf16_t* H; const PG8_LAS float* rst;
    __device__ __forceinline__ void operator()(const f32x4 (&acc)[2][2][4][2], const Unit& u, int wr, int wc, int fr, int fq) const {
        const int row0 = u.pm * BM + wr * 64 + fr; float rs[2][4];
#pragma unroll
        for (int ai = 0; ai < 2; ++ai)
#pragma unroll
            for (int m = 0; m < 4; ++m) rs[ai][m] = rst[(u.pm & 3) * BM + ai * HALF + wr * 64 + m * 16 + fr];
        const int col0 = u.pn * HALF + wc * 32 + 8 * fq;
#pragma unroll
        for (int ai = 0; ai < 2; ++ai)
#pragma unroll
            for (int m = 0; m < 4; ++m) { bf16_t* rowp = H + (size_t)(row0 + ai * HALF + m * 16) * 5632 + col0; const float r = rs[ai][m];
                float hv[8];
#pragma unroll
                for (int n = 0; n < 2; ++n)
#pragma unroll
                    for (int j = 0; j < 4; ++j) { const float g = acc[ai][0][m][n][j] * r, uu = acc[ai][1][m][n][j] * r;
                        hv[4 * n + j] = g * __builtin_amdgcn_rcpf(1.0f + __builtin_amdgcn_exp2f(-1.4426950408889634f * g)) * uu; }
                u32x4 w; w.x = cvt_pk_bf16(hv[0], hv[1]); w.y = cvt_pk_bf16(hv[2], hv[3]); w.z = cvt_pk_bf16(hv[4], hv[5]); w.w = cvt_pk_bf16(hv[6], hv[7]);
                *(u32x4*)rowp = w; }
    }
};
struct EpiRes {
    static constexpr bool PERM = true, AFTER_DRAIN = true;
    float* out; bf16_t* xb; unsigned long long* ssp; int stats; int final;
    __device__ __forceinline__ void fused(f32x4 (&acc)[2][2][4][2], const Unit& u, int wr, int wc, int fr, int fq, PG8_LAS unsigned char* lds, int wid, int lane) const {
        PG8_LAS float* P = (PG8_LAS float*)lds;
        const int col0 = u.pn * BM + wc * 32 + 8 * fq;
        u32x4 pre[8][2];
#pragma unroll
        for (int gi = 0; gi < 8; ++gi) { const size_t off = (size_t)(u.pm * BM + (gi >> 2) * HALF + wr * 64 + (gi & 3) * 16 + fr) * 2048 + col0;
#pragma unroll
            for (int bj = 0; bj < 2; ++bj) pre[gi][bj] = *(const u32x4*)(xb + off + bj * HALF); }
#pragma unroll
        for (int gi = 0; gi < 8; ++gi) { const int ai = gi >> 2, m = gi & 3; const int r = ai * HALF + wr * 64 + m * 16 + fr; const size_t off = (size_t)(u.pm * BM + r) * 2048 + col0; float s = 0.f;
#pragma unroll
            for (int bj = 0; bj < 2; ++bj) { const u32x4 b = pre[gi][bj];
                const f32x4 b0 = {__uint_as_float(b.x << 16), __uint_as_float(b.x & 0xffff0000u), __uint_as_float(b.y << 16), __uint_as_float(b.y & 0xffff0000u)};
                const f32x4 b1 = {__uint_as_float(b.z << 16), __uint_as_float(b.z & 0xffff0000u), __uint_as_float(b.w << 16), __uint_as_float(b.w & 0xffff0000u)};
                const f32x4 o0 = b0 + acc[ai][bj][m][0], o1 = b1 + acc[ai][bj][m][1];
                if (final) { *(f32x4*)(out + off + bj * HALF) = o0; *(f32x4*)(out + off + bj * HALF + 4) = o1; }
                if (stats) { s += ((o0[0] * o0[0] + o0[1] * o0[1]) + (o0[2] * o0[2] + o0[3] * o0[3])) + ((o1[0] * o1[0] + o1[1] * o1[1]) + (o1[2] * o1[2] + o1[3] * o1[3]));
                    u32x4 w; w.x = cvt_pk_bf16(o0[0], o0[1]); w.y = cvt_pk_bf16(o0[2], o0[3]); w.z = cvt_pk_bf16(o1[0], o1[1]); w.w = cvt_pk_bf16(o1[2], o1[3]); *(u32x4*)(xb + off + bj * HALF) = w; } }
            if (stats) { s += __shfl_xor(s, 16); s += __shfl_xor(s, 32); if (fq == 0) P[r * 4 + wc] = s; }
        }
        if (stats) {
            asm volatile("s_waitcnt lgkmcnt(0)" ::: "memory"); __builtin_amdgcn_s_barrier(); asm volatile("" ::: "memory");
            const int tid = wid * 64 + lane;
            if (tid < 256) { const float s = (P[tid * 4 + 0] + P[tid * 4 + 1]) + (P[tid * 4 + 2] + P[tid * 4 + 3]); atomicAdd(ssp + (u.pm * BM + tid), (unsigned long long)(s * 16777216.0f)); }
        }
    }
};
template <class Epi, class Sched, bool ALIGN_EPI = false, bool SP2 = false>
__device__ __forceinline__ void gemm_phase(PG8_LAS unsigned char* lds, const Gemm g, const Sched& S, const Epi& E) {
    int tid_ = threadIdx.x; asm volatile("" : "+v"(tid_));
    const int tid = tid_, wid = __builtin_amdgcn_readfirstlane(tid >> 6), lane = tid & 63, wr = wid >> 2, wc = wid & 3, fr = lane & 15, fq = lane >> 4;
    const int K = g.K, nt = K / BK;
    unsigned voffA[2], voffB[2];
#pragma unroll
    for (int i = 0; i < 2; ++i) { int R, C; stage_rc(tid * 16 + i * 8192, R, C); const int Rb = Epi::PERM ? ((R & ~31) + perm32(R & 31)) : R;
        voffA[i] = (unsigned)(R * K + C) * 2u; voffB[i] = (unsigned)(Rb * K + C) * 2u; }
    const size_t kstep = (size_t)(BK * 2);
    const size_t hstep = (size_t)HALF * K * 2;
    const size_t tstep = 2 * hstep;
    const unsigned ldsw = (unsigned)wid * 1024u;
    const int aoff = lds_byte(wr * 64 + fr, fq * 8), boff = lds_byte(wc * 32 + fr, fq * 8);
#define PG8_SA(b, h) (((b) * 2 + (h)) * HTB)
#define PG8_SB(b, h) ((4 + (b) * 2 + (h)) * HTB)
#define PG8_STAGE(bufoff, gbase, voff) do { _Pragma("unroll") for (int _i = 0; _i < 2; ++_i) \
        __builtin_amdgcn_global_load_lds((const unsigned*)((const char*)(gbase) + (voff)[_i]), (PG8_LAS unsigned*)(lds + (bufoff) + ldsw + _i * 8192), 16, 0, 0); } while (0)
#define PG8_LDA(dst, b, h) do { _Pragma("unroll") for (int m = 0; m < 4; ++m) _Pragma("unroll") for (int k = 0; k < 2; ++k) dst[m][k] = *(const PG8_LAS bf16x8*)(lds + PG8_SA(b, h) + aoff + m * 2048 + k * 1024); } while (0)
#define PG8_LDB(dst, b, h) do { _Pragma("unroll") for (int n = 0; n < 2; ++n) _Pragma("unroll") for (int k = 0; k < 2; ++k) dst[n][k] = *(const PG8_LAS bf16x8*)(lds + PG8_SB(b, h) + boff + n * 2048 + k * 1024); } while (0)
#define PG8_MMA(ai, bj, At, Bt) do { __builtin_amdgcn_s_setprio(1); _Pragma("unroll") for (int m = 0; m < 4; ++m) _Pragma("unroll") for (int n = 0; n < 2; ++n) _Pragma("unroll") for (int k = 0; k < 2; ++k) \
        acc[ai][bj][m][n] = __builtin_amdgcn_mfma_f32_16x16x32_bf16(Bt[n][k], At[m][k], acc[ai][bj][m][n], 0, 0, 0); __builtin_amdgcn_s_setprio(0); } while (0)
#define PG8_WAIT_V(n) asm volatile("s_waitcnt vmcnt(" #n ")" ::: "memory")
#define PG8_WAIT_L(n) asm volatile("s_waitcnt lgkmcnt(" #n ")" ::: "memory")
#define PG8_BAR __builtin_amdgcn_s_barrier()
#define PG8_SCHED __builtin_amdgcn_sched_barrier(0)
    Unit cur, nxt; int ui = 0;
    if (!S.next(0, cur)) return;
    f32x4 acc[2][2][4][2];
#pragma unroll
    for (int a = 0; a < 2; ++a)
#pragma unroll
        for (int b = 0; b < 2; ++b)
#pragma unroll
            for (int m = 0; m < 4; ++m)
#pragma unroll
                for (int n = 0; n < 2; ++n) acc[a][b][m][n] = (f32x4){0.f, 0.f, 0.f, 0.f};
    bf16x8 At[4][2], B0[2][2], B1[2][2];
    const char* cA = (const char*)g.A + (size_t)cur.pm * tstep; const char* cB = (const char*)g.Bt + (size_t)cur.pn * tstep;
    S.a_ready(cur);
    if constexpr (SP2) {
        PG8_STAGE(PG8_SB(0, 0), cB, voffB); PG8_STAGE(PG8_SB(0, 1), cB + hstep, voffB); PG8_STAGE(PG8_SA(0, 0), cA, voffA); PG8_STAGE(PG8_SA(0, 1), cA + hstep, voffA);
        if (wr == 1) PG8_BAR;
        PG8_WAIT_V(2); PG8_BAR;
        PG8_STAGE(PG8_SB(1, 0), cB + kstep, voffB); PG8_STAGE(PG8_SA(1, 0), cA + kstep, voffA); PG8_STAGE(PG8_SB(1, 1), cB + hstep + kstep, voffB);
        PG8_WAIT_V(6); PG8_BAR;
    } else {
        PG8_STAGE(PG8_SB(0, 0), cB, voffB); PG8_STAGE(PG8_SA(0, 0), cA, voffA); PG8_STAGE(PG8_SB(0, 1), cB + hstep, voffB); PG8_STAGE(PG8_SA(0, 1), cA + hstep, voffA);
        if (wr == 1) PG8_BAR;
        PG8_WAIT_V(4); PG8_BAR;
        PG8_STAGE(PG8_SB(1, 0), cB + kstep, voffB); PG8_STAGE(PG8_SA(1, 0), cA + kstep, voffA); PG8_STAGE(PG8_SB(1, 1), cB + hstep + kstep, voffB);
        PG8_WAIT_V(6); PG8_BAR;
    }
    for (;;) {
        const bool has_next = S.next(ui + 1, nxt);
        const char* nA = has_next ? (const char*)g.A + (size_t)nxt.pm * tstep : cA; const char* nB = has_next ? (const char*)g.Bt + (size_t)nxt.pn * tstep : cB;
        for (int t = 0; t < nt; t += 2) {
            const bool last = (t == nt - 2);
            const char* a1 = cA + (size_t)(t + 1) * kstep;
            const char* a2 = last ? nA : cA + (size_t)(t + 2) * kstep; const char* b2 = last ? nB : cB + (size_t)(t + 2) * kstep;
            const char* a3 = a2 + kstep; const char* b3 = b2 + kstep;
            if (last && has_next) S.a_ready(nxt);
            if constexpr (SP2) {
            PG8_LDB(B0, 0, 0); PG8_LDB(B1, 0, 1); PG8_SCHED; PG8_LDA(At, 0, 0); PG8_STAGE(PG8_SA(1, 1), a1 + hstep, voffA);
            PG8_WAIT_V(8); PG8_WAIT_L(0); PG8_BAR; PG8_MMA(0, 0, At, B0); PG8_MMA(0, 1, At, B1); PG8_BAR; PG8_SCHED;
            PG8_LDA(At, 0, 1); PG8_STAGE(PG8_SB(0, 0), b2, voffB); PG8_STAGE(PG8_SB(0, 1), b2 + hstep, voffB); PG8_STAGE(PG8_SA(0, 0), a2, voffA);
            PG8_WAIT_V(8); PG8_WAIT_L(0); PG8_BAR; PG8_MMA(1, 0, At, B0); PG8_MMA(1, 1, At, B1); PG8_BAR; PG8_SCHED;
            PG8_LDB(B0, 1, 0); PG8_LDB(B1, 1, 1); PG8_SCHED; PG8_LDA(At, 1, 0); PG8_STAGE(PG8_SA(0, 1), a2 + hstep, voffA);
            PG8_WAIT_V(8); PG8_WAIT_L(0); PG8_BAR; PG8_MMA(0, 0, At, B0); PG8_MMA(0, 1, At, B1); PG8_BAR; PG8_SCHED;
            PG8_LDA(At, 1, 1); PG8_STAGE(PG8_SB(1, 0), b3, voffB); PG8_STAGE(PG8_SB(1, 1), b3 + hstep, voffB); PG8_STAGE(PG8_SA(1, 0), a3, voffA);
            PG8_WAIT_V(8); PG8_WAIT_L(0); PG8_BAR; PG8_MMA(1, 0, At, B0); PG8_MMA(1, 1, At, B1); PG8_BAR; PG8_SCHED;
            } else {
            PG8_LDB(B0, 0, 0); PG8_SCHED; PG8_LDA(At, 0, 0); PG8_STAGE(PG8_SA(1, 1), a1 + hstep, voffA);
            PG8_WAIT_L(8); PG8_BAR; PG8_WAIT_L(0); PG8_MMA(0, 0, At, B0); PG8_BAR; PG8_SCHED;
            PG8_LDB(B1, 0, 1); PG8_STAGE(PG8_SB(0, 0), b2, voffB);
            PG8_BAR; PG8_WAIT_L(0); PG8_MMA(0, 1, At, B1); PG8_BAR;
            PG8_LDA(At, 0, 1); PG8_STAGE(PG8_SA(0, 0), a2, voffA);
            PG8_BAR; PG8_WAIT_L(0); PG8_MMA(1, 0, At, B0); PG8_BAR; PG8_SCHED;
            PG8_STAGE(PG8_SB(0, 1), b2 + hstep, voffB);
            PG8_WAIT_V(6); PG8_BAR; PG8_MMA(1, 1, At, B1); PG8_BAR;
            PG8_LDB(B0, 1, 0); PG8_SCHED; PG8_LDA(At, 1, 0); PG8_STAGE(PG8_SA(0, 1), a2 + hstep, voffA);
            PG8_WAIT_L(8); PG8_BAR; PG8_WAIT_L(0); PG8_MMA(0, 0, At, B0); PG8_BAR; PG8_SCHED;
            PG8_LDB(B1, 1, 1); PG8_STAGE(PG8_SB(1, 0), b3, voffB);
            PG8_BAR; PG8_WAIT_L(0); PG8_MMA(0, 1, At, B1); PG8_BAR;
            PG8_LDA(At, 1, 1); PG8_STAGE(PG8_SA(1, 0), a3, voffA);
            PG8_BAR; PG8_WAIT_L(0); PG8_MMA(1, 0, At, B0); PG8_BAR; PG8_SCHED;
            PG8_STAGE(PG8_SB(1, 1), b3 + hstep, voffB);
            PG8_WAIT_V(6); PG8_BAR; PG8_MMA(1, 1, At, B1); PG8_BAR;
            }
        }
        if constexpr (ALIGN_EPI) { if (wr == 0) PG8_BAR; }
        if constexpr (!Epi::AFTER_DRAIN) { E(acc, cur, wr, wc, fr, fq); S.done(cur); }
        if (!has_next) break;
#pragma unroll
        for (int a = 0; a < 2; ++a)
#pragma unroll
            for (int b = 0; b < 2; ++b)
#pragma unroll
                for (int m = 0; m < 4; ++m)
#pragma unroll
                    for (int n = 0; n < 2; ++n) acc[a][b][m][n] = (f32x4){0.f, 0.f, 0.f, 0.f};
        cur = nxt; cA = nA; cB = nB; ++ui;
        if constexpr (ALIGN_EPI) { if (wr == 1) PG8_BAR; }
    }
    PG8_WAIT_V(0);
    if constexpr (!ALIGN_EPI) { if (wr == 0) PG8_BAR; }
    PG8_BAR;
    if constexpr (Epi::AFTER_DRAIN) { E.fused(acc, cur, wr, wc, fr, fq, lds, wid, lane); S.done(cur); }
#undef PG8_SA
#undef PG8_SB
#undef PG8_STAGE
#undef PG8_LDA
#undef PG8_LDB
#undef PG8_MMA
#undef PG8_WAIT_V
#undef PG8_WAIT_L
#undef PG8_BAR
#undef PG8_SCHED
}
}
#define GAS __attribute__((address_space(1)))
#define LAS __attribute__((address_space(3)))
typedef unsigned short bf16;
typedef unsigned v4u __attribute__((ext_vector_type(4)));
typedef float f32x4 __attribute__((ext_vector_type(4)));
typedef short bf16x8 __attribute__((ext_vector_type(8)));
typedef GAS unsigned gu32;
typedef GAS unsigned long long gu64;
#define RLX_AGENT __ATOMIC_RELAXED, __HIP_MEMORY_SCOPE_AGENT
#define LDS_WAIT() asm volatile("s_waitcnt lgkmcnt(0)" ::: "memory")
#define VM_WAIT() asm volatile("s_waitcnt vmcnt(0)" ::: "memory")
__device__ __forceinline__ unsigned long long rt() { return __builtin_amdgcn_s_memrealtime(); }
__device__ __forceinline__ unsigned f2bf(float f) { unsigned u = __builtin_bit_cast(unsigned, f); return (u + 0x7fffu + ((u >> 16) & 1u)) >> 16; }
__device__ __forceinline__ unsigned pk2(float lo, float hi) { return f2bf(lo) | (f2bf(hi) << 16); }

#define XB_TMO      128
#define XB_XCNT(j)  (256  + 64 * (j))
#define XB_XSUB(j)  (1280 + 64 * (j))
#define XB_XGEN(j)  (2304 + 64 * (j))
#define XB_TOP      3328
#define XB_TOPGEN   3392
#define XCD_BAR_WORDS 3456
#define XB_SPIN_CAP (1u << 18)

__device__ __forceinline__ unsigned xb_ld(unsigned* p)              { return __hip_atomic_load(p, __ATOMIC_RELAXED, __HIP_MEMORY_SCOPE_AGENT); }
__device__ __forceinline__ unsigned xb_add(unsigned* p, unsigned v) { return __hip_atomic_fetch_add(p, v, __ATOMIC_RELAXED, __HIP_MEMORY_SCOPE_AGENT); }
__device__ __forceinline__ unsigned xb_xcc_id() { return (unsigned)__builtin_amdgcn_s_getreg((3 << 11) | 20) & 0xFu; }
#define XB_SPIN(cond, bar) do { unsigned _sp = 0; while (cond) { __builtin_amdgcn_s_sleep(1); \
    if ((++_sp & 255u) == 0u) { if (xb_ld(&(bar)[XB_TMO])) break; if (_sp > XB_SPIN_CAP) { atomicAdd(&(bar)[XB_TMO], 1u); break; } } } } while (0)

struct XcdBarrier {
    unsigned* bar; unsigned x;
    volatile LAS unsigned* st;
};

__device__ __forceinline__ XcdBarrier xcd_barrier_post(unsigned* bar, volatile LAS unsigned* st) {
    XcdBarrier b; b.bar = bar; b.x = xb_xcc_id(); b.st = st;
    if (threadIdx.x == 0) (void)xb_add(&bar[XB_XCNT(b.x)], 1u);
    return b;
}
__device__ __forceinline__ void xcd_barrier_complete(unsigned* bar, unsigned x, unsigned& nloc, unsigned& nx) {
    const unsigned G = gridDim.x * gridDim.y * gridDim.z;
    unsigned sum, cnt, mine, sp = 0u;
    for (;;) {
        sum = 0u; cnt = 0u; mine = 0u;
#pragma unroll
        for (unsigned j = 0; j < 16; ++j) { const unsigned c = xb_ld(&bar[XB_XCNT(j)]); sum += c; cnt += (c > 0u) ? 1u : 0u; mine = (j == x) ? c : mine; }
        if (sum == G) break;
        __builtin_amdgcn_s_sleep(1);
        if ((++sp & 255u) == 0u) { if (xb_ld(&bar[XB_TMO])) break; if (sp > XB_SPIN_CAP) { atomicAdd(&bar[XB_TMO], 1u); break; } }
    }
    nloc = mine > 0u ? mine : 1u; nx = cnt > 0u ? cnt : 1u;
}

__device__ __forceinline__ void xcd_barrier(const XcdBarrier& b) {
    asm volatile("s_waitcnt vmcnt(0)" ::: "memory");
    __syncthreads();
    if (threadIdx.x == 0) {
        unsigned* bar = b.bar; unsigned bx = b.x; asm volatile("" : "+s"(bar), "+s"(bx));
        __builtin_amdgcn_s_waitcnt(0);
        unsigned nloc = b.st[0], nx = b.st[1];
        if (nloc == 0u) { xcd_barrier_complete(bar, bx, nloc, nx); b.st[0] = nloc; b.st[1] = nx; }
        const unsigned old = xb_add(&bar[XB_XSUB(bx)], 1u);
        const unsigned gen = old / nloc;
        if (old + 1u == (gen + 1u) * nloc) {
            __builtin_amdgcn_fence(__ATOMIC_RELEASE, "agent");
            asm volatile("s_waitcnt vmcnt(0)" ::: "memory");
            const unsigned og = xb_add(&bar[XB_TOP], 1u);
            const unsigned tg = og / nx;
            if (og + 1u == (tg + 1u) * nx) xb_add(&bar[XB_TOPGEN], 1u);
            else XB_SPIN(xb_ld(&bar[XB_TOPGEN]) == tg, bar);
            xb_add(&bar[XB_XGEN(bx)], 1u);
            __builtin_amdgcn_fence(__ATOMIC_ACQUIRE, "agent");
            asm volatile("s_waitcnt vmcnt(0)" ::: "memory");
        } else {
            XB_SPIN(xb_ld(&bar[XB_XGEN(bx)]) == gen, bar);
            __builtin_amdgcn_fence(__ATOMIC_ACQUIRE, "agent");
            asm volatile("s_waitcnt vmcnt(0)" ::: "memory");
        }
    }
    __syncthreads();
}
constexpr int NWAVES = 8, NT = NWAVES * 64;
#ifndef MK_N_LAUNCHES
#define MK_N_LAUNCHES 1
#endif
constexpr int DM = 2048, NB = 4, SEQ = 2048, M = NB * SEQ, DEPTH = 2, INC = 5140, ZLD = 5120, ZN = 5376, DFF = 5632, GUN = 2 * DFF;
constexpr int Z_CB = 0, Z_CC = 512, Z_CH = 1024, Z_PU = 1536, Z_GQ = 2048, Z_GK = 2304, Z_GV = 2560, Z_GG = 3072, Z_FQ = 3584, Z_FK = 4096, Z_FV = 4608;
constexpr int Y_A = 0, Y_B = 512, Y_C = 1024, Y_D = 1536;
constexpr float EPS = 1e-6f, LOG2E = 1.4426950408889634f;
constexpr float QSCALE = 0.08838834764831845f * 1.4426950408889634f;
constexpr int NPHASE = 1 + 7 * DEPTH;
constexpr size_t MiB = 1u << 20;
constexpr size_t WS_CTL = 0, CTL_ZERO_BYTES = 1 * MiB;
constexpr size_t WS_WIN = 2 * MiB, WIN_BYTES = (size_t)ZN * DM * 2;
constexpr size_t WS_WOUT = 44 * MiB, WOUT_BYTES = (size_t)DM * DM * 2;
constexpr size_t WS_WGU = 60 * MiB, WGU_BYTES = (size_t)GUN * DM * 2;
constexpr size_t WS_WDN = 148 * MiB, WDN_BYTES = (size_t)DM * DFF * 2;
constexpr size_t WS_XB = 192 * MiB, WS_SSP = 224 * MiB, WS_ZS = 225 * MiB, WS_FB = 226 * MiB, WS_ELAST = 227 * MiB;
constexpr size_t WS_CC = 396 * MiB;
constexpr size_t WS_QN = 228 * MiB, WS_KN = 236 * MiB, WS_VT = 244 * MiB, WS_LOC = 252 * MiB, WS_SST = 268 * MiB;
constexpr size_t WS_Z = 284 * MiB, WS_Y = 364 * MiB, WS_H = 284 * MiB, WS_END = 404 * MiB;
static_assert(WS_WIN + 2 * WIN_BYTES <= WS_WOUT && WS_WOUT + 2 * WOUT_BYTES <= WS_WGU && WS_WGU + 2 * WGU_BYTES <= WS_WDN && WS_WDN + 2 * WDN_BYTES <= WS_XB, "weight map");
static_assert(WS_Z + (size_t)M * ZLD * 2 <= WS_Y && WS_Y + (size_t)M * DM * 2 <= WS_CC && WS_H + (size_t)M * DFF * 2 <= WS_CC, "activation map");
constexpr int CW_BAR = 4096;
constexpr int CW_SCAN = 16384;
constexpr size_t WS_SSQ = 256 * 1024;
constexpr int RST_OFF = 1024 + 131072;
constexpr int MISC_OFF = 0, SCR_OFF = 1024, LDS_BYTES = 147456;

struct Args { const float* in[17]; float* out; unsigned char* ws; int ph_lo, ph_hi; };
typedef const __attribute__((address_space(4))) Args* KArgs;
typedef unsigned u32x4v __attribute__((ext_vector_type(4)));
struct Ctx {
    KArgs ka; LAS unsigned char* scr; int tid, lane, wave, G, bid;
    __device__ __forceinline__ KArgs k() const { KArgs p = ka; asm volatile("" : "+s"(p)); return p; }
    __device__ __forceinline__ const float* inp(int i) const { return k()->in[i]; }
    __device__ __forceinline__ unsigned char* wsp() const { return k()->ws; }
    __device__ __forceinline__ float* outp() const { return k()->out; }
};
__device__ __forceinline__ float bf2f(unsigned h) { return __uint_as_float(h << 16); }
__device__ __forceinline__ void unpack8(const v4u w, float (&f)[8]) {
    f[0] = __uint_as_float(w.x << 16); f[1] = __uint_as_float(w.x & 0xffff0000u); f[2] = __uint_as_float(w.y << 16); f[3] = __uint_as_float(w.y & 0xffff0000u);
    f[4] = __uint_as_float(w.z << 16); f[5] = __uint_as_float(w.z & 0xffff0000u); f[6] = __uint_as_float(w.w << 16); f[7] = __uint_as_float(w.w & 0xffff0000u);
}
__device__ __forceinline__ v4u pack8(const float (&f)[8]) { v4u w; w.x = pk2(f[0], f[1]); w.y = pk2(f[2], f[3]); w.z = pk2(f[4], f[5]); w.w = pk2(f[6], f[7]); return w; }
__device__ __forceinline__ void st16_wt(void* p, v4u v) { asm volatile("global_store_dwordx4 %0, %1, off sc1\n\ts_nop 1" :: "v"(p), "v"(v) : "memory"); }
__device__ __forceinline__ float log_sigmoid(float x) { return fminf(x, 0.f) - log1pf(expf(-fabsf(x))); }
__device__ __forceinline__ float silu(float g) { return g / (1.0f + expf(-g)); }

__device__ __forceinline__ void tr_item(const float* W, int N, int K, int k0, int ns0, bf16* WT, int nd0, const float* gain, LAS float* scr, int lane) {
    f32x4 v[16]; float g[16];
#pragma unroll
    for (int i = 0; i < 16; ++i) { const int kk = i * 4 + (lane >> 4), c = (lane & 15) * 4;
        v[i] = *(const GAS f32x4*)(W + (size_t)(k0 + kk) * N + ns0 + c); g[i] = gain ? gain[k0 + kk] : 1.0f; }
#pragma unroll
    for (int i = 0; i < 16; ++i) { const int kk = i * 4 + (lane >> 4), c = (lane & 15) * 4;
        LAS float* s = scr + kk * 65 + c; s[0] = v[i].x * g[i]; s[1] = v[i].y * g[i]; s[2] = v[i].z * g[i]; s[3] = v[i].w * g[i]; }
    LDS_WAIT(); asm volatile("" ::: "memory");
    const int c = lane & 7;
#pragma unroll
    for (int j = 0; j < 8; ++j) { const int n = j * 8 + (lane >> 3); const LAS float* s = scr + (8 * c) * 65 + n;
        v4u o; o.x = pk2(s[0 * 65], s[1 * 65]); o.y = pk2(s[2 * 65], s[3 * 65]); o.z = pk2(s[4 * 65], s[5 * 65]); o.w = pk2(s[6 * 65], s[7 * 65]);
        *(GAS v4u*)(WT + (size_t)(nd0 + n) * K + k0 + 8 * c) = o; }
    LDS_WAIT(); asm volatile("" ::: "memory");
}
__device__ __forceinline__ void tr_item_tail(const float* W, int k0, bf16* WT, const float* gain, int lane) {
    const float* wr = W + (size_t)(k0 + lane) * INC; const float g = gain[k0 + lane]; float v[20];
#pragma unroll
    for (int q = 0; q < 4; ++q) { const f32x4 a = *(const GAS f32x4*)(wr + 3584 + 4 * q); v[4 * q] = a.x * g; v[4 * q + 1] = a.y * g; v[4 * q + 2] = a.z * g; v[4 * q + 3] = a.w * g; }
    { const f32x4 a = *(const GAS f32x4*)(wr + 5136); v[16] = a.x * g; v[17] = a.y * g; v[18] = a.z * g; v[19] = a.w * g; }
#pragma unroll
    for (int j = 0; j < 20; ++j) WT[(size_t)(5120 + j) * DM + k0 + lane] = (bf16)f2bf(v[j]);
    const v4u z = {0u, 0u, 0u, 0u};
    for (int i = 0; i < 30; ++i) { const int row = 5140 + i * 8 + (lane >> 3); if (row < ZN) *(GAS v4u*)(WT + (size_t)row * DM + k0 + (lane & 7) * 8) = z; }
}
typedef float f32x16p __attribute__((ext_vector_type(16)));
__device__ __forceinline__ void pool_fold_item(const float* W, const float* pw, const float* psc, const float* gain, bf16* WT, int gi, int k0, int dq, LAS float* scr, int lane) {
#pragma unroll 4
    for (int i = 0; i < 16; ++i) { const int idx = i * 64 + lane, kk = idx >> 5, c4 = (idx & 31) * 4;
        const f32x4 v = *(const GAS f32x4*)(W + (size_t)(k0 + kk) * INC + Z_PU + gi * 128 + c4); LAS float* s = scr + kk * 129 + c4; s[0] = v.x; s[1] = v.y; s[2] = v.z; s[3] = v.w; }
    LDS_WAIT(); asm volatile("" ::: "memory");
    const int r32 = lane & 31, hi = lane >> 5;
    const float* pwg = pw + (size_t)gi * 128 * 128 + dq * 32 + r32;
    f32x16p acc;
#pragma unroll
    for (int r = 0; r < 16; ++r) acc[r] = 0.f;
#pragma unroll 8
    for (int s = 0; s < 64; ++s) { const int c = 2 * s + hi; acc = __builtin_amdgcn_mfma_f32_32x32x2f32(scr[r32 * 129 + c], pwg[c * 128], acc, 0, 0, 0); }
    const float sc = psc[gi * 128 + dq * 32 + r32];
    bf16* o = WT + (size_t)(Z_PU + gi * 128 + dq * 32 + r32) * DM + k0 + 4 * hi;
#pragma unroll
    for (int g4 = 0; g4 < 4; ++g4) { const f32x4 gk = *(const GAS f32x4*)(gain + k0 + 8 * g4 + 4 * hi);
        const unsigned lo = pk2(acc[4 * g4] * sc * gk.x, acc[4 * g4 + 1] * sc * gk.y), hi2 = pk2(acc[4 * g4 + 2] * sc * gk.z, acc[4 * g4 + 3] * sc * gk.w);
        *(GAS unsigned long long*)(o + 8 * g4) = (unsigned long long)lo | ((unsigned long long)hi2 << 32); }
    LDS_WAIT(); asm volatile("" ::: "memory");
}
__device__ __forceinline__ float wave_sum(float v) {
#pragma unroll
    for (int o = 1; o < 64; o <<= 1) v += __shfl_xor(v, o);
    return v;
}
constexpr int I_IN = 80 * 32, I_TAIL = 32, I_POOL = 4 * 64 * 4, I_OUT = 32 * 32, I_GU = 176 * 32, I_DN = 32 * 88;
constexpr int CV_PER_LAYER = I_IN + I_TAIL + I_POOL + I_OUT + I_GU + I_DN, CV_FIRST = I_IN + I_TAIL + I_POOL + I_OUT;
__device__ __forceinline__ void convert_range(Ctx& C, int lo, int hi, int slot, int nslots) {
    LAS float* scr = (LAS float*)(C.scr + C.wave * 16896);
    for (int it = lo + slot; it < hi; it += nslots) {
        const int l = it / CV_PER_LAYER; int r = it % CV_PER_LAYER;
        const float* g_mix = C.inp(1) + l * DM; const float* g_ffn = C.inp(13) + l * DM;
        const float* w_in = C.inp(2) + (size_t)l * DM * INC;
        bf16* win_t = (bf16*)(C.wsp() + WS_WIN + l * WIN_BYTES);
        if (r < I_IN) { const int nb = r / 32, kb = r % 32; const int nd0 = nb * 64;
            if (nd0 >= Z_PU && nd0 < Z_GQ) continue;
            const int ns0 = nd0 < 3584 ? nd0 : nd0 + 16;
            tr_item(w_in, INC, DM, kb * 64, ns0, win_t, nd0, g_mix, scr, C.lane); continue; }
        r -= I_IN;
        if (r < I_TAIL) { tr_item_tail(w_in, r * 64, win_t, g_mix, C.lane); continue; }
        r -= I_TAIL;
        if (r < I_POOL) { const int gi = r >> 8, kb = (r >> 2) & 63, dq = r & 3;
            pool_fold_item(w_in, C.inp(4) + (size_t)l * 4 * 128 * 128, C.inp(5) + l * 512, g_mix, win_t, gi, kb * 32, dq, scr, C.lane); continue; }
        r -= I_POOL;
        if (r < I_OUT) { const int nb = r / 32, kb = r % 32;
            tr_item(C.inp(12) + (size_t)l * DM * DM, DM, DM, kb * 64, nb * 64, (bf16*)(C.wsp() + WS_WOUT + l * WOUT_BYTES), nb * 64, nullptr, scr, C.lane); continue; }
        r -= I_OUT;
        if (r < I_GU) { const int nb = r / 32, kb = r % 32; const int nd0 = nb * 64, t = nd0 >> 8, j = nd0 & 255;
            const float* src = (j < 128 ? C.inp(14) : C.inp(15)) + (size_t)l * DM * DFF;
            tr_item(src, DFF, DM, kb * 64, t * 128 + (j & 127), (bf16*)(C.wsp() + WS_WGU + l * WGU_BYTES), nd0, g_ffn, scr, C.lane); continue; }
        r -= I_GU;
        { const int nb = r / 88, kb = r % 88;
            tr_item(C.inp(16) + (size_t)l * DFF * DM, DM, DFF, kb * 64, nb * 64, (bf16*)(C.wsp() + WS_WDN + l * WDN_BYTES), nb * 64, nullptr, scr, C.lane); }
    }
}
__device__ __forceinline__ void convert_in_tail(Ctx& C, int nunits, int lo, int hi) {
    const int rem = nunits % C.G; if (rem == 0 || C.bid < rem || lo >= hi) return;
    convert_range(C, lo, hi, (C.bid - rem) * NWAVES + C.wave, (C.G - rem) * NWAVES);
    __syncthreads();
}
__device__ __forceinline__ void rstd_table(Ctx& C, const unsigned long long* ssq) {
    LAS float* rst = (LAS float*)(C.scr - SCR_OFF + RST_OFF); const int row0 = (C.bid & 7) * 1024;
#pragma unroll
    for (int i = 0; i < 2; ++i) { const int r = C.tid + NT * i; const unsigned long long v = ssq[row0 + r];
        const float s = (float)(unsigned)(v >> 32) * 4294967296.0f + (float)(unsigned)v; rst[r] = __builtin_amdgcn_rsqf(s * (1.0f / (16777216.0f * 2048.0f)) + 1e-6f); }
    __syncthreads();
}
__device__ __forceinline__ void warm_in_tail(Ctx& C, int nunits, const void* p, size_t bytes) {
    const int rem = nunits % C.G; if (rem == 0 || C.bid < rem) return;
    const size_t nlines = bytes >> 7, slot = (size_t)(C.bid - rem) * NT + C.tid, nslots = (size_t)(C.G - rem) * NT; unsigned acc = 0u;
#pragma unroll 8
    for (size_t i = slot; i < nlines; i += nslots) acc += *(const GAS unsigned*)((const char*)p + (i << 7));
    asm volatile("" :: "v"(acc));
}
__device__ __forceinline__ void p0_prologue(Ctx& C) {
    const int gw = C.bid * NWAVES + C.wave, NGW = C.G * NWAVES;
#ifndef CV_ALL_IN_PROLOGUE
    convert_range(C, 0, CV_FIRST + I_GU, gw, NGW);
    convert_range(C, CV_PER_LAYER + I_IN + I_TAIL + I_POOL, CV_PER_LAYER + CV_FIRST + I_GU, gw, NGW);
#else
    convert_range(C, 0, DEPTH * CV_PER_LAYER, gw, NGW);
#endif
    bf16* XB = (bf16*)(C.wsp() + WS_XB); unsigned long long* SSQ = (unsigned long long*)(C.wsp() + WS_SSQ);
    for (int m = gw; m < M; m += NGW) {
        const GAS f32x4* xr = (const GAS f32x4*)(C.inp(0) + (size_t)m * DM) + C.lane; float s = 0.f;
        GAS unsigned long long* o8 = (GAS unsigned long long*)(XB + (size_t)m * DM) + C.lane;
#pragma unroll
        for (int j = 0; j < 8; ++j) { const f32x4 v = xr[64 * j]; s += (v.x * v.x + v.y * v.y) + (v.z * v.z + v.w * v.w);
            o8[64 * j] = (unsigned long long)pk2(v.x, v.y) | ((unsigned long long)pk2(v.z, v.w) << 32); }
        s = wave_sum(s);
        if (C.lane == 0) SSQ[m] = (unsigned long long)(s * 16777216.0f);
    }
}

__device__ __forceinline__ void conv_item(Ctx& C, int l, int item) {
    const bf16* Z = (const bf16*)(C.wsp() + WS_Z); bf16* Y = (bf16*)(C.wsp() + WS_Y); const float* cw = C.inp(3) + l * 1536;
    const int c0 = C.lane * 8; float w0[8], w1[8], w2[8];
#pragma unroll
    for (int i = 0; i < 8; ++i) { w0[i] = cw[c0 + i]; w1[i] = cw[512 + c0 + i]; w2[i] = cw[1024 + c0 + i]; }
    const int t0 = item * 64 + C.wave * 8, s0 = t0 & (SEQ - 1);
    v4u rc[10], rh[10], rb[8];
#pragma unroll
    for (int r = 0; r < 10; ++r) { const bool ok = s0 + r - 2 >= 0; const bf16* zr = Z + (size_t)(t0 + (ok ? r - 2 : 0)) * ZLD + c0;
        rc[r] = *(const GAS v4u*)(zr + Z_CC); rh[r] = *(const GAS v4u*)(zr + Z_CH); if (!ok) { rc[r] = (v4u){0u, 0u, 0u, 0u}; } }
#pragma unroll
    for (int i = 0; i < 8; ++i) rb[i] = *(const GAS v4u*)(Z + (size_t)(t0 + i) * ZLD + Z_CB + c0);
    float u0[8], u1[8], u2[8], a[8], b[8];
    unpack8(rc[0], a); unpack8(rh[0], b);
#pragma unroll
    for (int q = 0; q < 8; ++q) u0[q] = a[q] * b[q];
    unpack8(rc[1], a); unpack8(rh[1], b);
#pragma unroll
    for (int q = 0; q < 8; ++q) u1[q] = a[q] * b[q];
#pragma unroll
    for (int i = 0; i < 8; ++i) { unpack8(rc[i + 2], a); unpack8(rh[i + 2], b);
#pragma unroll
        for (int q = 0; q < 8; ++q) u2[q] = a[q] * b[q];
        unpack8(rb[i], a); float o[8];
#pragma unroll
        for (int q = 0; q < 8; ++q) { o[q] = a[q] * (w0[q] * u0[q] + w1[q] * u1[q] + w2[q] * u2[q]); u0[q] = u1[q]; u1[q] = u2[q]; }
        *(GAS v4u*)(Y + (size_t)(t0 + i) * DM + Y_A + c0) = pack8(o); }
}
template <int WIN> __device__ __forceinline__ void pool_wave(const bf16* Z, bf16* Y, int tfirst, int c0) {
    const int s0 = tfirst & (SEQ - 1);
    v4u rp[WIN + 7];
#pragma unroll
    for (int r = 0; r < WIN + 7; ++r) { const bool ok = s0 + r - (WIN - 1) >= 0; rp[r] = *(const GAS v4u*)(Z + (size_t)(tfirst + (ok ? r - (WIN - 1) : 0)) * ZLD + Z_PU + c0); if (!ok) rp[r] = (v4u){0u, 0u, 0u, 0u}; }
    float acc[8], a[8], b[8];
#pragma unroll
    for (int q = 0; q < 8; ++q) acc[q] = 0.f;
#pragma unroll
    for (int r = 0; r < WIN - 1; ++r) { unpack8(rp[r], a);
#pragma unroll
        for (int q = 0; q < 8; ++q) acc[q] += a[q]; }
#pragma unroll
    for (int i = 0; i < 8; ++i) { unpack8(rp[i + WIN - 1], a);
#pragma unroll
        for (int q = 0; q < 8; ++q) acc[q] += a[q];
        const int cnt = (s0 + i + 1) < WIN ? (s0 + i + 1) : WIN; const float inv = 1.0f / (float)cnt; float o[8];
#pragma unroll
        for (int q = 0; q < 8; ++q) o[q] = acc[q] * inv - a[q];
        *(GAS v4u*)(Y + (size_t)(tfirst + i) * DM + Y_B + c0) = pack8(o);
        unpack8(rp[i], b);
#pragma unroll
        for (int q = 0; q < 8; ++q) acc[q] -= b[q]; }
}
__device__ __forceinline__ void pool_item(Ctx& C, int item) {
    const bf16* Z = (const bf16*)(C.wsp() + WS_Z); bf16* Y = (bf16*)(C.wsp() + WS_Y);
    const int g = C.wave & 3, c0 = g * 128 + (C.lane & 15) * 8, tfirst = item * 64 + (C.wave >> 2) * 32 + (C.lane >> 4) * 8;
    if (g == 0) pool_wave<2>(Z, Y, tfirst, c0); else if (g == 1) pool_wave<4>(Z, Y, tfirst, c0); else if (g == 2) pool_wave<8>(Z, Y, tfirst, c0); else pool_wave<16>(Z, Y, tfirst, c0);
}
__device__ __forceinline__ void foxprep_item(Ctx& C, int l, int item) {
    const bf16* Z = (const bf16*)(C.wsp() + WS_Z); bf16* QN = (bf16*)(C.wsp() + WS_QN); bf16* KN = (bf16*)(C.wsp() + WS_KN);
    LAS unsigned short* T = (LAS unsigned short*)C.scr;
    const int t0 = item * 64, b = t0 >> 11, s0 = t0 & (SEQ - 1);
    const int d0 = (C.lane & 15) * 8; float gq[8], gk[8];
#pragma unroll
    for (int q = 0; q < 8; ++q) { gq[q] = C.inp(9)[l * 128 + d0 + q] * QSCALE; gk[q] = C.inp(10)[l * 128 + d0 + q]; }
    v4u rq[8], rk[8];
#pragma unroll
    for (int i = 0; i < 8; ++i) { const int ch = C.tid + NT * i, tok = ch >> 6, c8 = (ch & 63) * 8; const bf16* zr = Z + (size_t)(t0 + tok) * ZLD + c8;
        rq[i] = *(const GAS v4u*)(zr + Z_FQ); rk[i] = *(const GAS v4u*)(zr + Z_FK); }
#pragma unroll
    for (int i = 0; i < 8; ++i) { const int ch = C.tid + NT * i, tok = ch >> 6, c8 = (ch & 63) * 8; float a[8];
#pragma unroll
        for (int which = 0; which < 2; ++which) {
            unpack8(which ? rk[i] : rq[i], a);
            float ss = 0.f;
#pragma unroll
            for (int q = 0; q < 8; ++q) ss += a[q] * a[q];
            ss += __shfl_xor(ss, 1); ss += __shfl_xor(ss, 2); ss += __shfl_xor(ss, 4); ss += __shfl_xor(ss, 8);
            const float rstd = 1.0f / sqrtf(ss * (1.0f / 128.0f) + EPS);
#pragma unroll
            for (int q = 0; q < 8; ++q) a[q] = a[q] * rstd * (which ? gk[q] : gq[q]);
            if (which) *(LAS v4u*)(T + tok * 520 + c8) = pack8(a); else *(GAS v4u*)(QN + (size_t)(t0 + tok) * 512 + c8) = pack8(a); } }
    __syncthreads();
#pragma unroll
    for (int i = 0; i < 8; ++i) { const int oc = C.tid + NT * i, ln = oc & 63, ds = (oc >> 6) & 7, blk = (oc >> 9) & 1, h = oc >> 10;
        const v4u w = *(const LAS v4u*)(T + (blk * 32 + (ln & 31)) * 520 + h * 128 + ds * 16 + (ln >> 5) * 8);
        *(GAS v4u*)(KN + ((((size_t)(b * 4 + h) * 64 + (s0 >> 5) + blk) * 8 + ds) * 64 + ln) * 8) = w; }
    __syncthreads();
}
__device__ __forceinline__ float fls(float x) { const float e = __builtin_amdgcn_exp2f(-fabsf(x) * LOG2E); return fminf(x, 0.f) - 0.6931471805599453f * __builtin_amdgcn_logf(1.0f + e); }
__device__ __forceinline__ void fscan_item(Ctx& C, int l, int item) {
    const float* ZS = (const float*)(C.wsp() + WS_ZS); float* FB = (float*)(C.wsp() + WS_FB); LAS float* WTOT = (LAS float*)C.scr;
    const int b = item >> 2, h = item & 3; const float bf = C.inp(11)[l * 4 + h];
    const int s0 = C.tid * 4; float v[4]; float run = 0.f;
#pragma unroll
    for (int j = 0; j < 4; ++j) { run += fls(ZS[(size_t)(b * SEQ + s0 + j) * 32 + 16 + h] + bf); v[j] = run; }
    float inc = run;
#pragma unroll
    for (int o = 1; o < 64; o <<= 1) { const float nb = __shfl_up(inc, o); if (C.lane >= o) inc += nb; }
    if (C.lane == 63) WTOT[C.wave] = inc;
    __syncthreads();
    float excl = inc - run;
    for (int w = 0; w < C.wave; ++w) excl += WTOT[w];
    *(GAS f32x4*)(FB + (size_t)item * SEQ + s0) = (f32x4){-(v[0] + excl) * LOG2E, -(v[1] + excl) * LOG2E, -(v[2] + excl) * LOG2E, -(v[3] + excl) * LOG2E};
    __syncthreads();
}
__device__ __forceinline__ void gla_scan_item(Ctx& C, int item) {
    if (C.tid >= 128) return;
    const float* LOC = (const float*)(C.wsp() + WS_LOC); const float* EL = (const float*)(C.wsp() + WS_ELAST); float* SST = (float*)(C.wsp() + WS_SST);
    const int c = (item * 128 + C.tid) * 4, bh = c >> 13, kv = c & 8191, k = kv >> 7, b = bh >> 2, h = bh & 3;
    f32x4 st = {0.f, 0.f, 0.f, 0.f};
#pragma unroll
    for (int n0 = 0; n0 < 32; n0 += 16) {
        f32x4 lo[16]; float e[16];
#pragma unroll
        for (int n = 0; n < 16; ++n) { const int unit = (b * 32 + n0 + n) * 4 + h; lo[n] = *(const GAS f32x4*)(LOC + (size_t)unit * 8192 + kv); e[n] = EL[unit * 64 + k]; }
#pragma unroll
        for (int n = 0; n < 16; ++n) { const int unit = (b * 32 + n0 + n) * 4 + h; st16_wt(SST + (size_t)unit * 8192 + kv, __builtin_bit_cast(v4u, st)); st = st * e[n] + lo[n]; }
    }
}
typedef float f32x16 __attribute__((ext_vector_type(16)));
__device__ __forceinline__ void vtprep_item(Ctx& C, int item) {
    const bf16* Z = (const bf16*)(C.wsp() + WS_Z); bf16* VF = (bf16*)(C.wsp() + WS_VT);
    LAS unsigned short* T = (LAS unsigned short*)C.scr;
    const int t0 = item * 64, b = t0 >> 11, kt = (t0 & (SEQ - 1)) >> 6;
#pragma unroll
    for (int i = 0; i < 8; ++i) { const int ch = C.tid + NT * i, tok = ch >> 6, c8 = (ch & 63) * 8;
        *(LAS v4u*)(T + tok * 520 + c8) = *(const GAS v4u*)(Z + (size_t)(t0 + tok) * ZLD + Z_FV + c8); }
    __syncthreads();
#pragma unroll
    for (int i = 0; i < 8; ++i) { const int ch = C.tid + NT * i, ln = ch & 63, s = (ch >> 6) & 3, dblk = (ch >> 8) & 3, h = ch >> 10, hx = ln >> 5, li = ln & 15;
        const LAS unsigned short* p = T + (16 * s + 4 * hx + (li >> 2)) * 520 + h * 128 + dblk * 32 + 16 * ((ln >> 4) & 1) + 4 * (li & 3);
        typedef short v4s_t __attribute__((ext_vector_type(4)));
        const v4s_t lo = __builtin_amdgcn_ds_read_tr16_b64_v4i16((LAS v4s_t*)p), hi2 = __builtin_amdgcn_ds_read_tr16_b64_v4i16((LAS v4s_t*)(p + 8 * 520));
        v4u w; w.x = (unsigned short)lo[0] | ((unsigned)(unsigned short)lo[1] << 16); w.y = (unsigned short)lo[2] | ((unsigned)(unsigned short)lo[3] << 16);
        w.z = (unsigned short)hi2[0] | ((unsigned)(unsigned short)hi2[1] << 16); w.w = (unsigned short)hi2[2] | ((unsigned)(unsigned short)hi2[3] << 16);
        *(GAS v4u*)(VF + ((((size_t)(b * 4 + h) * 32 + kt) * 16 + dblk * 4 + s) * 64 + ln) * 8) = w; }
    __syncthreads();
}
__device__ __forceinline__ unsigned cvtpk(float lo, float hi) { typedef float f2 __attribute__((ext_vector_type(2))); typedef __bf16 b2 __attribute__((ext_vector_type(2))); f2 v = {lo, hi}; b2 r = __builtin_convertvector(v, b2); return __builtin_bit_cast(unsigned, r); }
typedef float f32x4m __attribute__((ext_vector_type(4)));
__device__ __forceinline__ float fast_log_sigmoid(float x) { const float e = __builtin_amdgcn_exp2f(-fabsf(x) * LOG2E); return fminf(x, 0.f) - 0.6931471805599453f * __builtin_amdgcn_logf(1.0f + e); }
__device__ __forceinline__ float ex2(float x) { return __builtin_amdgcn_exp2f(x); }
__device__ __forceinline__ void gla_stage_wd(Ctx& C, int l, int h) {
    LAS float* wd = (LAS float*)(C.scr - SCR_OFF + RST_OFF);
    for (int i = C.tid; i < 1024; i += NT) wd[i] = C.inp(6)[l * 4096 + (i >> 6) * 256 + h * 64 + (i & 63)];
    if (C.tid < 64) wd[1024 + C.tid] = C.inp(7)[l * 256 + h * 64 + C.tid];
    __syncthreads();
}
__device__ __forceinline__ void gla_cc8(Ctx& C, int l, int t0, int h, float (&cc)[8], LAS float* WT) {
    const int t = C.tid >> 3, k0 = (C.tid & 7) * 8;
    const float* zs = (const float*)(C.wsp() + WS_ZS) + (size_t)(t0 + t) * 32; const LAS float* wd = (const LAS float*)(C.scr - SCR_OFF + RST_OFF) + k0; const LAS float* bd = wd + 1024;
    float ga[16], x[8];
#pragma unroll
    for (int i = 0; i < 4; ++i) { const f32x4 v = *(const GAS f32x4*)(zs + 4 * i); ga[4 * i] = v.x; ga[4 * i + 1] = v.y; ga[4 * i + 2] = v.z; ga[4 * i + 3] = v.w; }
    { const f32x4 a = *(const LAS f32x4*)bd, b = *(const LAS f32x4*)(bd + 4); x[0] = a.x; x[1] = a.y; x[2] = a.z; x[3] = a.w; x[4] = b.x; x[5] = b.y; x[6] = b.z; x[7] = b.w; }
#pragma unroll
    for (int r = 0; r < 16; ++r) { const f32x4 a = *(const LAS f32x4*)(wd + r * 64), b = *(const LAS f32x4*)(wd + r * 64 + 4);
        x[0] += ga[r] * a.x; x[1] += ga[r] * a.y; x[2] += ga[r] * a.z; x[3] += ga[r] * a.w; x[4] += ga[r] * b.x; x[5] += ga[r] * b.y; x[6] += ga[r] * b.z; x[7] += ga[r] * b.w; }
#pragma unroll
    for (int q = 0; q < 8; ++q) cc[q] = fast_log_sigmoid(x[q]) * (1.0f / 16.0f);
#pragma unroll
    for (int off = 8; off < 64; off <<= 1)
#pragma unroll
        for (int q = 0; q < 8; ++q) { const float nb = __shfl_up(cc[q], off); if (C.lane >= off) cc[q] += nb; }
    if (C.lane >= 56) { *(LAS f32x4*)(WT + C.wave * 64 + k0) = (f32x4){cc[0], cc[1], cc[2], cc[3]}; *(LAS f32x4*)(WT + C.wave * 64 + k0 + 4) = (f32x4){cc[4], cc[5], cc[6], cc[7]}; }
    __syncthreads();
    for (int w = 0; w < C.wave; ++w) { const f32x4 a = *(const LAS f32x4*)(WT + w * 64 + k0), b = *(const LAS f32x4*)(WT + w * 64 + k0 + 4);
        cc[0] += a.x; cc[1] += a.y; cc[2] += a.z; cc[3] += a.w; cc[4] += b.x; cc[5] += b.y; cc[6] += b.z; cc[7] += b.w; }
}
__device__ __forceinline__ void wt_prefix(const LAS float* WT, int k0, int nw, float (&s)[8]) {
#pragma unroll
    for (int q = 0; q < 8; ++q) s[q] = 0.f;
    for (int w = 0; w < nw; ++w) { const f32x4 a = *(const LAS f32x4*)(WT + w * 64 + k0), b = *(const LAS f32x4*)(WT + w * 64 + k0 + 4);
        s[0] += a.x; s[1] += a.y; s[2] += a.z; s[3] += a.w; s[4] += b.x; s[5] += b.y; s[6] += b.z; s[7] += b.w; }
}
__device__ __forceinline__ void gla_load_v(Ctx& C, const bf16* Z, int t0, int h, v4u (&w)[2]) {
#pragma unroll
    for (int i = 0; i < 2; ++i) { const int ch = C.tid + NT * i, t = ch >> 4, v8 = (ch & 15) * 8; w[i] = *(const GAS v4u*)(Z + (size_t)(t0 + t) * ZLD + Z_GV + h * 128 + v8); }
}
__device__ __forceinline__ void gla_write_v(Ctx& C, const v4u (&wv)[2], LAS unsigned short* V) {
#pragma unroll
    for (int i = 0; i < 2; ++i) { const int ch = C.tid + NT * i, t = ch >> 4, v8 = (ch & 15) * 8; *(LAS v4u*)(V + t * 136 + v8) = wv[i]; }
}
typedef short v4i16_t __attribute__((ext_vector_type(4)));
__device__ __forceinline__ bf16x8 tr_frag(const LAS unsigned short* T, int stride, int kbase, int n0, int lane) {
    const int kg = lane >> 4, i = lane & 15;
    const LAS unsigned short* p = T + (kbase + 8 * kg + (i >> 2)) * stride + n0 + 4 * (i & 3);
    const v4i16_t lo = __builtin_amdgcn_ds_read_tr16_b64_v4i16((LAS v4i16_t*)p), hi = __builtin_amdgcn_ds_read_tr16_b64_v4i16((LAS v4i16_t*)(p + 4 * stride));
    return (bf16x8){lo[0], lo[1], lo[2], lo[3], hi[0], hi[1], hi[2], hi[3]};
}
#define GLA_MFMA(a, b, c) __builtin_amdgcn_mfma_f32_16x16x32_bf16(a, b, c, 0, 0, 0)
#define GLA_FRAG(base, row, ks) (*(const LAS bf16x8*)((base) + (row) * 72 + (ks) * 32 + 8 * (C.lane >> 4)))
__device__ __forceinline__ void gla1_mfma_item(Ctx& C, int l, int unit) {
    const bf16* Z = (const bf16*)(C.wsp() + WS_Z); float* LOC = (float*)(C.wsp() + WS_LOC); float* EL = (float*)(C.wsp() + WS_ELAST);
    const int h = unit & 3, n = (unit >> 2) & 31, b = unit >> 7, t0 = b * SEQ + n * 64;
    LAS float* WT = (LAS float*)C.scr; LAS unsigned short* KMD = (LAS unsigned short*)(C.scr + 4096); LAS unsigned short* VV = (LAS unsigned short*)(C.scr + 13312);
    const int t = C.tid >> 3, k0 = (C.tid & 7) * 8;
    float cc[8], last[8], kf[8];
    const v4u kraw = *(const GAS v4u*)(Z + (size_t)(t0 + t) * ZLD + Z_GK + h * 64 + k0); v4u vraw[2]; gla_load_v(C, Z, t0, h, vraw);
    gla_cc8(C, l, t0, h, cc, WT);
    wt_prefix(WT, k0, 8, last);
    unpack8(kraw, kf);
#pragma unroll
    for (int q = 0; q < 8; ++q) kf[q] *= ex2((last[q] - cc[q]) * LOG2E);
    *(LAS v4u*)(KMD + t * 72 + k0) = pack8(kf);
    if (t == 0) { float* e = EL + unit * 64 + k0;
#pragma unroll
        for (int q = 0; q < 8; ++q) e[q] = ex2(last[q] * LOG2E); }
    { float* cs = (float*)(C.wsp() + WS_CC) + ((size_t)unit * 64 + t) * 64 + k0;
        *(GAS f32x4*)cs = (f32x4){cc[0], cc[1], cc[2], cc[3]}; *(GAS f32x4*)(cs + 4) = (f32x4){cc[4], cc[5], cc[6], cc[7]}; }
    gla_write_v(C, vraw, VV);
    __syncthreads();
    const int tm = C.wave >> 1, fr = C.lane & 15, fq = C.lane >> 4;
    const bf16x8 a0 = tr_frag(KMD, 72, 0, 16 * tm, C.lane), a1 = tr_frag(KMD, 72, 32, 16 * tm, C.lane);
#pragma unroll
    for (int i = 0; i < 4; ++i) { const int tn = 4 * (C.wave & 1) + i; f32x4 acc = {0.f, 0.f, 0.f, 0.f};
        acc = GLA_MFMA(a0, tr_frag(VV, 136, 0, 16 * tn, C.lane), acc); acc = GLA_MFMA(a1, tr_frag(VV, 136, 32, 16 * tn, C.lane), acc);
        float* o = LOC + ((size_t)unit * 64 + 16 * tm + 4 * fq) * 128 + 16 * tn + fr;
        o[0] = acc.x; o[128] = acc.y; o[256] = acc.z; o[384] = acc.w; }
    __syncthreads();
}
__device__ __forceinline__ void gla3_mfma_item(Ctx& C, int l, int unit) {
    const bf16* Z = (const bf16*)(C.wsp() + WS_Z); const float* SST = (const float*)(C.wsp() + WS_SST) + (size_t)unit * 8192; bf16* Y = (bf16*)(C.wsp() + WS_Y);
    const int h = unit & 3, n = (unit >> 2) & 31, b = unit >> 7, t0 = b * SEQ + n * 64;
    LAS float* RS = (LAS float*)(C.scr + 2048);
    LAS unsigned short* QP = (LAS unsigned short*)(C.scr + 4096); LAS unsigned short* KM = QP + 4608; LAS unsigned short* QM = KM + 4608; LAS unsigned short* KP = QM + 4608;
    LAS unsigned short* PP = KP + 4608; LAS unsigned short* VV = PP + 4608; LAS unsigned short* STD = VV + 8704; LAS float* OUT = (LAS float*)(C.scr + 84992);
    const int t = C.tid >> 3, k0 = (C.tid & 7) * 8;
    const v4u qraw = *(const GAS v4u*)(Z + (size_t)(t0 + t) * ZLD + Z_GQ + h * 64 + k0), kraw = *(const GAS v4u*)(Z + (size_t)(t0 + t) * ZLD + Z_GK + h * 64 + k0);
    v4u vraw[2]; gla_load_v(C, Z, t0, h, vraw);
    f32x4 sraw[4];
#pragma unroll
    for (int i = 0; i < 4; ++i) { const int ch = C.tid + NT * i; sraw[i] = *(const GAS f32x4*)(SST + (ch >> 5) * 128 + (ch & 31) * 4); }
    v4u graw[2];
    { const bf16* gr = Z + (size_t)(t0 + t) * ZLD + Z_GG + h * 128 + (C.tid & 7) * 16; graw[0] = *(const GAS v4u*)gr; graw[1] = *(const GAS v4u*)(gr + 8); }
    const float* CCu = (const float*)(C.wsp() + WS_CC) + (size_t)unit * 4096;
    f32x4 ccr[2], c0r[2]; float c0s[4];
    ccr[0] = *(const GAS f32x4*)(CCu + t * 64 + k0); ccr[1] = *(const GAS f32x4*)(CCu + t * 64 + k0 + 4); c0r[0] = *(const GAS f32x4*)(CCu + 31 * 64 + k0); c0r[1] = *(const GAS f32x4*)(CCu + 31 * 64 + k0 + 4);
#pragma unroll
    for (int i = 0; i < 4; ++i) c0s[i] = CCu[31 * 64 + ((C.tid + NT * i) >> 5)];
    { float qf[8], kf[8], a[8];
        const float cc[8] = {ccr[0].x, ccr[0].y, ccr[0].z, ccr[0].w, ccr[1].x, ccr[1].y, ccr[1].z, ccr[1].w}, c0[8] = {c0r[0].x, c0r[0].y, c0r[0].z, c0r[0].w, c0r[1].x, c0r[1].y, c0r[1].z, c0r[1].w};
        unpack8(qraw, qf); unpack8(kraw, kf);
        float ep[8], em[8];
#pragma unroll
        for (int q = 0; q < 8; ++q) { ep[q] = ex2((cc[q] - c0[q]) * LOG2E); em[q] = ex2((c0[q] - cc[q]) * LOG2E); qf[q] *= 0.125f; }
#pragma unroll
        for (int q = 0; q < 8; ++q) a[q] = qf[q] * ep[q];
        *(LAS v4u*)(QP + t * 72 + k0) = pack8(a);
#pragma unroll
        for (int q = 0; q < 8; ++q) a[q] = qf[q] * em[q];
        *(LAS v4u*)(QM + t * 72 + k0) = pack8(a);
#pragma unroll
        for (int q = 0; q < 8; ++q) a[q] = kf[q] * em[q];
        *(LAS v4u*)(KM + t * 72 + k0) = pack8(a);
#pragma unroll
        for (int q = 0; q < 8; ++q) a[q] = kf[q] * ep[q];
        *(LAS v4u*)(KP + t * 72 + k0) = pack8(a); }
    gla_write_v(C, vraw, VV);
#pragma unroll
    for (int i = 0; i < 4; ++i) { const int ch = C.tid + NT * i, k = ch >> 5, v4 = (ch & 31) * 4; const f32x4 s = sraw[i];
        const float e = ex2(c0s[i] * LOG2E);
        *(LAS unsigned long long*)(STD + k * 136 + v4) = (unsigned long long)pk2(s.x * e, s.y * e) | ((unsigned long long)pk2(s.z * e, s.w * e) << 32); }
    __syncthreads();
    const int tm = C.wave >> 1, fr = C.lane & 15, fq = C.lane >> 4;
    const bf16x8 qp0 = GLA_FRAG(QP, 16 * tm + fr, 0), qp1 = GLA_FRAG(QP, 16 * tm + fr, 1);
    { const bf16x8 qm0 = GLA_FRAG(QM, 16 * tm + fr, 0), qm1 = GLA_FRAG(QM, 16 * tm + fr, 1);
#pragma unroll
        for (int i = 0; i < 2; ++i) { const int tn = 2 * (C.wave & 1) + i; f32x4 s1 = {0.f, 0.f, 0.f, 0.f}, s2 = {0.f, 0.f, 0.f, 0.f};
            s1 = GLA_MFMA(qp0, GLA_FRAG(KM, 16 * tn + fr, 0), s1); s1 = GLA_MFMA(qp1, GLA_FRAG(KM, 16 * tn + fr, 1), s1);
            s2 = GLA_MFMA(qm0, GLA_FRAG(KP, 16 * tn + fr, 0), s2); s2 = GLA_MFMA(qm1, GLA_FRAG(KP, 16 * tn + fr, 1), s2);
            const int s = 16 * tn + fr;
#pragma unroll
            for (int r = 0; r < 4; ++r) { const int tt = 16 * tm + 4 * fq + r; PP[tt * 72 + s] = (unsigned short)f2bf(s <= tt ? s1[r] : s2[r]); } } }
    __syncthreads();
    f32x4 acc[4];
    { const bf16x8 p0 = GLA_FRAG(PP, 16 * tm + fr, 0), p1 = GLA_FRAG(PP, 16 * tm + fr, 1);
#pragma unroll
        for (int i = 0; i < 4; ++i) { const int tn = 4 * (C.wave & 1) + i; f32x4 a = {0.f, 0.f, 0.f, 0.f};
            a = GLA_MFMA(p0, tr_frag(VV, 136, 0, 16 * tn, C.lane), a); a = GLA_MFMA(p1, tr_frag(VV, 136, 32, 16 * tn, C.lane), a);
            a = GLA_MFMA(qp0, tr_frag(STD, 136, 0, 16 * tn, C.lane), a); a = GLA_MFMA(qp1, tr_frag(STD, 136, 32, 16 * tn, C.lane), a); acc[i] = a; } }
#pragma unroll
    for (int r = 0; r < 4; ++r) { float ss = (acc[0][r] * acc[0][r] + acc[1][r] * acc[1][r]) + (acc[2][r] * acc[2][r] + acc[3][r] * acc[3][r]);
        ss += __shfl_xor(ss, 1); ss += __shfl_xor(ss, 2); ss += __shfl_xor(ss, 4); ss += __shfl_xor(ss, 8);
        if (fr == 0) RS[(16 * tm + 4 * fq + r) * 2 + (C.wave & 1)] = ss; }
    __syncthreads();
#pragma unroll
    for (int r = 0; r < 4; ++r) { const int tt = 16 * tm + 4 * fq + r; const float rstd = 1.0f / sqrtf((RS[tt * 2] + RS[tt * 2 + 1]) * (1.0f / 128.0f) + EPS);
#pragma unroll
        for (int i = 0; i < 4; ++i) OUT[tt * 132 + 16 * (4 * (C.wave & 1) + i) + fr] = acc[i][r] * rstd; }
    __syncthreads();
    { const int v0 = (C.tid & 7) * 16; bf16* yo = Y + (size_t)(t0 + t) * DM + Y_C + h * 128 + v0; const float* og = C.inp(8) + l * 128 + v0;
#pragma unroll
        for (int hh = 0; hh < 2; ++hh) { float g[8], f8[8]; unpack8(graw[hh], g);
            const f32x4 o0 = *(const LAS f32x4*)(OUT + t * 132 + v0 + hh * 8), o1 = *(const LAS f32x4*)(OUT + t * 132 + v0 + hh * 8 + 4);
            const float ov[8] = {o0.x, o0.y, o0.z, o0.w, o1.x, o1.y, o1.z, o1.w};
#pragma unroll
            for (int q = 0; q < 8; ++q) f8[q] = ov[q] * og[hh * 8 + q] * (g[q] * __builtin_amdgcn_rcpf(1.0f + ex2(-LOG2E * g[q])));
            *(GAS v4u*)(yo + hh * 8) = pack8(f8); } }
    __syncthreads();
}
constexpr int FOX_SLOT = 33024;
constexpr size_t WS_PO = 404 * MiB, WS_ML = 420 * MiB, WS_END2 = 421 * MiB;
__device__ __forceinline__ void glds16(const void* gsrc, unsigned lds_dst) { unsigned keep;
    asm volatile("s_mov_b32 %0, m0\n\ts_mov_b32 m0, %2\n\ts_nop 0\n\tglobal_load_lds_dwordx4 %1, off\n\ts_mov_b32 m0, %0" : "=&s"(keep) : "v"(gsrc), "s"(lds_dst) : "memory"); }
__device__ __forceinline__ void glds4(const void* gsrc, unsigned lds_dst) { unsigned keep;
    asm volatile("s_mov_b32 %0, m0\n\ts_mov_b32 m0, %2\n\ts_nop 0\n\tglobal_load_lds_dword %1, off\n\ts_mov_b32 m0, %0" : "=&s"(keep) : "v"(gsrc), "s"(lds_dst) : "memory"); }
#define FOX_WAIT_BAR(N) asm volatile("s_waitcnt vmcnt(" #N ") lgkmcnt(0)\n\ts_barrier" ::: "memory")
__device__ __forceinline__ void fox_dma(const char* kf, const char* vf, const char* fb, int t, unsigned slot_lds, int wave, int lane) {
    const char* kt = kf + (size_t)t * 16384 + lane * 16; const char* vt = vf + (size_t)t * 16384 + lane * 16;
    glds16(kt + wave * 1024, (unsigned)__builtin_amdgcn_readfirstlane(slot_lds + wave * 1024));
    glds16(kt + (wave + 8) * 1024, (unsigned)__builtin_amdgcn_readfirstlane(slot_lds + (wave + 8) * 1024));
    glds16(vt + wave * 1024, (unsigned)__builtin_amdgcn_readfirstlane(slot_lds + 16384 + wave * 1024));
    glds16(vt + (wave + 8) * 1024, (unsigned)__builtin_amdgcn_readfirstlane(slot_lds + 16384 + (wave + 8) * 1024));
    glds4(fb + (size_t)t * 256 + lane * 4, (unsigned)__builtin_amdgcn_readfirstlane(slot_lds + 32768));
}
__device__ __forceinline__ void fox_seg(Ctx& C, int b, int h, int qb, int t0, int t1, int pidx) {
    const bf16* QN = (const bf16*)(C.wsp() + WS_QN); const int bh = b * 4 + h;
    const char* kf = (const char*)(C.wsp() + WS_KN) + (size_t)bh * 64 * 8192; const char* vf = (const char*)(C.wsp() + WS_VT) + (size_t)bh * 32 * 16384;
    const char* fb = (const char*)((const float*)(C.wsp() + WS_FB) + (size_t)bh * SEQ);
    const int lane = C.lane, r32 = lane & 31, hi = lane >> 5, w = C.wave, n = t1 - t0;
    LAS unsigned char* ring = C.scr; const unsigned ring_lds = (unsigned)(uintptr_t)ring;
    LAS float* WSF = (LAS float*)(ring + 3 * FOX_SLOT) + w * 32;
    const int tq0 = b * SEQ + qb * 256 + w * 32;
    bf16x8 qf[8];
#pragma unroll
    for (int ds = 0; ds < 8; ++ds) qf[ds] = *(const GAS bf16x8*)(QN + (size_t)(tq0 + r32) * 512 + h * 128 + ds * 16 + hi * 8);
    asm volatile("" ::: "memory");
    fox_dma(kf, vf, fb, t0, ring_lds, w, lane);
    if (n > 1) fox_dma(kf, vf, fb, t0 + 1, ring_lds + FOX_SLOT, w, lane);
    f32x16 o[4];
#pragma unroll
    for (int d = 0; d < 4; ++d)
#pragma unroll
        for (int r = 0; r < 16; ++r) o[d][r] = 0.f;
    float m = -1e30f, lsum = 0.f;
    const int kmax = 4 * qb + (w >> 1);
    int sc = 0;
    for (int i = 0; i < n; ++i) {
        if (i + 1 < n) FOX_WAIT_BAR(5); else FOX_WAIT_BAR(0);
        if (i + 2 < n) fox_dma(kf, vf, fb, t0 + i + 2, ring_lds + (unsigned)((sc + 2) % 3) * FOX_SLOT, w, lane);
        const int kt = t0 + i;
        if (kt <= kmax) {
            const LAS unsigned char* slot = ring + sc * FOX_SLOT + lane * 16; const LAS float* fbs = (const LAS float*)(ring + sc * FOX_SLOT + 32768);
            bf16x8 kfr[16];
#pragma unroll
            for (int ds = 0; ds < 8; ++ds) { kfr[2 * ds] = *(const LAS bf16x8*)(slot + ds * 1024); kfr[2 * ds + 1] = *(const LAS bf16x8*)(slot + (8 + ds) * 1024); }
            f32x16 p0, p1;
#pragma unroll
            for (int g4 = 0; g4 < 4; ++g4) { const f32x4 a = *(const LAS f32x4*)(fbs + 8 * g4 + 4 * hi), bq = *(const LAS f32x4*)(fbs + 32 + 8 * g4 + 4 * hi);
                p0[4 * g4] = a.x; p0[4 * g4 + 1] = a.y; p0[4 * g4 + 2] = a.z; p0[4 * g4 + 3] = a.w; p1[4 * g4] = bq.x; p1[4 * g4 + 1] = bq.y; p1[4 * g4 + 2] = bq.z; p1[4 * g4 + 3] = bq.w; }
            __builtin_amdgcn_sched_barrier(0);
#pragma unroll
            for (int ds = 0; ds < 8; ++ds) { p0 = __builtin_amdgcn_mfma_f32_32x32x16_bf16(kfr[2 * ds], qf[ds], p0, 0, 0, 0); p1 = __builtin_amdgcn_mfma_f32_32x32x16_bf16(kfr[2 * ds + 1], qf[ds], p1, 0, 0, 0); }
            __builtin_amdgcn_sched_barrier(0);
            bf16x8 va[8], vb[8];
#pragma unroll
            for (int q = 0; q < 8; ++q) va[q] = *(const LAS bf16x8*)(slot + 16384 + q * 1024);
            __builtin_amdgcn_sched_barrier(0);
            if (kt == kmax) { const int qrel = (w & 1) * 32 + r32;
#pragma unroll
                for (int r = 0; r < 16; ++r) { const int kr = (r & 3) + 8 * (r >> 2) + 4 * hi; if (kr > qrel) p0[r] = -1e30f; if (kr + 32 > qrel) p1[r] = -1e30f; } }
            float mx = fmaxf(p0[0], p1[0]);
#pragma unroll
            for (int r = 1; r < 16; ++r) mx = fmaxf(mx, fmaxf(p0[r], p1[r]));
            mx = fmaxf(mx, __shfl_xor(mx, 32));
            const float mnew = fmaxf(m, mx), f = __builtin_amdgcn_exp2f(m - mnew); m = mnew;
            float rs = 0.f;
#pragma unroll
            for (int r = 0; r < 16; ++r) { p0[r] = __builtin_amdgcn_exp2f(p0[r] - mnew); p1[r] = __builtin_amdgcn_exp2f(p1[r] - mnew); rs += p0[r] + p1[r]; }
            lsum = lsum * f + rs;
            if (!__all(f == 1.0f)) {
                if (hi == 0) WSF[r32] = f;
#pragma unroll
                for (int g4 = 0; g4 < 4; ++g4) { const f32x4 ff = *(const LAS f32x4*)(WSF + 8 * g4 + 4 * hi);
#pragma unroll
                    for (int d = 0; d < 4; ++d) { o[d][4 * g4] *= ff.x; o[d][4 * g4 + 1] *= ff.y; o[d][4 * g4 + 2] *= ff.z; o[d][4 * g4 + 3] *= ff.w; } }
            }
            u32x4v pa[4];
#pragma unroll
            for (int q = 0; q < 4; ++q) { pa[0][q] = cvtpk(p0[2 * q], p0[2 * q + 1]); pa[1][q] = cvtpk(p0[8 + 2 * q], p0[9 + 2 * q]); pa[2][q] = cvtpk(p1[2 * q], p1[2 * q + 1]); pa[3][q] = cvtpk(p1[8 + 2 * q], p1[9 + 2 * q]); }
            __builtin_amdgcn_sched_barrier(0);
#pragma unroll
            for (int q = 0; q < 8; ++q) vb[q] = *(const LAS bf16x8*)(slot + 16384 + (8 + q) * 1024);
            __builtin_amdgcn_sched_barrier(0);
#pragma unroll
            for (int d = 0; d < 2; ++d)
#pragma unroll
                for (int s = 0; s < 4; ++s) o[d] = __builtin_amdgcn_mfma_f32_32x32x16_bf16(__builtin_bit_cast(bf16x8, pa[s]), va[d * 4 + s], o[d], 0, 0, 0);
#pragma unroll
            for (int d = 0; d < 2; ++d)
#pragma unroll
                for (int s = 0; s < 4; ++s) o[d + 2] = __builtin_amdgcn_mfma_f32_32x32x16_bf16(__builtin_bit_cast(bf16x8, pa[s]), vb[d * 4 + s], o[d + 2], 0, 0, 0);
        }
        sc = (sc == 2) ? 0 : sc + 1;
    }
    lsum += __shfl_xor(lsum, 32);
    FOX_WAIT_BAR(0);
    { const float inv = lsum > 0.f ? 1.0f / lsum : 0.f; if (hi == 0) WSF[r32] = inv; }
    LAS unsigned short* stg = (LAS unsigned short*)(ring + w * 8192);
#pragma unroll
    for (int g4 = 0; g4 < 4; ++g4) { const f32x4 ww = *(const LAS f32x4*)(WSF + 8 * g4 + 4 * hi);
#pragma unroll
        for (int i = 0; i < 4; ++i) { const int q = 8 * g4 + 4 * hi + i; const float wq = i == 0 ? ww.x : i == 1 ? ww.y : i == 2 ? ww.z : ww.w;
#pragma unroll
            for (int d = 0; d < 4; ++d) stg[q * 128 + d * 32 + r32] = (unsigned short)f2bf(o[d][4 * g4 + i] * wq); } }
    bf16* dst; size_t ld;
    if (pidx < 0) { dst = (bf16*)(C.wsp() + WS_Y) + (size_t)tq0 * DM + Y_D + h * 128; ld = DM; }
    else { dst = (bf16*)(C.wsp() + WS_PO) + ((size_t)(bh * 16 + pidx) * 256 + w * 32) * 128; ld = 128;
        if (hi == 0) { float* ml = (float*)(C.wsp() + WS_ML) + ((size_t)(bh * 16 + pidx) * 256 + w * 32 + r32) * 2; __hip_atomic_store((unsigned long long*)ml, (unsigned long long)__float_as_uint(m) | ((unsigned long long)__float_as_uint(lsum) << 32), __ATOMIC_RELAXED, __HIP_MEMORY_SCOPE_AGENT); } }
#pragma unroll
    for (int i = 0; i < 8; ++i) { const int row = i * 4 + (lane >> 4), ch = lane & 15; const v4u vv = *(const LAS v4u*)(stg + row * 128 + ch * 8);
        if (pidx < 0) *(GAS v4u*)(dst + (size_t)row * ld + ch * 8) = vv; else st16_wt(dst + (size_t)row * ld + ch * 8, vv); }
    FOX_WAIT_BAR(0);
}
__device__ __forceinline__ void fox_wg(Ctx& C, int b, int h, int i) {
    const int nseg = (i == 13 || i == 15) ? 2 : 1;
    for (int s = 0; s < nseg; ++s) {
        int qb, t0, t1, pidx = i;
        if (s == 1) { qb = i == 13 ? 0 : 1; t0 = 0; t1 = i == 13 ? 4 : 8; pidx = -1; }
        else if (i < 4) { qb = 7; t0 = 8 * i; t1 = t0 + 8; }
        else if (i < 7) { qb = 6; t0 = i == 4 ? 0 : i == 5 ? 10 : 19; t1 = i == 4 ? 10 : i == 5 ? 19 : 28; }
        else if (i < 10) { qb = 5; t0 = 8 * (i - 7); t1 = t0 + 8; }
        else if (i < 12) { qb = 4; t0 = 10 * (i - 10); t1 = t0 + 10; }
        else if (i < 14) { qb = 3; t0 = i == 12 ? 0 : 10; t1 = i == 12 ? 10 : 16; }
        else { qb = 2; t0 = i == 14 ? 0 : 10; t1 = i == 14 ? 10 : 12; }
        fox_seg(C, b, h, qb, t0, t1, pidx);
    }
}
__device__ __forceinline__ void fox_combine_item(Ctx& C, int item) {
    const int bh = item / 24, r = item % 24, ui = r >> 2, chunk = r & 3, qb = 2 + ui;
    const int pb = ui == 0 ? 14 : ui == 1 ? 12 : ui == 2 ? 10 : ui == 3 ? 7 : ui == 4 ? 4 : 0, np = ui < 3 ? 2 : ui < 5 ? 3 : 4;
    const bf16* PO = (const bf16*)(C.wsp() + WS_PO); const float* ML = (const float*)(C.wsp() + WS_ML); bf16* Y = (bf16*)(C.wsp() + WS_Y);
    const int row = chunk * 64 + (C.tid >> 3), col0 = (C.tid & 7) * 16;
    float mm[4], ll[4], ms = -1e30f;
#pragma unroll
    for (int p = 0; p < 4; ++p) { if (p < np) { const float* ml = ML + ((size_t)(bh * 16 + pb + p) * 256 + row) * 2; mm[p] = ml[0]; ll[p] = ml[1]; } else { mm[p] = -1e30f; ll[p] = 0.f; } ms = fmaxf(ms, mm[p]); }
    float L = 0.f;
#pragma unroll
    for (int p = 0; p < 4; ++p) { ll[p] *= __builtin_amdgcn_exp2f(mm[p] - ms); L += ll[p]; }
    const float invL = 1.0f / L; float acc[16];
#pragma unroll
    for (int q = 0; q < 16; ++q) acc[q] = 0.f;
#pragma unroll
    for (int p = 0; p < 4; ++p) { if (p < np) { const bf16* po = PO + ((size_t)(bh * 16 + pb + p) * 256 + row) * 128 + col0; const float wgt = ll[p] * invL; float a[8], bq[8];
        unpack8(*(const GAS v4u*)po, a); unpack8(*(const GAS v4u*)(po + 8), bq);
#pragma unroll
        for (int q = 0; q < 8; ++q) { acc[q] += wgt * a[q]; acc[8 + q] += wgt * bq[q]; } } }
    bf16* yo = Y + (size_t)((bh >> 2) * SEQ + qb * 256 + row) * DM + Y_D + (bh & 3) * 128 + col0; float f8[8];
#pragma unroll
    for (int hh = 0; hh < 2; ++hh) {
#pragma unroll
        for (int q = 0; q < 8; ++q) f8[q] = acc[hh * 8 + q];
        *(GAS v4u*)(yo + hh * 8) = pack8(f8); }
}
#define FOX_UNIT fox_mfma_unit
#define GLA1_ITEM gla1_mfma_item
#define GLA3_ITEM gla3_mfma_item
#ifndef WGM_IN
#define WGM_IN 2
#endif
#ifndef WGM_GU
#define WGM_GU 2
#endif
#ifndef WGM_OUT
#define WGM_OUT 2
#endif
#ifndef WGM_DN
#define WGM_DN 2
#endif
#define ITEM_CTX() do { int t_ = C.tid; asm volatile("" : "+v"(t_)); C.tid = t_; C.lane = t_ & 63; } while (0)
__device__ __forceinline__ Ctx mk_ctx(LAS unsigned char* ldsbase) {
    Ctx C; KArgs ka = (KArgs)__builtin_amdgcn_kernarg_segment_ptr(); asm volatile("" : "+s"(ka)); C.ka = ka;
    int tid = threadIdx.x; asm volatile("" : "+v"(tid)); int G = gridDim.x, bid = blockIdx.x; asm volatile("" : "+s"(G), "+s"(bid));
    C.scr = ldsbase + SCR_OFF; C.tid = tid; C.lane = tid & 63; C.wave = __builtin_amdgcn_readfirstlane(tid >> 6); C.G = G; C.bid = bid; return C;
}
__global__ void __launch_bounds__(NT, 2) trunk_fwd(Args args_unused) {
    extern __shared__ __attribute__((aligned(16))) unsigned char lds[];
    volatile LAS unsigned* MISC = (volatile LAS unsigned*)((LAS unsigned char*)lds + MISC_OFF);
    for (int u = threadIdx.x; u < SCR_OFF / 4; u += NT) MISC[u] = 0u;
    __syncthreads();
    int ph_lo, ph_hi; XcdBarrier bar;
    { Ctx C = mk_ctx((LAS unsigned char*)lds); ph_lo = C.k()->ph_lo; ph_hi = C.k()->ph_hi;
      bar.bar = (unsigned*)((gu32*)(C.wsp() + WS_CTL) + CW_BAR); bar.x = 0; bar.st = nullptr;
      if (ph_hi - ph_lo > 1) bar = xcd_barrier_post((unsigned*)((gu32*)(C.wsp() + WS_CTL) + CW_BAR), MISC + 8); }
    PG8_LAS unsigned char* ring = (PG8_LAS unsigned char*)lds + SCR_OFF;

#ifndef REP_MASK
#define REP_MASK 0
#endif
    for (int ph = ph_lo; ph < ph_hi; ++ph)
    for (int rep = 0; rep < (REP_MASK != 0 && ((REP_MASK >> (ph == 0 ? 0 : 1 + (ph - 1) % 7)) & 1) ? 2 : 1); ++rep) {
        if (ph > 0 && (ph - 1) % 7 == 3) continue;
        int l = (ph - 1) / 7, sub = ph == 0 ? -1 : (ph - 1) % 7; asm volatile("" : "+s"(l), "+s"(sub));
        Ctx C = mk_ctx((LAS unsigned char*)lds);
        if (sub < 0) {
            p0_prologue(C);
        } else if (sub == 0) {
            unsigned char* ws = C.wsp();
            pg8::Gemm g{(const bf16*)(ws + WS_XB), (const bf16*)(ws + WS_WIN + l * WIN_BYTES), M, ZN, DM}; pg8::StaticOrder S; S.init(M, ZN, C.G, C.bid, WGM_IN);
            rstd_table(C, (const unsigned long long*)(ws + WS_SSQ) + (size_t)(2 * l) * M);
            pg8::EpiZ E{(bf16*)(ws + WS_Z), (float*)(ws + WS_ZS), (const PG8_LAS float*)((PG8_LAS unsigned char*)lds + RST_OFF)};
            pg8::gemm_phase<pg8::EpiZ, pg8::StaticOrder, true, true>(ring, g, S, E);
#ifndef CV_ALL_IN_PROLOGUE
            if (l == 0) convert_in_tail(C, (M / 256) * (ZN / 256), CV_FIRST + I_GU, CV_PER_LAYER);
            else convert_in_tail(C, (M / 256) * (ZN / 256), CV_PER_LAYER + CV_FIRST + I_GU, 2 * CV_PER_LAYER);
#endif
        } else if (sub == 1) {
            gla_stage_wd(C, l, C.bid & 3);
            for (int it = C.bid; it < 1040; it += C.G) {
                ITEM_CTX();
                if (it < 512) GLA1_ITEM(C, l, it);
                else if (it < 640) conv_item(C, l, it - 512);
                else if (it < 768) pool_item(C, it - 640);
                else if (it < 896) vtprep_item(C, it - 768);
                else if (it < 1024) foxprep_item(C, l, it - 896);
                else fscan_item(C, l, it - 1024);
            }
        } else if (sub == 2) {
            gu32* scan_cnt = (gu32*)(C.wsp() + WS_CTL) + CW_SCAN + 64 * l;
            for (int it = C.bid; it < 256; it += C.G) { ITEM_CTX(); gla_scan_item(C, it); }
            asm volatile("s_waitcnt vmcnt(0)" ::: "memory"); __syncthreads();
            if (C.tid == 0) __hip_atomic_fetch_add(scan_cnt, 1u, __ATOMIC_RELAXED, __HIP_MEMORY_SCOPE_AGENT);
            for (int it = C.bid; it < 256; it += C.G) { ITEM_CTX(); const int v = (it & 7) * 32 + (it >> 3), bh = v >> 4; fox_wg(C, bh >> 2, bh & 3, v & 15); }
            gu32* fox_cnt = (gu32*)(C.wsp() + WS_CTL) + CW_SCAN + 1024 + 64 * l;
            asm volatile("s_waitcnt vmcnt(0)" ::: "memory"); __syncthreads();
            if (C.tid == 0) __hip_atomic_fetch_add(fox_cnt, 1u, __ATOMIC_RELAXED, __HIP_MEMORY_SCOPE_AGENT);
            if (C.tid == 0) { unsigned sp = 0;
                while (__hip_atomic_load(scan_cnt, __ATOMIC_RELAXED, __HIP_MEMORY_SCOPE_AGENT) < (unsigned)(C.G < 256 ? C.G : 256)) { __builtin_amdgcn_s_sleep(2); if (++sp > (1u << 22)) break; }
                __builtin_amdgcn_fence(__ATOMIC_ACQUIRE, "agent"); asm volatile("s_waitcnt vmcnt(0)" ::: "memory"); }
            __syncthreads();
            for (int it = C.bid; it < 512; it += C.G) { ITEM_CTX(); GLA3_ITEM(C, l, it); }
            if (C.tid == 0) { unsigned sp = 0;
                while (__hip_atomic_load(fox_cnt, __ATOMIC_RELAXED, __HIP_MEMORY_SCOPE_AGENT) < (unsigned)(C.G < 256 ? C.G : 256)) { __builtin_amdgcn_s_sleep(2); if (++sp > (1u << 22)) break; }
                __builtin_amdgcn_fence(__ATOMIC_ACQUIRE, "agent"); asm volatile("s_waitcnt vmcnt(0)" ::: "memory"); }
            __syncthreads();
            for (int it = C.bid; it < 384; it += C.G) { ITEM_CTX(); fox_combine_item(C, it); }
        } else if (sub == 3) {
        } else if (sub == 5) {
            unsigned char* ws = C.wsp();
            pg8::Gemm g{(const bf16*)(ws + WS_XB), (const bf16*)(ws + WS_WGU + l * WGU_BYTES), M, GUN, DM}; pg8::StaticOrder S; S.init(M, GUN, C.G, C.bid, WGM_GU);
            rstd_table(C, (const unsigned long long*)(ws + WS_SSQ) + (size_t)(2 * l + 1) * M);
            pg8::EpiSwiglu E{(bf16*)(ws + WS_H), (const PG8_LAS float*)((PG8_LAS unsigned char*)lds + RST_OFF)};
            pg8::gemm_phase<pg8::EpiSwiglu, pg8::StaticOrder, true, true>(ring, g, S, E);
            warm_in_tail(C, (M / 256) * (GUN / 256), C.wsp() + WS_WDN + l * WDN_BYTES, WDN_BYTES);
#ifndef CV_ALL_IN_PROLOGUE
            if (l == 0) convert_in_tail(C, (M / 256) * (GUN / 256), CV_PER_LAYER, CV_PER_LAYER + I_IN + I_TAIL + I_POOL);
#endif
        } else {
            unsigned char* ws = C.wsp(); const bool dn = sub == 6;
            pg8::Gemm g{(const bf16*)(ws + (dn ? WS_H : WS_Y)), (const bf16*)(ws + (dn ? WS_WDN + l * WDN_BYTES : WS_WOUT + l * WOUT_BYTES)), M, DM, dn ? DFF : DM};
            pg8::StaticOrder S; S.init(M, DM, C.G, C.bid, dn ? WGM_DN : WGM_OUT);
            const int fin = (dn && l + 1 == DEPTH) ? 1 : 0;
            pg8::EpiRes E{C.outp(), (bf16*)(ws + WS_XB), (unsigned long long*)(ws + WS_SSQ) + (size_t)(dn ? 2 * l + 2 : 2 * l + 1) * M, fin ? 0 : 1, fin};
            pg8::gemm_phase<pg8::EpiRes, pg8::StaticOrder, false, true>(ring, g, S, E);
        }
        if (ph + 1 < ph_hi || rep == 0 && REP_MASK != 0) xcd_barrier(bar);
    }
}

extern "C" void kernel_launch(void* const* d_in, const int* in_sizes, int n_in, void* d_out, int out_size, void* d_ws, size_t ws_size, hipStream_t stream) {
    static int grid = 0;
    if (grid == 0) {
        if (n_in != 17 || in_sizes[0] != M * DM || out_size != M * DM || ws_size < WS_END2) { fprintf(stderr, "kernel_launch: unexpected shapes (n_in %d, in0 %d, out %d, ws %zu); nothing launched\n", n_in, n_in > 0 ? in_sizes[0] : -1, out_size, ws_size); grid = -1; return; }
        int dev = 0, cus = 0, per_cu = 0;
        if (hipGetDevice(&dev) != hipSuccess || hipDeviceGetAttribute(&cus, hipDeviceAttributeMultiprocessorCount, dev) != hipSuccess) { fprintf(stderr, "kernel_launch: device query failed\n"); grid = -1; return; }
        if (hipFuncSetAttribute((const void*)trunk_fwd, hipFuncAttributeMaxDynamicSharedMemorySize, LDS_BYTES) != hipSuccess) { fprintf(stderr, "kernel_launch: hipFuncSetAttribute failed\n"); grid = -1; return; }
        if (hipOccupancyMaxActiveBlocksPerMultiprocessor(&per_cu, (const void*)trunk_fwd, NT, LDS_BYTES) != hipSuccess || per_cu < 1) { fprintf(stderr, "kernel_launch: occupancy query reports %d workgroups per CU\n", per_cu); }
        (void)hipGetLastError();
        grid = cus;
        if (grid != 256) { fprintf(stderr, "kernel_launch: built for a 256-CU device, found %d CUs; nothing launched\n", cus); grid = -1; return; }
    }
    if (grid < 0) return;
    if (hipMemsetAsync((char*)d_ws + WS_CTL, 0, CTL_ZERO_BYTES, stream) != hipSuccess) { fprintf(stderr, "kernel_launch: hipMemsetAsync failed\n"); return; }
    Args a{};
    for (int i = 0; i < 17; ++i) a.in[i] = (const float*)d_in[i];
    a.out = (float*)d_out; a.ws = (unsigned char*)d_ws;
    if (MK_N_LAUNCHES == 1) { a.ph_lo = 0; a.ph_hi = NPHASE; hipLaunchKernelGGL(trunk_fwd, dim3(grid), dim3(NT), LDS_BYTES, stream, a); }
    else for (int p = 0; p < NPHASE; ++p) { a.ph_lo = p; a.ph_hi = p + 1; hipLaunchKernelGGL(trunk_fwd, dim3(grid), dim3(NT), LDS_BYTES, stream, a); }
    const hipError_t le = hipPeekAtLastError();
    if (le != hipSuccess) fprintf(stderr, "kernel_launch: launch failed: %s\n", hipGetErrorName(le));
}
```

```cpp
#include <hip/hip_runtime.h>
#include <cstdio>
#include <cstdint>
namespace pg8 {
#define PG8_LAS __attribute__((address_space(3)))
typedef unsigned short bf16_t;
typedef short bf16x8 __attribute__((ext_vector_type(8)));
typedef float f32x4 __attribute__((ext_vector_type(4)));
typedef unsigned u32x4 __attribute__((ext_vector_type(4)));
constexpr int BM = 256, BK = 64, HALF = 128, HTB = HALF * BK * 2  , STAGE_BYTES = 8 * HTB, NXCD = 8, WGM = 8;

__host__ __device__ __forceinline__ int lds_byte(int r, int c) { const int st = (r >> 4) * 2 + (c >> 5), rr = r & 15, cc = c & 31, ob = rr * 64 + cc * 2; return st * 1024 + (ob ^ (((ob >> 9) & 1) << 5)); }
__host__ __device__ __forceinline__ void stage_rc(int b, int& R, int& C) { const int st = b / 1024, sb = b % 1024, swz = sb ^ (((sb >> 9) & 1) << 5); R = (st >> 1) * 16 + swz / 64; C = (st & 1) * 32 + (swz % 64) / 2; }
__host__ __device__ __forceinline__ int perm32(int rho) { const int n = rho >> 4, i = rho & 15; return 8 * (i >> 2) + 4 * n + (i & 3); }

struct Unit { int pm, pn; };
struct Gemm { const bf16_t* A; const bf16_t* Bt; int M, N, K; };

struct StaticOrder {
    int nM, nN, nwg, G, c, wgm;
    __host__ __device__ void init(int M, int N, int G_, int c_, int wgm_) { nM = M / BM; nN = N / BM; nwg = nM * nN; G = G_; c = c_; wgm = wgm_; }
    __host__ __device__ bool next(int i, Unit& u) const {
        const long L = (long)i * G + c; if (L >= nwg) return false;
        int wgid = (int)L; { const int q = nwg / NXCD, r = nwg % NXCD, xcd = wgid % NXCD, off = wgid / NXCD; wgid = (xcd < r ? xcd * (q + 1) : r * (q + 1) + (xcd - r) * q) + off; }
        const int nig = wgm * nN, gid = wgid / nig, fm = gid * wgm, gsz = (nM - fm) < wgm ? (nM - fm) : wgm;
        u.pm = fm + ((wgid % nig) % gsz); u.pn = (wgid % nig) / gsz; return true;
    }
    __device__ __forceinline__ void a_ready(const Unit&) const {}
    __device__ __forceinline__ void done(const Unit&) const {}
};

__device__ __forceinline__ unsigned cvt_pk_bf16(float lo, float hi) { unsigned r; asm volatile("v_cvt_pk_bf16_f32 %0, %1, %2" : "=v"(r) : "v"(lo), "v"(hi)); return r; }
typedef unsigned u32x2 __attribute__((ext_vector_type(2)));
typedef float f32x2 __attribute__((ext_vector_type(2)));
__device__ __forceinline__ void load_rstd(const unsigned long long* ssq, int row0, float (&rs)[2][4]) {
    unsigned long long v[2][4];
#pragma unroll
    for (int ai = 0; ai < 2; ++ai)
#pragma unroll
        for (int m = 0; m < 4; ++m) v[ai][m] = ssq[row0 + ai * HALF + m * 16];
#pragma unroll
    for (int ai = 0; ai < 2; ++ai)
#pragma unroll
        for (int m = 0; m < 4; ++m) { const float s = (float)(unsigned)(v[ai][m] >> 32) * 4294967296.0f + (float)(unsigned)v[ai][m];
            rs[ai][m] = __builtin_amdgcn_rsqf(s * (1.0f / (16777216.0f * 2048.0f)) + 1e-6f); }
}
__device__ __forceinline__ void build_rstd_table(const PG8_LAS float* rst, const unsigned long long* ssq, int tid) {
    PG8_LAS float* w = (PG8_LAS float*)rst; unsigned long long v[2];
#pragma unroll
    for (int i = 0; i < 2; ++i) v[i] = ssq[tid + 512 * i];
#pragma unroll
    for (int i = 0; i < 2; ++i) { const float s = (float)(unsigned)(v[i] >> 32) * 4294967296.0f + (float)(unsigned)v[i]; w[tid + 512 * i] = __builtin_amdgcn_rsqf(s * (1.0f / (16777216.0f * 2048.0f)) + 1e-6f); }
}
struct EpiZ {
    static constexpr bool PERM = true, AFTER_DRAIN = false;
    bf16_t* Z; float* ZS; const PG8_LAS float* rst; const unsigned long long* ssq;
    __device__ __forceinline__ void pre(int tid) const { build_rstd_table(rst, ssq, tid); }
    __device__ __forceinline__ void operator()(const f32x4 (&acc)[2][2][4][2], const Unit& u, int wr, int wc, int fr, int fq) const {
        const int row0 = u.pm * BM + wr * 64 + fr; float rs[2][4];
#pragma unroll
        for (int ai = 0; ai < 2; ++ai)
#pragma unroll
            for (int m = 0; m < 4; ++m) rs[ai][m] = rst[(u.pm & 3) * BM + ai * HALF + wr * 64 + m * 16 + fr];
        if (u.pn < 20) {
            const int col0 = u.pn * BM + wc * 32 + 8 * fq;
#pragma unroll
            for (int ai = 0; ai < 2; ++ai)
#pragma unroll
                for (int m = 0; m < 4; ++m) { bf16_t* rowp = Z + (size_t)(row0 + ai * HALF + m * 16) * 5120 + col0; const float r = rs[ai][m];
#pragma unroll
                    for (int bj = 0; bj < 2; ++bj) { const f32x4 v0 = acc[ai][bj][m][0] * r, v1 = acc[ai][bj][m][1] * r;
                        u32x4 w; w.x = cvt_pk_bf16(v0[0], v0[1]); w.y = cvt_pk_bf16(v0[2], v0[3]); w.z = cvt_pk_bf16(v1[0], v1[1]); w.w = cvt_pk_bf16(v1[2], v1[3]);
                        *(u32x4*)(rowp + bj * HALF) = w; } }
        } else if (wc == 0 && fq < 3) {
#pragma unroll
            for (int ai = 0; ai < 2; ++ai)
#pragma unroll
                for (int m = 0; m < 4; ++m) { float* rp = ZS + (size_t)(row0 + ai * HALF + m * 16) * 32 + 8 * fq; const float r = rs[ai][m];
                    *(f32x4*)rp = acc[ai][0][m][0] * r; *(f32x4*)(rp + 4) = acc[ai][0][m][1] * r; }
        }
    }
};
struct EpiSwiglu {
    static constexpr bool PERM = true, AFTER_DRAIN = false;
    bf16_t* H; const PG8_LAS float* rst; const unsigned long long* ssq;
    __device__ __forceinline__ void pre(int tid) const { build_rstd_table(rst, ssq, tid); }
    __device__ __forceinline__ void operator()(const f32x4 (&acc)[2][2][4][2], const Unit& u, int wr, int wc, int fr, int fq) const {
        const int row0 = u.pm * BM + wr * 64 + fr; float rs[2][4];
#pragma unroll
        for (int ai = 0; ai < 2; ++ai)
#pragma unroll
            for (int m = 0; m < 4; ++m) rs[ai][m] = rst[(u.pm & 3) * BM + ai * HALF + wr * 64 + m * 16 + fr];
        const int col0 = u.pn * HALF + wc * 32 + 8 * fq;
#pragma unroll
        for (int ai = 0; ai < 2; ++ai)
#pragma unroll
            for (int m = 0; m < 4; ++m) { bf16_t* rowp = H + (size_t)(row0 + ai * HALF + m * 16) * 5632 + col0; const float r = rs[ai][m];
                unsigned hw[4];
#pragma unroll
                for (int n = 0; n < 2; ++n)
#pragma unroll
                    for (int j = 0; j < 4; j += 2) { const f32x2 a = {acc[ai][0][m][n][j], acc[ai][0][m][n][j + 1]}, b = {acc[ai][1][m][n][j], acc[ai][1][m][n][j + 1]};
                        const f32x2 g = a * r, uu = b * r, t = g * -1.4426950408889634f;
                        f32x2 e2 = {__builtin_amdgcn_exp2f(t.x), __builtin_amdgcn_exp2f(t.y)}; e2 = e2 + 1.0f;
                        const f32x2 rc = {__builtin_amdgcn_rcpf(e2.x), __builtin_amdgcn_rcpf(e2.y)}; const f32x2 h = (g * rc) * uu;
                        hw[2 * n + (j >> 1)] = cvt_pk_bf16(h.x, h.y); }
                u32x4 w; w.x = hw[0]; w.y = hw[1]; w.z = hw[2]; w.w = hw[3];
                *(u32x4*)rowp = w; }
    }
};
struct EpiRes {
    static constexpr bool PERM = true, AFTER_DRAIN = true;
    float* out; bf16_t* xb; unsigned long long* ssp; int stats; int final;
    __device__ __forceinline__ void pre(int) const {}
    __device__ __forceinline__ void fused(f32x4 (&acc)[2][2][4][2], const Unit& u, int wr, int wc, int fr, int fq, PG8_LAS unsigned char* lds, int wid, int lane) const {
        PG8_LAS float* P = (PG8_LAS float*)lds;
        const int col0 = u.pn * BM + wc * 32 + 8 * fq;
        u32x4 pre[8][2];
#pragma unroll
        for (int gi = 0; gi < 8; ++gi) { const size_t off = (size_t)(u.pm * BM + (gi >> 2) * HALF + wr * 64 + (gi & 3) * 16 + fr) * 2048 + col0;
#pragma unroll
            for (int bj = 0; bj < 2; ++bj) pre[gi][bj] = *(const u32x4*)(xb + off + bj * HALF); }
#pragma unroll
        for (int gi = 0; gi < 8; ++gi) { const int ai = gi >> 2, m = gi & 3; const int r = ai * HALF + wr * 64 + m * 16 + fr; const size_t off = (size_t)(u.pm * BM + r) * 2048 + col0; float s = 0.f;
#pragma unroll
            for (int bj = 0; bj < 2; ++bj) { const u32x4 b = pre[gi][bj];
                const f32x4 b0 = {__uint_as_float(b.x << 16), __uint_as_float(b.x & 0xffff0000u), __uint_as_float(b.y << 16), __uint_as_float(b.y & 0xffff0000u)};
                const f32x4 b1 = {__uint_as_float(b.z << 16), __uint_as_float(b.z & 0xffff0000u), __uint_as_float(b.w << 16), __uint_as_float(b.w & 0xffff0000u)};
                const f32x4 o0 = b0 + acc[ai][bj][m][0], o1 = b1 + acc[ai][bj][m][1];
                if (final) { *(f32x4*)(out + off + bj * HALF) = o0; *(f32x4*)(out + off + bj * HALF + 4) = o1; }
                if (stats) { s += ((o0[0] * o0[0] + o0[1] * o0[1]) + (o0[2] * o0[2] + o0[3] * o0[3])) + ((o1[0] * o1[0] + o1[1] * o1[1]) + (o1[2] * o1[2] + o1[3] * o1[3]));
                    u32x4 w; w.x = cvt_pk_bf16(o0[0], o0[1]); w.y = cvt_pk_bf16(o0[2], o0[3]); w.z = cvt_pk_bf16(o1[0], o1[1]); w.w = cvt_pk_bf16(o1[2], o1[3]); *(u32x4*)(xb + off + bj * HALF) = w; } }
            if (stats) { s += __shfl_xor(s, 16); s += __shfl_xor(s, 32); if (fq == 0) P[r * 4 + wc] = s; }
        }
        if (stats) {
            asm volatile("s_waitcnt lgkmcnt(0)" ::: "memory"); __builtin_amdgcn_s_barrier(); asm volatile("" ::: "memory");
            const int tid = wid * 64 + lane;
            if (tid < 256) { const float s = (P[tid * 4 + 0] + P[tid * 4 + 1]) + (P[tid * 4 + 2] + P[tid * 4 + 3]); atomicAdd(ssp + (u.pm * BM + tid), (unsigned long long)(s * 16777216.0f)); }
        }
    }
};
template <class Epi, class Sched, bool ALIGN_EPI = false, bool SP2 = false>
__device__ __forceinline__ void gemm_phase(PG8_LAS unsigned char* lds, const Gemm g, const Sched& S, const Epi& E) {
    int tid_ = threadIdx.x; asm volatile("" : "+v"(tid_));
    const int tid = tid_, wid = __builtin_amdgcn_readfirstlane(tid >> 6), lane = tid & 63, wr = wid >> 2, wc = wid & 3, fr = lane & 15, fq = lane >> 4;
    const int K = g.K, nt = K / BK;
    unsigned voffA[2], voffB[2];
#pragma unroll
    for (int i = 0; i < 2; ++i) { int R, C; stage_rc(tid * 16 + i * 8192, R, C); const int Rb = Epi::PERM ? ((R & ~31) + perm32(R & 31)) : R;
        voffA[i] = (unsigned)(R * K + C) * 2u; voffB[i] = (unsigned)(Rb * K + C) * 2u; }
    const size_t kstep = (size_t)(BK * 2);
    const size_t hstep = (size_t)HALF * K * 2;
    const size_t tstep = 2 * hstep;
    const unsigned ldsw = (unsigned)wid * 1024u;
    const int aoff = lds_byte(wr * 64 + fr, fq * 8), boff = lds_byte(wc * 32 + fr, fq * 8);
#define PG8_SA(b, h) (((b) * 2 + (h)) * HTB)
#define PG8_SB(b, h) ((4 + (b) * 2 + (h)) * HTB)
#define PG8_STAGE(bufoff, gbase, voff) do { _Pragma("unroll") for (int _i = 0; _i < 2; ++_i) \
        __builtin_amdgcn_global_load_lds((const unsigned*)((const char*)(gbase) + (voff)[_i]), (PG8_LAS unsigned*)(lds + (bufoff) + ldsw + _i * 8192), 16, 0, 0); } while (0)
#define PG8_LDA(dst, b, h) do { _Pragma("unroll") for (int m = 0; m < 4; ++m) _Pragma("unroll") for (int k = 0; k < 2; ++k) dst[m][k] = *(const PG8_LAS bf16x8*)(lds + PG8_SA(b, h) + aoff + m * 2048 + k * 1024); } while (0)
#define PG8_LDB(dst, b, h) do { _Pragma("unroll") for (int n = 0; n < 2; ++n) _Pragma("unroll") for (int k = 0; k < 2; ++k) dst[n][k] = *(const PG8_LAS bf16x8*)(lds + PG8_SB(b, h) + boff + n * 2048 + k * 1024); } while (0)
#define PG8_MMA(ai, bj, At, Bt) do { __builtin_amdgcn_s_setprio(1); _Pragma("unroll") for (int m = 0; m < 4; ++m) _Pragma("unroll") for (int n = 0; n < 2; ++n) _Pragma("unroll") for (int k = 0; k < 2; ++k) \
        acc[ai][bj][m][n] = __builtin_amdgcn_mfma_f32_16x16x32_bf16(Bt[n][k], At[m][k], acc[ai][bj][m][n], 0, 0, 0); __builtin_amdgcn_s_setprio(0); } while (0)
#define PG8_WAIT_V(n) asm volatile("s_waitcnt vmcnt(" #n ")" ::: "memory")
#define PG8_WAIT_L(n) asm volatile("s_waitcnt lgkmcnt(" #n ")" ::: "memory")
#define PG8_BAR __builtin_amdgcn_s_barrier()
#define PG8_SCHED __builtin_amdgcn_sched_barrier(0)
    Unit cur, nxt; int ui = 0;
    if (!S.next(0, cur)) return;
    f32x4 acc[2][2][4][2];
#pragma unroll
    for (int a = 0; a < 2; ++a)
#pragma unroll
        for (int b = 0; b < 2; ++b)
#pragma unroll
            for (int m = 0; m < 4; ++m)
#pragma unroll
                for (int n = 0; n < 2; ++n) acc[a][b][m][n] = (f32x4){0.f, 0.f, 0.f, 0.f};
    bf16x8 At[4][2], B0[2][2], B1[2][2];
    const char* cA = (const char*)g.A + (size_t)cur.pm * tstep; const char* cB = (const char*)g.Bt + (size_t)cur.pn * tstep;
    S.a_ready(cur);
    if constexpr (SP2) {
        PG8_STAGE(PG8_SB(0, 0), cB, voffB); PG8_STAGE(PG8_SB(0, 1), cB + hstep, voffB); PG8_STAGE(PG8_SA(0, 0), cA, voffA); PG8_STAGE(PG8_SA(0, 1), cA + hstep, voffA);
        E.pre(tid);
        if (wr == 1) PG8_BAR;
        PG8_WAIT_V(2); PG8_BAR;
        PG8_STAGE(PG8_SB(1, 0), cB + kstep, voffB); PG8_STAGE(PG8_SA(1, 0), cA + kstep, voffA); PG8_STAGE(PG8_SB(1, 1), cB + hstep + kstep, voffB);
        PG8_WAIT_V(6); PG8_BAR;
    } else {
        PG8_STAGE(PG8_SB(0, 0), cB, voffB); PG8_STAGE(PG8_SA(0, 0), cA, voffA); PG8_STAGE(PG8_SB(0, 1), cB + hstep, voffB); PG8_STAGE(PG8_SA(0, 1), cA + hstep, voffA);
        if (wr == 1) PG8_BAR;
        PG8_WAIT_V(4); PG8_BAR;
        PG8_STAGE(PG8_SB(1, 0), cB + kstep, voffB); PG8_STAGE(PG8_SA(1, 0), cA + kstep, voffA); PG8_STAGE(PG8_SB(1, 1), cB + hstep + kstep, voffB);
        PG8_WAIT_V(6); PG8_BAR;
    }
    for (;;) {
        const bool has_next = S.next(ui + 1, nxt);
        const char* nA = has_next ? (const char*)g.A + (size_t)nxt.pm * tstep : cA; const char* nB = has_next ? (const char*)g.Bt + (size_t)nxt.pn * tstep : cB;
        for (int t = 0; t < nt; t += 2) {
            const bool last = (t == nt - 2);
            const char* a1 = cA + (size_t)(t + 1) * kstep;
            const char* a2 = last ? nA : cA + (size_t)(t + 2) * kstep; const char* b2 = last ? nB : cB + (size_t)(t + 2) * kstep;
            const char* a3 = a2 + kstep; const char* b3 = b2 + kstep;
            if (last && has_next) S.a_ready(nxt);
            if constexpr (SP2) {
            PG8_LDB(B0, 0, 0); PG8_LDB(B1, 0, 1); PG8_SCHED; PG8_LDA(At, 0, 0); PG8_STAGE(PG8_SA(1, 1), a1 + hstep, voffA);
            PG8_WAIT_V(8); PG8_WAIT_L(0); PG8_BAR; PG8_MMA(0, 0, At, B0); PG8_MMA(0, 1, At, B1); PG8_BAR; PG8_SCHED;
            PG8_LDA(At, 0, 1); PG8_STAGE(PG8_SB(0, 0), b2, voffB); PG8_STAGE(PG8_SB(0, 1), b2 + hstep, voffB); PG8_STAGE(PG8_SA(0, 0), a2, voffA);
            PG8_WAIT_V(8); PG8_WAIT_L(0); PG8_BAR; PG8_MMA(1, 0, At, B0); PG8_MMA(1, 1, At, B1); PG8_BAR; PG8_SCHED;
            PG8_LDB(B0, 1, 0); PG8_LDB(B1, 1, 1); PG8_SCHED; PG8_LDA(At, 1, 0); PG8_STAGE(PG8_SA(0, 1), a2 + hstep, voffA);
            PG8_WAIT_V(8); PG8_WAIT_L(0); PG8_BAR; PG8_MMA(0, 0, At, B0); PG8_MMA(0, 1, At, B1); PG8_BAR; PG8_SCHED;
            PG8_LDA(At, 1, 1); PG8_STAGE(PG8_SB(1, 0), b3, voffB); PG8_STAGE(PG8_SB(1, 1), b3 + hstep, voffB); PG8_STAGE(PG8_SA(1, 0), a3, voffA);
            PG8_WAIT_V(8); PG8_WAIT_L(0); PG8_BAR; PG8_MMA(1, 0, At, B0); PG8_MMA(1, 1, At, B1); PG8_BAR; PG8_SCHED;
            } else {
            PG8_LDB(B0, 0, 0); PG8_SCHED; PG8_LDA(At, 0, 0); PG8_STAGE(PG8_SA(1, 1), a1 + hstep, voffA);
            PG8_WAIT_L(8); PG8_BAR; PG8_WAIT_L(0); PG8_MMA(0, 0, At, B0); PG8_BAR; PG8_SCHED;
            PG8_LDB(B1, 0, 1); PG8_STAGE(PG8_SB(0, 0), b2, voffB);
            PG8_BAR; PG8_WAIT_L(0); PG8_MMA(0, 1, At, B1); PG8_BAR;
            PG8_LDA(At, 0, 1); PG8_STAGE(PG8_SA(0, 0), a2, voffA);
            PG8_BAR; PG8_WAIT_L(0); PG8_MMA(1, 0, At, B0); PG8_BAR; PG8_SCHED;
            PG8_STAGE(PG8_SB(0, 1), b2 + hstep, voffB);
            PG8_WAIT_V(6); PG8_BAR; PG8_MMA(1, 1, At, B1); PG8_BAR;
            PG8_LDB(B0, 1, 0); PG8_SCHED; PG8_LDA(At, 1, 0); PG8_STAGE(PG8_SA(0, 1), a2 + hstep, voffA);
            PG8_WAIT_L(8); PG8_BAR; PG8_WAIT_L(0); PG8_MMA(0, 0, At, B0); PG8_BAR; PG8_SCHED;
            PG8_LDB(B1, 1, 1); PG8_STAGE(PG8_SB(1, 0), b3, voffB);
            PG8_BAR; PG8_WAIT_L(0); PG8_MMA(0, 1, At, B1); PG8_BAR;
            PG8_LDA(At, 1, 1); PG8_STAGE(PG8_SA(1, 0), a3, voffA);
            PG8_BAR; PG8_WAIT_L(0); PG8_MMA(1, 0, At, B0); PG8_BAR; PG8_SCHED;
            PG8_STAGE(PG8_SB(1, 1), b3 + hstep, voffB);
            PG8_WAIT_V(6); PG8_BAR; PG8_MMA(1, 1, At, B1); PG8_BAR;
            }
        }
        if constexpr (ALIGN_EPI) { if (wr == 0) PG8_BAR; }
        if constexpr (!Epi::AFTER_DRAIN) { E(acc, cur, wr, wc, fr, fq); S.done(cur); }
        if (!has_next) break;
#pragma unroll
        for (int a = 0; a < 2; ++a)
#pragma unroll
            for (int b = 0; b < 2; ++b)
#pragma unroll
                for (int m = 0; m < 4; ++m)
#pragma unroll
                    for (int n = 0; n < 2; ++n) acc[a][b][m][n] = (f32x4){0.f, 0.f, 0.f, 0.f};
        cur = nxt; cA = nA; cB = nB; ++ui;
        if constexpr (ALIGN_EPI) { if (wr == 1) PG8_BAR; }
    }
    PG8_WAIT_V(0);
    if constexpr (!ALIGN_EPI) { if (wr == 0) PG8_BAR; }
    PG8_BAR;
    if constexpr (Epi::AFTER_DRAIN) { E.fused(acc, cur, wr, wc, fr, fq, lds, wid, lane); S.done(cur); }
#undef PG8_SA
#undef PG8_SB
#undef PG8_STAGE
#undef PG8_LDA
#undef PG8_LDB
#undef PG8_MMA
#undef PG8_WAIT_V
#undef PG8_WAIT_L
#undef PG8_BAR
#undef PG8_SCHED
}
}
#define GAS __attribute__((address_space(1)))
#define LAS __attribute__((address_space(3)))
typedef unsigned short bf16;
typedef unsigned v4u __attribute__((ext_vector_type(4)));
typedef float f32x4 __attribute__((ext_vector_type(4)));
typedef short bf16x8 __attribute__((ext_vector_type(8)));
typedef GAS unsigned gu32;
typedef GAS unsigned long long gu64;
#define RLX_AGENT __ATOMIC_RELAXED, __HIP_MEMORY_SCOPE_AGENT
#define LDS_WAIT() asm volatile("s_waitcnt lgkmcnt(0)" ::: "memory")
#define VM_WAIT() asm volatile("s_waitcnt vmcnt(0)" ::: "memory")
__device__ __forceinline__ unsigned long long rt() { return __builtin_amdgcn_s_memrealtime(); }
__device__ __forceinline__ unsigned f2bf(float f) { unsigned u = __builtin_bit_cast(unsigned, f); return (u + 0x7fffu + ((u >> 16) & 1u)) >> 16; }
__device__ __forceinline__ unsigned pk2(float lo, float hi) { return f2bf(lo) | (f2bf(hi) << 16); }

#define XB_TMO      128
#define XB_XCNT(j)  (256  + 64 * (j))
#define XB_XSUB(j)  (1280 + 64 * (j))
#define XB_XGEN(j)  (2304 + 64 * (j))
#define XB_TOP      3328
#define XB_TOPGEN   3392
#define XCD_BAR_WORDS 3456
#define XB_SPIN_CAP (1u << 18)

__device__ __forceinline__ unsigned xb_ld(unsigned* p)              { return __hip_atomic_load(p, __ATOMIC_RELAXED, __HIP_MEMORY_SCOPE_AGENT); }
__device__ __forceinline__ unsigned xb_add(unsigned* p, unsigned v) { return __hip_atomic_fetch_add(p, v, __ATOMIC_RELAXED, __HIP_MEMORY_SCOPE_AGENT); }
__device__ __forceinline__ unsigned xb_xcc_id() { return (unsigned)__builtin_amdgcn_s_getreg((3 << 11) | 20) & 0xFu; }
#define XB_SPIN(cond, bar) do { unsigned _sp = 0; while (cond) { __builtin_amdgcn_s_sleep(1); \
    if ((++_sp & 255u) == 0u) { if (xb_ld(&(bar)[XB_TMO])) break; if (_sp > XB_SPIN_CAP) { atomicAdd(&(bar)[XB_TMO], 1u); break; } } } } while (0)

struct XcdBarrier {
    unsigned* bar; unsigned x;
    volatile LAS unsigned* st;
};

__device__ __forceinline__ XcdBarrier xcd_barrier_post(unsigned* bar, volatile LAS unsigned* st) {
    XcdBarrier b; b.bar = bar; b.x = xb_xcc_id(); b.st = st;
    if (threadIdx.x == 0) (void)xb_add(&bar[XB_XCNT(b.x)], 1u);
    return b;
}
__device__ __forceinline__ void xcd_barrier_complete(unsigned* bar, unsigned x, unsigned& nloc, unsigned& nx) {
    const unsigned G = gridDim.x * gridDim.y * gridDim.z;
    unsigned sum, cnt, mine, sp = 0u;
    for (;;) {
        sum = 0u; cnt = 0u; mine = 0u;
#pragma unroll
        for (unsigned j = 0; j < 16; ++j) { const unsigned c = xb_ld(&bar[XB_XCNT(j)]); sum += c; cnt += (c > 0u) ? 1u : 0u; mine = (j == x) ? c : mine; }
        if (sum == G) break;
        __builtin_amdgcn_s_sleep(1);
        if ((++sp & 255u) == 0u) { if (xb_ld(&bar[XB_TMO])) break; if (sp > XB_SPIN_CAP) { atomicAdd(&bar[XB_TMO], 1u); break; } }
    }
    nloc = mine > 0u ? mine : 1u; nx = cnt > 0u ? cnt : 1u;
}

__device__ __forceinline__ void xcd_barrier(const XcdBarrier& b) {
    asm volatile("s_waitcnt vmcnt(0)" ::: "memory");
    __syncthreads();
    if (threadIdx.x == 0) {
        unsigned* bar = b.bar; unsigned bx = b.x; asm volatile("" : "+s"(bar), "+s"(bx));
        __builtin_amdgcn_s_waitcnt(0);
        unsigned nloc = b.st[0], nx = b.st[1];
        if (nloc == 0u) { xcd_barrier_complete(bar, bx, nloc, nx); b.st[0] = nloc; b.st[1] = nx; }
        const unsigned old = xb_add(&bar[XB_XSUB(bx)], 1u);
        const unsigned gen = old / nloc;
        if (old + 1u == (gen + 1u) * nloc) {
            __builtin_amdgcn_fence(__ATOMIC_RELEASE, "agent");
            asm volatile("s_waitcnt vmcnt(0)" ::: "memory");
            const unsigned og = xb_add(&bar[XB_TOP], 1u);
            const unsigned tg = og / nx;
            if (og + 1u == (tg + 1u) * nx) xb_add(&bar[XB_TOPGEN], 1u);
            else XB_SPIN(xb_ld(&bar[XB_TOPGEN]) == tg, bar);
            xb_add(&bar[XB_XGEN(bx)], 1u);
            __builtin_amdgcn_fence(__ATOMIC_ACQUIRE, "agent");
            asm volatile("s_waitcnt vmcnt(0)" ::: "memory");
        } else {
            XB_SPIN(xb_ld(&bar[XB_XGEN(bx)]) == gen, bar);
            __builtin_amdgcn_fence(__ATOMIC_ACQUIRE, "agent");
            asm volatile("s_waitcnt vmcnt(0)" ::: "memory");
        }
    }
    __syncthreads();
}
constexpr int NWAVES = 8, NT = NWAVES * 64;
#ifndef MK_N_LAUNCHES
#define MK_N_LAUNCHES 1
#endif
constexpr int DM = 2048, NB = 4, SEQ = 2048, M = NB * SEQ, DEPTH = 2, INC = 5140, ZLD = 5120, ZN = 5376, DFF = 5632, GUN = 2 * DFF;
constexpr int Z_CB = 0, Z_CC = 512, Z_CH = 1024, Z_PU = 1536, Z_GQ = 2048, Z_GK = 2304, Z_GV = 2560, Z_GG = 3072, Z_FQ = 3584, Z_FK = 4096, Z_FV = 4608;
constexpr int Y_A = 0, Y_B = 512, Y_C = 1024, Y_D = 1536;
constexpr float EPS = 1e-6f, LOG2E = 1.4426950408889634f;
constexpr float QSCALE = 0.08838834764831845f * 1.4426950408889634f;
constexpr int NPHASE = 1 + 7 * DEPTH;
constexpr size_t MiB = 1u << 20;
constexpr size_t WS_CTL = 0, CTL_ZERO_BYTES = 1 * MiB;
constexpr size_t WS_WIN = 2 * MiB, WIN_BYTES = (size_t)ZN * DM * 2;
constexpr size_t WS_WOUT = 44 * MiB, WOUT_BYTES = (size_t)DM * DM * 2;
constexpr size_t WS_WGU = 60 * MiB, WGU_BYTES = (size_t)GUN * DM * 2;
constexpr size_t WS_WDN = 148 * MiB, WDN_BYTES = (size_t)DM * DFF * 2;
constexpr size_t WS_XB = 192 * MiB, WS_SSP = 224 * MiB, WS_ZS = 225 * MiB, WS_FB = 226 * MiB, WS_ELAST = 227 * MiB;
constexpr size_t WS_CC = 396 * MiB;
constexpr size_t WS_QN = 228 * MiB, WS_KN = 236 * MiB, WS_VT = 244 * MiB, WS_LOC = 252 * MiB, WS_SST = 268 * MiB;
constexpr size_t WS_Z = 284 * MiB, WS_Y = 364 * MiB, WS_H = 284 * MiB, WS_END = 404 * MiB;
static_assert(WS_WIN + 2 * WIN_BYTES <= WS_WOUT && WS_WOUT + 2 * WOUT_BYTES <= WS_WGU && WS_WGU + 2 * WGU_BYTES <= WS_WDN && WS_WDN + 2 * WDN_BYTES <= WS_XB, "weight map");
static_assert(WS_Z + (size_t)M * ZLD * 2 <= WS_Y && WS_Y + (size_t)M * DM * 2 <= WS_CC && WS_H + (size_t)M * DFF * 2 <= WS_CC, "activation map");
constexpr int CW_BAR = 4096;
constexpr int CW_SCAN = 16384;
constexpr size_t WS_SSQ = 256 * 1024;
constexpr int RST_OFF = 1024 + 131072;
constexpr int MISC_OFF = 0, SCR_OFF = 1024, LDS_BYTES = 147456;

struct Args { const float* in[17]; float* out; unsigned char* ws; int ph_lo, ph_hi; };
typedef const __attribute__((address_space(4))) Args* KArgs;
typedef unsigned u32x4v __attribute__((ext_vector_type(4)));
struct Ctx {
    KArgs ka; LAS unsigned char* scr; int tid, lane, wave, G, bid;
    __device__ __forceinline__ KArgs k() const { KArgs p = ka; asm volatile("" : "+s"(p)); return p; }
    __device__ __forceinline__ const float* inp(int i) const { return k()->in[i]; }
    __device__ __forceinline__ unsigned char* wsp() const { return k()->ws; }
    __device__ __forceinline__ float* outp() const { return k()->out; }
};
__device__ __forceinline__ float bf2f(unsigned h) { return __uint_as_float(h << 16); }
__device__ __forceinline__ void unpack8(const v4u w, float (&f)[8]) {
    f[0] = __uint_as_float(w.x << 16); f[1] = __uint_as_float(w.x & 0xffff0000u); f[2] = __uint_as_float(w.y << 16); f[3] = __uint_as_float(w.y & 0xffff0000u);
    f[4] = __uint_as_float(w.z << 16); f[5] = __uint_as_float(w.z & 0xffff0000u); f[6] = __uint_as_float(w.w << 16); f[7] = __uint_as_float(w.w & 0xffff0000u);
}
__device__ __forceinline__ v4u pack8(const float (&f)[8]) { v4u w; w.x = pk2(f[0], f[1]); w.y = pk2(f[2], f[3]); w.z = pk2(f[4], f[5]); w.w = pk2(f[6], f[7]); return w; }
__device__ __forceinline__ void st16_wt(void* p, v4u v) { asm volatile("global_store_dwordx4 %0, %1, off sc1\n\ts_nop 1" :: "v"(p), "v"(v) : "memory"); }
__device__ __forceinline__ float log_sigmoid(float x) { return fminf(x, 0.f) - log1pf(expf(-fabsf(x))); }
__device__ __forceinline__ float silu(float g) { return g / (1.0f + expf(-g)); }

__device__ __forceinline__ void tr_item(const float* W, int N, int K, int k0, int ns0, bf16* WT, int nd0, const float* gain, LAS float* scr, int lane) {
    f32x4 v[16]; float g[16];
#pragma unroll
    for (int i = 0; i < 16; ++i) { const int kk = i * 4 + (lane >> 4), c = (lane & 15) * 4;
        v[i] = *(const GAS f32x4*)(W + (size_t)(k0 + kk) * N + ns0 + c); g[i] = gain ? gain[k0 + kk] : 1.0f; }
#pragma unroll
    for (int i = 0; i < 16; ++i) { const int kk = i * 4 + (lane >> 4), c = (lane & 15) * 4;
        LAS float* s = scr + kk * 65 + c; s[0] = v[i].x * g[i]; s[1] = v[i].y * g[i]; s[2] = v[i].z * g[i]; s[3] = v[i].w * g[i]; }
    LDS_WAIT(); asm volatile("" ::: "memory");
    const int c = lane & 7;
#pragma unroll
    for (int j = 0; j < 8; ++j) { const int n = j * 8 + (lane >> 3); const LAS float* s = scr + (8 * c) * 65 + n;
        v4u o; o.x = pk2(s[0 * 65], s[1 * 65]); o.y = pk2(s[2 * 65], s[3 * 65]); o.z = pk2(s[4 * 65], s[5 * 65]); o.w = pk2(s[6 * 65], s[7 * 65]);
        *(GAS v4u*)(WT + (size_t)(nd0 + n) * K + k0 + 8 * c) = o; }
    LDS_WAIT(); asm volatile("" ::: "memory");
}
__device__ __forceinline__ void tr_item_tail(const float* W, int k0, bf16* WT, const float* gain, int lane) {
    const float* wr = W + (size_t)(k0 + lane) * INC; const float g = gain[k0 + lane]; float v[20];
#pragma unroll
    for (int q = 0; q < 4; ++q) { const f32x4 a = *(const GAS f32x4*)(wr + 3584 + 4 * q); v[4 * q] = a.x * g; v[4 * q + 1] = a.y * g; v[4 * q + 2] = a.z * g; v[4 * q + 3] = a.w * g; }
    { const f32x4 a = *(const GAS f32x4*)(wr + 5136); v[16] = a.x * g; v[17] = a.y * g; v[18] = a.z * g; v[19] = a.w * g; }
#pragma unroll
    for (int j = 0; j < 20; ++j) WT[(size_t)(5120 + j) * DM + k0 + lane] = (bf16)f2bf(v[j]);
    const v4u z = {0u, 0u, 0u, 0u};
    for (int i = 0; i < 30; ++i) { const int row = 5140 + i * 8 + (lane >> 3); if (row < ZN) *(GAS v4u*)(WT + (size_t)row * DM + k0 + (lane & 7) * 8) = z; }
}
typedef float f32x16p __attribute__((ext_vector_type(16)));
__device__ __forceinline__ void pool_fold_item(const float* W, const float* pw, const float* psc, const float* gain, bf16* WT, int gi, int k0, int dq, LAS float* scr, int lane) {
#pragma unroll 4
    for (int i = 0; i < 16; ++i) { const int idx = i * 64 + lane, kk = idx >> 5, c4 = (idx & 31) * 4;
        const f32x4 v = *(const GAS f32x4*)(W + (size_t)(k0 + kk) * INC + Z_PU + gi * 128 + c4); LAS float* s = scr + kk * 129 + c4; s[0] = v.x; s[1] = v.y; s[2] = v.z; s[3] = v.w; }
    LDS_WAIT(); asm volatile("" ::: "memory");
    const int r32 = lane & 31, hi = lane >> 5;
    const float* pwg = pw + (size_t)gi * 128 * 128 + dq * 32 + r32;
    f32x16p acc;
#pragma unroll
    for (int r = 0; r < 16; ++r) acc[r] = 0.f;
#pragma unroll 8
    for (int s = 0; s < 64; ++s) { const int c = 2 * s + hi; acc = __builtin_amdgcn_mfma_f32_32x32x2f32(scr[r32 * 129 + c], pwg[c * 128], acc, 0, 0, 0); }
    const float sc = psc[gi * 128 + dq * 32 + r32];
    bf16* o = WT + (size_t)(Z_PU + gi * 128 + dq * 32 + r32) * DM + k0 + 4 * hi;
#pragma unroll
    for (int g4 = 0; g4 < 4; ++g4) { const f32x4 gk = *(const GAS f32x4*)(gain + k0 + 8 * g4 + 4 * hi);
        const unsigned lo = pk2(acc[4 * g4] * sc * gk.x, acc[4 * g4 + 1] * sc * gk.y), hi2 = pk2(acc[4 * g4 + 2] * sc * gk.z, acc[4 * g4 + 3] * sc * gk.w);
        *(GAS unsigned long long*)(o + 8 * g4) = (unsigned long long)lo | ((unsigned long long)hi2 << 32); }
    LDS_WAIT(); asm volatile("" ::: "memory");
}
__device__ __forceinline__ float wave_sum(float v) {
#pragma unroll
    for (int o = 1; o < 64; o <<= 1) v += __shfl_xor(v, o);
    return v;
}
constexpr int I_IN = 80 * 32, I_TAIL = 32, I_POOL = 4 * 64 * 4, I_OUT = 32 * 32, I_GU = 176 * 32, I_DN = 32 * 88;
constexpr int CV_PER_LAYER = I_IN + I_TAIL + I_POOL + I_OUT + I_GU + I_DN, CV_FIRST = I_IN + I_TAIL + I_POOL + I_OUT;
__device__ __forceinline__ void convert_range(Ctx& C, int lo, int hi, int slot, int nslots) {
    LAS float* scr = (LAS float*)(C.scr + C.wave * 16896);
    for (int it = lo + slot; it < hi; it += nslots) {
        const int l = it / CV_PER_LAYER; int r = it % CV_PER_LAYER;
        const float* g_mix = C.inp(1) + l * DM; const float* g_ffn = C.inp(13) + l * DM;
        const float* w_in = C.inp(2) + (size_t)l * DM * INC;
        bf16* win_t = (bf16*)(C.wsp() + WS_WIN + l * WIN_BYTES);
        if (r < I_IN) { const int nb = r / 32, kb = r % 32; const int nd0 = nb * 64;
            if (nd0 >= Z_PU && nd0 < Z_GQ) continue;
            const int ns0 = nd0 < 3584 ? nd0 : nd0 + 16;
            tr_item(w_in, INC, DM, kb * 64, ns0, win_t, nd0, g_mix, scr, C.lane); continue; }
        r -= I_IN;
        if (r < I_TAIL) { tr_item_tail(w_in, r * 64, win_t, g_mix, C.lane); continue; }
        r -= I_TAIL;
        if (r < I_POOL) { const int gi = r >> 8, kb = (r >> 2) & 63, dq = r & 3;
            pool_fold_item(w_in, C.inp(4) + (size_t)l * 4 * 128 * 128, C.inp(5) + l * 512, g_mix, win_t, gi, kb * 32, dq, scr, C.lane); continue; }
        r -= I_POOL;
        if (r < I_OUT) { const int nb = r / 32, kb = r % 32;
            tr_item(C.inp(12) + (size_t)l * DM * DM, DM, DM, kb * 64, nb * 64, (bf16*)(C.wsp() + WS_WOUT + l * WOUT_BYTES), nb * 64, nullptr, scr, C.lane); continue; }
        r -= I_OUT;
        if (r < I_GU) { const int nb = r / 32, kb = r % 32; const int nd0 = nb * 64, t = nd0 >> 8, j = nd0 & 255;
            const float* src = (j < 128 ? C.inp(14) : C.inp(15)) + (size_t)l * DM * DFF;
            tr_item(src, DFF, DM, kb * 64, t * 128 + (j & 127), (bf16*)(C.wsp() + WS_WGU + l * WGU_BYTES), nd0, g_ffn, scr, C.lane); continue; }
        r -= I_GU;
        { const int nb = r / 88, kb = r % 88;
            tr_item(C.inp(16) + (size_t)l * DFF * DM, DM, DFF, kb * 64, nb * 64, (bf16*)(C.wsp() + WS_WDN + l * WDN_BYTES), nb * 64, nullptr, scr, C.lane); }
    }
}
__device__ __forceinline__ void convert_in_tail(Ctx& C, int nunits, int lo, int hi) {
    const int rem = nunits % C.G; if (rem == 0 || C.bid < rem || lo >= hi) return;
    convert_range(C, lo, hi, (C.bid - rem) * NWAVES + C.wave, (C.G - rem) * NWAVES);
    __syncthreads();
}
__device__ __forceinline__ void rstd_table(Ctx& C, const unsigned long long* ssq) {
    LAS float* rst = (LAS float*)(C.scr - SCR_OFF + RST_OFF); const int row0 = (C.bid & 7) * 1024;
#pragma unroll
    for (int i = 0; i < 2; ++i) { const int r = C.tid + NT * i; const unsigned long long v = ssq[row0 + r];
        const float s = (float)(unsigned)(v >> 32) * 4294967296.0f + (float)(unsigned)v; rst[r] = __builtin_amdgcn_rsqf(s * (1.0f / (16777216.0f * 2048.0f)) + 1e-6f); }
    __syncthreads();
}
__device__ __forceinline__ void warm_in_tail(Ctx& C, int nunits, const void* p, size_t bytes) {
    const int rem = nunits % C.G; if (rem == 0 || C.bid < rem) return;
    const size_t nlines = bytes >> 7, slot = (size_t)(C.bid - rem) * NT + C.tid, nslots = (size_t)(C.G - rem) * NT; unsigned acc = 0u;
#pragma unroll 8
    for (size_t i = slot; i < nlines; i += nslots) acc += *(const GAS unsigned*)((const char*)p + (i << 7));
    asm volatile("" :: "v"(acc));
}
__device__ __forceinline__ void p0_prologue(Ctx& C) {
    const int gw = C.bid * NWAVES + C.wave, NGW = C.G * NWAVES;
#ifndef CV_ALL_IN_PROLOGUE
    convert_range(C, 0, CV_FIRST + I_GU, gw, NGW);
    convert_range(C, CV_PER_LAYER + I_IN + I_TAIL + I_POOL, CV_PER_LAYER + CV_FIRST + I_GU, gw, NGW);
#else
    convert_range(C, 0, DEPTH * CV_PER_LAYER, gw, NGW);
#endif
    bf16* XB = (bf16*)(C.wsp() + WS_XB); unsigned long long* SSQ = (unsigned long long*)(C.wsp() + WS_SSQ);
    for (int m = gw; m < M; m += NGW) {
        const GAS f32x4* xr = (const GAS f32x4*)(C.inp(0) + (size_t)m * DM) + C.lane; float s = 0.f;
        GAS unsigned long long* o8 = (GAS unsigned long long*)(XB + (size_t)m * DM) + C.lane;
#pragma unroll
        for (int j = 0; j < 8; ++j) { const f32x4 v = xr[64 * j]; s += (v.x * v.x + v.y * v.y) + (v.z * v.z + v.w * v.w);
            o8[64 * j] = (unsigned long long)pk2(v.x, v.y) | ((unsigned long long)pk2(v.z, v.w) << 32); }
        s = wave_sum(s);
        if (C.lane == 0) SSQ[m] = (unsigned long long)(s * 16777216.0f);
    }
}

__device__ __forceinline__ void conv_item(Ctx& C, int l, int item) {
    const bf16* Z = (const bf16*)(C.wsp() + WS_Z); bf16* Y = (bf16*)(C.wsp() + WS_Y); const float* cw = C.inp(3) + l * 1536;
    const int c0 = C.lane * 8; float w0[8], w1[8], w2[8];
#pragma unroll
    for (int i = 0; i < 8; ++i) { w0[i] = cw[c0 + i]; w1[i] = cw[512 + c0 + i]; w2[i] = cw[1024 + c0 + i]; }
    const int t0 = item * 64 + C.wave * 8, s0 = t0 & (SEQ - 1);
    v4u rc[10], rh[10], rb[8];
#pragma unroll
    for (int r = 0; r < 10; ++r) { const bool ok = s0 + r - 2 >= 0; const bf16* zr = Z + (size_t)(t0 + (ok ? r - 2 : 0)) * ZLD + c0;
        rc[r] = *(const GAS v4u*)(zr + Z_CC); rh[r] = *(const GAS v4u*)(zr + Z_CH); if (!ok) { rc[r] = (v4u){0u, 0u, 0u, 0u}; } }
#pragma unroll
    for (int i = 0; i < 8; ++i) rb[i] = *(const GAS v4u*)(Z + (size_t)(t0 + i) * ZLD + Z_CB + c0);
    float u0[8], u1[8], u2[8], a[8], b[8];
    unpack8(rc[0], a); unpack8(rh[0], b);
#pragma unroll
    for (int q = 0; q < 8; ++q) u0[q] = a[q] * b[q];
    unpack8(rc[1], a); unpack8(rh[1], b);
#pragma unroll
    for (int q = 0; q < 8; ++q) u1[q] = a[q] * b[q];
#pragma unroll
    for (int i = 0; i < 8; ++i) { unpack8(rc[i + 2], a); unpack8(rh[i + 2], b);
#pragma unroll
        for (int q = 0; q < 8; ++q) u2[q] = a[q] * b[q];
        unpack8(rb[i], a); float o[8];
#pragma unroll
        for (int q = 0; q < 8; ++q) { o[q] = a[q] * (w0[q] * u0[q] + w1[q] * u1[q] + w2[q] * u2[q]); u0[q] = u1[q]; u1[q] = u2[q]; }
        *(GAS v4u*)(Y + (size_t)(t0 + i) * DM + Y_A + c0) = pack8(o); }
}
template <int WIN> __device__ __forceinline__ void pool_wave(const bf16* Z, bf16* Y, int tfirst, int c0) {
    const int s0 = tfirst & (SEQ - 1);
    v4u rp[WIN + 7];
#pragma unroll
    for (int r = 0; r < WIN + 7; ++r) { const bool ok = s0 + r - (WIN - 1) >= 0; rp[r] = *(const GAS v4u*)(Z + (size_t)(tfirst + (ok ? r - (WIN - 1) : 0)) * ZLD + Z_PU + c0); if (!ok) rp[r] = (v4u){0u, 0u, 0u, 0u}; }
    float acc[8], a[8], b[8];
#pragma unroll
    for (int q = 0; q < 8; ++q) acc[q] = 0.f;
#pragma unroll
    for (int r = 0; r < WIN - 1; ++r) { unpack8(rp[r], a);
#pragma unroll
        for (int q = 0; q < 8; ++q) acc[q] += a[q]; }
#pragma unroll
    for (int i = 0; i < 8; ++i) { unpack8(rp[i + WIN - 1], a);
#pragma unroll
        for (int q = 0; q < 8; ++q) acc[q] += a[q];
        const int cnt = (s0 + i + 1) < WIN ? (s0 + i + 1) : WIN; const float inv = 1.0f / (float)cnt; float o[8];
#pragma unroll
        for (int q = 0; q < 8; ++q) o[q] = acc[q] * inv - a[q];
        *(GAS v4u*)(Y + (size_t)(tfirst + i) * DM + Y_B + c0) = pack8(o);
        unpack8(rp[i], b);
#pragma unroll
        for (int q = 0; q < 8; ++q) acc[q] -= b[q]; }
}
__device__ __forceinline__ void pool_item(Ctx& C, int item) {
    const bf16* Z = (const bf16*)(C.wsp() + WS_Z); bf16* Y = (bf16*)(C.wsp() + WS_Y);
    const int g = C.wave & 3, c0 = g * 128 + (C.lane & 15) * 8, tfirst = item * 64 + (C.wave >> 2) * 32 + (C.lane >> 4) * 8;
    if (g == 0) pool_wave<2>(Z, Y, tfirst, c0); else if (g == 1) pool_wave<4>(Z, Y, tfirst, c0); else if (g == 2) pool_wave<8>(Z, Y, tfirst, c0); else pool_wave<16>(Z, Y, tfirst, c0);
}
__device__ __forceinline__ void foxprep_item(Ctx& C, int l, int item) {
    const bf16* Z = (const bf16*)(C.wsp() + WS_Z); bf16* QN = (bf16*)(C.wsp() + WS_QN); bf16* KN = (bf16*)(C.wsp() + WS_KN);
    LAS unsigned short* T = (LAS unsigned short*)C.scr;
    const int t0 = item * 64, b = t0 >> 11, s0 = t0 & (SEQ - 1);
    const int d0 = (C.lane & 15) * 8; float gq[8], gk[8];
#pragma unroll
    for (int q = 0; q < 8; ++q) { gq[q] = C.inp(9)[l * 128 + d0 + q] * QSCALE; gk[q] = C.inp(10)[l * 128 + d0 + q]; }
    v4u rq[8], rk[8];
#pragma unroll
    for (int i = 0; i < 8; ++i) { const int ch = C.tid + NT * i, tok = ch >> 6, c8 = (ch & 63) * 8; const bf16* zr = Z + (size_t)(t0 + tok) * ZLD + c8;
        rq[i] = *(const GAS v4u*)(zr + Z_FQ); rk[i] = *(const GAS v4u*)(zr + Z_FK); }
#pragma unroll
    for (int i = 0; i < 8; ++i) { const int ch = C.tid + NT * i, tok = ch >> 6, c8 = (ch & 63) * 8; float a[8];
#pragma unroll
        for (int which = 0; which < 2; ++which) {
            unpack8(which ? rk[i] : rq[i], a);
            float ss = 0.f;
#pragma unroll
            for (int q = 0; q < 8; ++q) ss += a[q] * a[q];
            ss += __shfl_xor(ss, 1); ss += __shfl_xor(ss, 2); ss += __shfl_xor(ss, 4); ss += __shfl_xor(ss, 8);
            const float rstd = 1.0f / sqrtf(ss * (1.0f / 128.0f) + EPS);
#pragma unroll
            for (int q = 0; q < 8; ++q) a[q] = a[q] * rstd * (which ? gk[q] : gq[q]);
            if (which) *(LAS v4u*)(T + tok * 520 + c8) = pack8(a); else *(GAS v4u*)(QN + (size_t)(t0 + tok) * 512 + c8) = pack8(a); } }
    __syncthreads();
#pragma unroll
    for (int i = 0; i < 8; ++i) { const int oc = C.tid + NT * i, ln = oc & 63, ds = (oc >> 6) & 7, blk = (oc >> 9) & 1, h = oc >> 10;
        const v4u w = *(const LAS v4u*)(T + (blk * 32 + (ln & 31)) * 520 + h * 128 + ds * 16 + (ln >> 5) * 8);
        *(GAS v4u*)(KN + ((((size_t)(b * 4 + h) * 64 + (s0 >> 5) + blk) * 8 + ds) * 64 + ln) * 8) = w; }
    __syncthreads();
}
__device__ __forceinline__ float fls(float x) { const float e = __builtin_amdgcn_exp2f(-fabsf(x) * LOG2E); return fminf(x, 0.f) - 0.6931471805599453f * __builtin_amdgcn_logf(1.0f + e); }
__device__ __forceinline__ void fscan_item(Ctx& C, int l, int item) {
    const float* ZS = (const float*)(C.wsp() + WS_ZS); float* FB = (float*)(C.wsp() + WS_FB); LAS float* WTOT = (LAS float*)C.scr;
    const int b = item >> 2, h = item & 3; const float bf = C.inp(11)[l * 4 + h];
    const int s0 = C.tid * 4; float v[4]; float run = 0.f;
#pragma unroll
    for (int j = 0; j < 4; ++j) { run += fls(ZS[(size_t)(b * SEQ + s0 + j) * 32 + 16 + h] + bf); v[j] = run; }
    float inc = run;
#pragma unroll
    for (int o = 1; o < 64; o <<= 1) { const float nb = __shfl_up(inc, o); if (C.lane >= o) inc += nb; }
    if (C.lane == 63) WTOT[C.wave] = inc;
    __syncthreads();
    float excl = inc - run;
    for (int w = 0; w < C.wave; ++w) excl += WTOT[w];
    *(GAS f32x4*)(FB + (size_t)item * SEQ + s0) = (f32x4){-(v[0] + excl) * LOG2E, -(v[1] + excl) * LOG2E, -(v[2] + excl) * LOG2E, -(v[3] + excl) * LOG2E};
    __syncthreads();
}
__device__ __forceinline__ void gla_scan_item(Ctx& C, int item) {
    if (C.tid >= 128) return;
    const float* LOC = (const float*)(C.wsp() + WS_LOC); const float* EL = (const float*)(C.wsp() + WS_ELAST); float* SST = (float*)(C.wsp() + WS_SST);
    const int c = (item * 128 + C.tid) * 4, bh = c >> 13, kv = c & 8191, k = kv >> 7, b = bh >> 2, h = bh & 3;
    f32x4 st = {0.f, 0.f, 0.f, 0.f};
#pragma unroll
    for (int n0 = 0; n0 < 32; n0 += 16) {
        f32x4 lo[16]; float e[16];
#pragma unroll
        for (int n = 0; n < 16; ++n) { const int unit = (b * 32 + n0 + n) * 4 + h; lo[n] = *(const GAS f32x4*)(LOC + (size_t)unit * 8192 + kv); e[n] = EL[unit * 64 + k]; }
#pragma unroll
        for (int n = 0; n < 16; ++n) { const int unit = (b * 32 + n0 + n) * 4 + h; st16_wt(SST + (size_t)unit * 8192 + kv, __builtin_bit_cast(v4u, st)); st = st * e[n] + lo[n]; }
    }
}
typedef float f32x16 __attribute__((ext_vector_type(16)));
__device__ __forceinline__ void vtprep_item(Ctx& C, int item) {
    const bf16* Z = (const bf16*)(C.wsp() + WS_Z); bf16* VF = (bf16*)(C.wsp() + WS_VT);
    LAS unsigned short* T = (LAS unsigned short*)C.scr;
    const int t0 = item * 64, b = t0 >> 11, kt = (t0 & (SEQ - 1)) >> 6;
#pragma unroll
    for (int i = 0; i < 8; ++i) { const int ch = C.tid + NT * i, tok = ch >> 6, c8 = (ch & 63) * 8;
        *(LAS v4u*)(T + tok * 520 + c8) = *(const GAS v4u*)(Z + (size_t)(t0 + tok) * ZLD + Z_FV + c8); }
    __syncthreads();
#pragma unroll
    for (int i = 0; i < 8; ++i) { const int ch = C.tid + NT * i, ln = ch & 63, s = (ch >> 6) & 3, dblk = (ch >> 8) & 3, h = ch >> 10, hx = ln >> 5, li = ln & 15;
        const LAS unsigned short* p = T + (16 * s + 4 * hx + (li >> 2)) * 520 + h * 128 + dblk * 32 + 16 * ((ln >> 4) & 1) + 4 * (li & 3);
        typedef short v4s_t __attribute__((ext_vector_type(4)));
        const v4s_t lo = __builtin_amdgcn_ds_read_tr16_b64_v4i16((LAS v4s_t*)p), hi2 = __builtin_amdgcn_ds_read_tr16_b64_v4i16((LAS v4s_t*)(p + 8 * 520));
        v4u w; w.x = (unsigned short)lo[0] | ((unsigned)(unsigned short)lo[1] << 16); w.y = (unsigned short)lo[2] | ((unsigned)(unsigned short)lo[3] << 16);
        w.z = (unsigned short)hi2[0] | ((unsigned)(unsigned short)hi2[1] << 16); w.w = (unsigned short)hi2[2] | ((unsigned)(unsigned short)hi2[3] << 16);
        *(GAS v4u*)(VF + ((((size_t)(b * 4 + h) * 32 + kt) * 16 + dblk * 4 + s) * 64 + ln) * 8) = w; }
    __syncthreads();
}
__device__ __forceinline__ unsigned cvtpk(float lo, float hi) { typedef float f2 __attribute__((ext_vector_type(2))); typedef __bf16 b2 __attribute__((ext_vector_type(2))); f2 v = {lo, hi}; b2 r = __builtin_convertvector(v, b2); return __builtin_bit_cast(unsigned, r); }
typedef float f32x4m __attribute__((ext_vector_type(4)));
__device__ __forceinline__ float fast_log_sigmoid(float x) { const float e = __builtin_amdgcn_exp2f(-fabsf(x) * LOG2E); return fminf(x, 0.f) - 0.6931471805599453f * __builtin_amdgcn_logf(1.0f + e); }
__device__ __forceinline__ float ex2(float x) { return __builtin_amdgcn_exp2f(x); }
__device__ __forceinline__ void gla_stage_wd(Ctx& C, int l, int h) {
    LAS float* wd = (LAS float*)(C.scr - SCR_OFF + RST_OFF);
    for (int i = C.tid; i < 1024; i += NT) wd[i] = C.inp(6)[l * 4096 + (i >> 6) * 256 + h * 64 + (i & 63)];
    if (C.tid < 64) wd[1024 + C.tid] = C.inp(7)[l * 256 + h * 64 + C.tid];
    __syncthreads();
}
__device__ __forceinline__ void gla_cc8(Ctx& C, int l, int t0, int h, float (&cc)[8], LAS float* WT) {
    const int t = C.tid >> 3, k0 = (C.tid & 7) * 8;
    const float* zs = (const float*)(C.wsp() + WS_ZS) + (size_t)(t0 + t) * 32; const LAS float* wd = (const LAS float*)(C.scr - SCR_OFF + RST_OFF) + k0; const LAS float* bd = wd + 1024;
    float ga[16], x[8];
#pragma unroll
    for (int i = 0; i < 4; ++i) { const f32x4 v = *(const GAS f32x4*)(zs + 4 * i); ga[4 * i] = v.x; ga[4 * i + 1] = v.y; ga[4 * i + 2] = v.z; ga[4 * i + 3] = v.w; }
    { const f32x4 a = *(const LAS f32x4*)bd, b = *(const LAS f32x4*)(bd + 4); x[0] = a.x; x[1] = a.y; x[2] = a.z; x[3] = a.w; x[4] = b.x; x[5] = b.y; x[6] = b.z; x[7] = b.w; }
#pragma unroll
    for (int r = 0; r < 16; ++r) { const f32x4 a = *(const LAS f32x4*)(wd + r * 64), b = *(const LAS f32x4*)(wd + r * 64 + 4);
        x[0] += ga[r] * a.x; x[1] += ga[r] * a.y; x[2] += ga[r] * a.z; x[3] += ga[r] * a.w; x[4] += ga[r] * b.x; x[5] += ga[r] * b.y; x[6] += ga[r] * b.z; x[7] += ga[r] * b.w; }
#pragma unroll
    for (int q = 0; q < 8; ++q) cc[q] = fast_log_sigmoid(x[q]) * (1.0f / 16.0f);
#pragma unroll
    for (int off = 8; off < 64; off <<= 1)
#pragma unroll
        for (int q = 0; q < 8; ++q) { const float nb = __shfl_up(cc[q], off); if (C.lane >= off) cc[q] += nb; }
    if (C.lane >= 56) { *(LAS f32x4*)(WT + C.wave * 64 + k0) = (f32x4){cc[0], cc[1], cc[2], cc[3]}; *(LAS f32x4*)(WT + C.wave * 64 + k0 + 4) = (f32x4){cc[4], cc[5], cc[6], cc[7]}; }
    __syncthreads();
    for (int w = 0; w < C.wave; ++w) { const f32x4 a = *(const LAS f32x4*)(WT + w * 64 + k0), b = *(const LAS f32x4*)(WT + w * 64 + k0 + 4);
        cc[0] += a.x; cc[1] += a.y; cc[2] += a.z; cc[3] += a.w; cc[4] += b.x; cc[5] += b.y; cc[6] += b.z; cc[7] += b.w; }
}
__device__ __forceinline__ void wt_prefix(const LAS float* WT, int k0, int nw, float (&s)[8]) {
#pragma unroll
    for (int q = 0; q < 8; ++q) s[q] = 0.f;
    for (int w = 0; w < nw; ++w) { const f32x4 a = *(const LAS f32x4*)(WT + w * 64 + k0), b = *(const LAS f32x4*)(WT + w * 64 + k0 + 4);
        s[0] += a.x; s[1] += a.y; s[2] += a.z; s[3] += a.w; s[4] += b.x; s[5] += b.y; s[6] += b.z; s[7] += b.w; }
}
__device__ __forceinline__ void gla_load_v(Ctx& C, const bf16* Z, int t0, int h, v4u (&w)[2]) {
#pragma unroll
    for (int i = 0; i < 2; ++i) { const int ch = C.tid + NT * i, t = ch >> 4, v8 = (ch & 15) * 8; w[i] = *(const GAS v4u*)(Z + (size_t)(t0 + t) * ZLD + Z_GV + h * 128 + v8); }
}
__device__ __forceinline__ void gla_write_v(Ctx& C, const v4u (&wv)[2], LAS unsigned short* V) {
#pragma unroll
    for (int i = 0; i < 2; ++i) { const int ch = C.tid + NT * i, t = ch >> 4, v8 = (ch & 15) * 8; *(LAS v4u*)(V + t * 136 + v8) = wv[i]; }
}
typedef short v4i16_t __attribute__((ext_vector_type(4)));
__device__ __forceinline__ bf16x8 tr_frag(const LAS unsigned short* T, int stride, int kbase, int n0, int lane) {
    const int kg = lane >> 4, i = lane & 15;
    const LAS unsigned short* p = T + (kbase + 8 * kg + (i >> 2)) * stride + n0 + 4 * (i & 3);
    const v4i16_t lo = __builtin_amdgcn_ds_read_tr16_b64_v4i16((LAS v4i16_t*)p), hi = __builtin_amdgcn_ds_read_tr16_b64_v4i16((LAS v4i16_t*)(p + 4 * stride));
    return (bf16x8){lo[0], lo[1], lo[2], lo[3], hi[0], hi[1], hi[2], hi[3]};
}
#define GLA_MFMA(a, b, c) __builtin_amdgcn_mfma_f32_16x16x32_bf16(a, b, c, 0, 0, 0)
#define GLA_FRAG(base, row, ks) (*(const LAS bf16x8*)((base) + (row) * 72 + (ks) * 32 + 8 * (C.lane >> 4)))
__device__ __forceinline__ void gla1_mfma_item(Ctx& C, int l, int unit) {
    const bf16* Z = (const bf16*)(C.wsp() + WS_Z); float* LOC = (float*)(C.wsp() + WS_LOC); float* EL = (float*)(C.wsp() + WS_ELAST);
    const int h = unit & 3, n = (unit >> 2) & 31, b = unit >> 7, t0 = b * SEQ + n * 64;
    LAS float* WT = (LAS float*)C.scr; LAS unsigned short* KMD = (LAS unsigned short*)(C.scr + 4096); LAS unsigned short* VV = (LAS unsigned short*)(C.scr + 13312);
    const int t = C.tid >> 3, k0 = (C.tid & 7) * 8;
    float cc[8], last[8], kf[8];
    const v4u kraw = *(const GAS v4u*)(Z + (size_t)(t0 + t) * ZLD + Z_GK + h * 64 + k0); v4u vraw[2]; gla_load_v(C, Z, t0, h, vraw);
    gla_cc8(C, l, t0, h, cc, WT);
    wt_prefix(WT, k0, 8, last);
    unpack8(kraw, kf);
#pragma unroll
    for (int q = 0; q < 8; ++q) kf[q] *= ex2((last[q] - cc[q]) * LOG2E);
    *(LAS v4u*)(KMD + t * 72 + k0) = pack8(kf);
    if (t == 0) { float* e = EL + unit * 64 + k0;
#pragma unroll
        for (int q = 0; q < 8; ++q) e[q] = ex2(last[q] * LOG2E); }
    { float* cs = (float*)(C.wsp() + WS_CC) + ((size_t)unit * 64 + t) * 64 + k0;
        *(GAS f32x4*)cs = (f32x4){cc[0], cc[1], cc[2], cc[3]}; *(GAS f32x4*)(cs + 4) = (f32x4){cc[4], cc[5], cc[6], cc[7]}; }
    gla_write_v(C, vraw, VV);
    __syncthreads();
    const int tm = C.wave >> 1, fr = C.lane & 15, fq = C.lane >> 4;
    const bf16x8 a0 = tr_frag(KMD, 72, 0, 16 * tm, C.lane), a1 = tr_frag(KMD, 72, 32, 16 * tm, C.lane);
#pragma unroll
    for (int i = 0; i < 4; ++i) { const int tn = 4 * (C.wave & 1) + i; f32x4 acc = {0.f, 0.f, 0.f, 0.f};
        acc = GLA_MFMA(a0, tr_frag(VV, 136, 0, 16 * tn, C.lane), acc); acc = GLA_MFMA(a1, tr_frag(VV, 136, 32, 16 * tn, C.lane), acc);
        float* o = LOC + ((size_t)unit * 64 + 16 * tm + 4 * fq) * 128 + 16 * tn + fr;
        o[0] = acc.x; o[128] = acc.y; o[256] = acc.z; o[384] = acc.w; }
    __syncthreads();
}
__device__ __forceinline__ void gla3_mfma_item(Ctx& C, int l, int unit) {
    const bf16* Z = (const bf16*)(C.wsp() + WS_Z); const float* SST = (const float*)(C.wsp() + WS_SST) + (size_t)unit * 8192; bf16* Y = (bf16*)(C.wsp() + WS_Y);
    const int h = unit & 3, n = (unit >> 2) & 31, b = unit >> 7, t0 = b * SEQ + n * 64;
    LAS float* RS = (LAS float*)(C.scr + 2048);
    LAS unsigned short* QP = (LAS unsigned short*)(C.scr + 4096); LAS unsigned short* KM = QP + 4608; LAS unsigned short* QM = KM + 4608; LAS unsigned short* KP = QM + 4608;
    LAS unsigned short* PP = KP + 4608; LAS unsigned short* VV = PP + 4608; LAS unsigned short* STD = VV + 8704; LAS float* OUT = (LAS float*)(C.scr + 84992);
    const int t = C.tid >> 3, k0 = (C.tid & 7) * 8;
    const v4u qraw = *(const GAS v4u*)(Z + (size_t)(t0 + t) * ZLD + Z_GQ + h * 64 + k0), kraw = *(const GAS v4u*)(Z + (size_t)(t0 + t) * ZLD + Z_GK + h * 64 + k0);
    v4u vraw[2]; gla_load_v(C, Z, t0, h, vraw);
    f32x4 sraw[4];
#pragma unroll
    for (int i = 0; i < 4; ++i) { const int ch = C.tid + NT * i; sraw[i] = *(const GAS f32x4*)(SST + (ch >> 5) * 128 + (ch & 31) * 4); }
    v4u graw[2];
    { const bf16* gr = Z + (size_t)(t0 + t) * ZLD + Z_GG + h * 128 + (C.tid & 7) * 16; graw[0] = *(const GAS v4u*)gr; graw[1] = *(const GAS v4u*)(gr + 8); }
    const float* CCu = (const float*)(C.wsp() + WS_CC) + (size_t)unit * 4096;
    f32x4 ccr[2], c0r[2]; float c0s[4];
    ccr[0] = *(const GAS f32x4*)(CCu + t * 64 + k0); ccr[1] = *(const GAS f32x4*)(CCu + t * 64 + k0 + 4); c0r[0] = *(const GAS f32x4*)(CCu + 31 * 64 + k0); c0r[1] = *(const GAS f32x4*)(CCu + 31 * 64 + k0 + 4);
#pragma unroll
    for (int i = 0; i < 4; ++i) c0s[i] = CCu[31 * 64 + ((C.tid + NT * i) >> 5)];
    { float qf[8], kf[8], a[8];
        const float cc[8] = {ccr[0].x, ccr[0].y, ccr[0].z, ccr[0].w, ccr[1].x, ccr[1].y, ccr[1].z, ccr[1].w}, c0[8] = {c0r[0].x, c0r[0].y, c0r[0].z, c0r[0].w, c0r[1].x, c0r[1].y, c0r[1].z, c0r[1].w};
        unpack8(qraw, qf); unpack8(kraw, kf);
        float ep[8], em[8];
#pragma unroll
        for (int q = 0; q < 8; ++q) { ep[q] = ex2((cc[q] - c0[q]) * LOG2E); em[q] = ex2((c0[q] - cc[q]) * LOG2E); qf[q] *= 0.125f; }
#pragma unroll
        for (int q = 0; q < 8; ++q) a[q] = qf[q] * ep[q];
        *(LAS v4u*)(QP + t * 72 + k0) = pack8(a);
#pragma unroll
        for (int q = 0; q < 8; ++q) a[q] = qf[q] * em[q];
        *(LAS v4u*)(QM + t * 72 + k0) = pack8(a);
#pragma unroll
        for (int q = 0; q < 8; ++q) a[q] = kf[q] * em[q];
        *(LAS v4u*)(KM + t * 72 + k0) = pack8(a);
#pragma unroll
        for (int q = 0; q < 8; ++q) a[q] = kf[q] * ep[q];
        *(LAS v4u*)(KP + t * 72 + k0) = pack8(a); }
    gla_write_v(C, vraw, VV);
#pragma unroll
    for (int i = 0; i < 4; ++i) { const int ch = C.tid + NT * i, k = ch >> 5, v4 = (ch & 31) * 4; const f32x4 s = sraw[i];
        const float e = ex2(c0s[i] * LOG2E);
        *(LAS unsigned long long*)(STD + k * 136 + v4) = (unsigned long long)pk2(s.x * e, s.y * e) | ((unsigned long long)pk2(s.z * e, s.w * e) << 32); }
    __syncthreads();
    const int tm = C.wave >> 1, fr = C.lane & 15, fq = C.lane >> 4;
    const bf16x8 qp0 = GLA_FRAG(QP, 16 * tm + fr, 0), qp1 = GLA_FRAG(QP, 16 * tm + fr, 1);
    { const bf16x8 qm0 = GLA_FRAG(QM, 16 * tm + fr, 0), qm1 = GLA_FRAG(QM, 16 * tm + fr, 1);
#pragma unroll
        for (int i = 0; i < 2; ++i) { const int tn = 2 * (C.wave & 1) + i; f32x4 s1 = {0.f, 0.f, 0.f, 0.f}, s2 = {0.f, 0.f, 0.f, 0.f};
            s1 = GLA_MFMA(qp0, GLA_FRAG(KM, 16 * tn + fr, 0), s1); s1 = GLA_MFMA(qp1, GLA_FRAG(KM, 16 * tn + fr, 1), s1);
            s2 = GLA_MFMA(qm0, GLA_FRAG(KP, 16 * tn + fr, 0), s2); s2 = GLA_MFMA(qm1, GLA_FRAG(KP, 16 * tn + fr, 1), s2);
            const int s = 16 * tn + fr;
#pragma unroll
            for (int r = 0; r < 4; ++r) { const int tt = 16 * tm + 4 * fq + r; PP[tt * 72 + s] = (unsigned short)f2bf(s <= tt ? s1[r] : s2[r]); } } }
    __syncthreads();
    f32x4 acc[4];
    { const bf16x8 p0 = GLA_FRAG(PP, 16 * tm + fr, 0), p1 = GLA_FRAG(PP, 16 * tm + fr, 1);
#pragma unroll
        for (int i = 0; i < 4; ++i) { const int tn = 4 * (C.wave & 1) + i; f32x4 a = {0.f, 0.f, 0.f, 0.f};
            a = GLA_MFMA(p0, tr_frag(VV, 136, 0, 16 * tn, C.lane), a); a = GLA_MFMA(p1, tr_frag(VV, 136, 32, 16 * tn, C.lane), a);
            a = GLA_MFMA(qp0, tr_frag(STD, 136, 0, 16 * tn, C.lane), a); a = GLA_MFMA(qp1, tr_frag(STD, 136, 32, 16 * tn, C.lane), a); acc[i] = a; } }
#pragma unroll
    for (int r = 0; r < 4; ++r) { float ss = (acc[0][r] * acc[0][r] + acc[1][r] * acc[1][r]) + (acc[2][r] * acc[2][r] + acc[3][r] * acc[3][r]);
        ss += __shfl_xor(ss, 1); ss += __shfl_xor(ss, 2); ss += __shfl_xor(ss, 4); ss += __shfl_xor(ss, 8);
        if (fr == 0) RS[(16 * tm + 4 * fq + r) * 2 + (C.wave & 1)] = ss; }
    __syncthreads();
#pragma unroll
    for (int r = 0; r < 4; ++r) { const int tt = 16 * tm + 4 * fq + r; const float rstd = 1.0f / sqrtf((RS[tt * 2] + RS[tt * 2 + 1]) * (1.0f / 128.0f) + EPS);
#pragma unroll
        for (int i = 0; i < 4; ++i) OUT[tt * 132 + 16 * (4 * (C.wave & 1) + i) + fr] = acc[i][r] * rstd; }
    __syncthreads();
    { const int v0 = (C.tid & 7) * 16; bf16* yo = Y + (size_t)(t0 + t) * DM + Y_C + h * 128 + v0; const float* og = C.inp(8) + l * 128 + v0;
#pragma unroll
        for (int hh = 0; hh < 2; ++hh) { float g[8], f8[8]; unpack8(graw[hh], g);
            const f32x4 o0 = *(const LAS f32x4*)(OUT + t * 132 + v0 + hh * 8), o1 = *(const LAS f32x4*)(OUT + t * 132 + v0 + hh * 8 + 4);
            const float ov[8] = {o0.x, o0.y, o0.z, o0.w, o1.x, o1.y, o1.z, o1.w};
#pragma unroll
            for (int q = 0; q < 8; ++q) f8[q] = ov[q] * og[hh * 8 + q] * (g[q] * __builtin_amdgcn_rcpf(1.0f + ex2(-LOG2E * g[q])));
            *(GAS v4u*)(yo + hh * 8) = pack8(f8); } }
    __syncthreads();
}
constexpr int FOX_SLOT = 33024;
constexpr size_t WS_PO = 404 * MiB, WS_ML = 420 * MiB, WS_END2 = 421 * MiB;
__device__ __forceinline__ void glds16(const void* gsrc, unsigned lds_dst) { unsigned keep;
    asm volatile("s_mov_b32 %0, m0\n\ts_mov_b32 m0, %2\n\ts_nop 0\n\tglobal_load_lds_dwordx4 %1, off\n\ts_mov_b32 m0, %0" : "=&s"(keep) : "v"(gsrc), "s"(lds_dst) : "memory"); }
__device__ __forceinline__ void glds4(const void* gsrc, unsigned lds_dst) { unsigned keep;
    asm volatile("s_mov_b32 %0, m0\n\ts_mov_b32 m0, %2\n\ts_nop 0\n\tglobal_load_lds_dword %1, off\n\ts_mov_b32 m0, %0" : "=&s"(keep) : "v"(gsrc), "s"(lds_dst) : "memory"); }
#define FOX_WAIT_BAR(N) asm volatile("s_waitcnt vmcnt(" #N ") lgkmcnt(0)\n\ts_barrier" ::: "memory")
__device__ __forceinline__ void fox_dma(const char* kf, const char* vf, const char* fb, int t, unsigned slot_lds, int wave, int lane) {
    const char* kt = kf + (size_t)t * 16384 + lane * 16; const char* vt = vf + (size_t)t * 16384 + lane * 16;
    glds16(kt + wave * 1024, (unsigned)__builtin_amdgcn_readfirstlane(slot_lds + wave * 1024));
    glds16(kt + (wave + 8) * 1024, (unsigned)__builtin_amdgcn_readfirstlane(slot_lds + (wave + 8) * 1024));
    glds16(vt + wave * 1024, (unsigned)__builtin_amdgcn_readfirstlane(slot_lds + 16384 + wave * 1024));
    glds16(vt + (wave + 8) * 1024, (unsigned)__builtin_amdgcn_readfirstlane(slot_lds + 16384 + (wave + 8) * 1024));
    glds4(fb + (size_t)t * 256 + lane * 4, (unsigned)__builtin_amdgcn_readfirstlane(slot_lds + 32768));
}
__device__ __forceinline__ void fox_seg(Ctx& C, int b, int h, int qb, int t0, int t1, int pidx) {
    const bf16* QN = (const bf16*)(C.wsp() + WS_QN); const int bh = b * 4 + h;
    const char* kf = (const char*)(C.wsp() + WS_KN) + (size_t)bh * 64 * 8192; const char* vf = (const char*)(C.wsp() + WS_VT) + (size_t)bh * 32 * 16384;
    const char* fb = (const char*)((const float*)(C.wsp() + WS_FB) + (size_t)bh * SEQ);
    const int lane = C.lane, r32 = lane & 31, hi = lane >> 5, w = C.wave, n = t1 - t0;
    LAS unsigned char* ring = C.scr; const unsigned ring_lds = (unsigned)(uintptr_t)ring;
    LAS float* WSF = (LAS float*)(ring + 3 * FOX_SLOT) + w * 32;
    const int tq0 = b * SEQ + qb * 256 + w * 32;
    bf16x8 qf[8];
#pragma unroll
    for (int ds = 0; ds < 8; ++ds) qf[ds] = *(const GAS bf16x8*)(QN + (size_t)(tq0 + r32) * 512 + h * 128 + ds * 16 + hi * 8);
    asm volatile("" ::: "memory");
    fox_dma(kf, vf, fb, t0, ring_lds, w, lane);
    if (n > 1) fox_dma(kf, vf, fb, t0 + 1, ring_lds + FOX_SLOT, w, lane);
    f32x16 o[4];
#pragma unroll
    for (int d = 0; d < 4; ++d)
#pragma unroll
        for (int r = 0; r < 16; ++r) o[d][r] = 0.f;
    float m = -1e30f, lsum = 0.f;
    const int kmax = 4 * qb + (w >> 1);
    int sc = 0;
    for (int i = 0; i < n; ++i) {
        if (i + 1 < n) FOX_WAIT_BAR(5); else FOX_WAIT_BAR(0);
        if (i + 2 < n) fox_dma(kf, vf, fb, t0 + i + 2, ring_lds + (unsigned)((sc + 2) % 3) * FOX_SLOT, w, lane);
        const int kt = t0 + i;
        if (kt <= kmax) {
            const LAS unsigned char* slot = ring + sc * FOX_SLOT + lane * 16; const LAS float* fbs = (const LAS float*)(ring + sc * FOX_SLOT + 32768);
            bf16x8 kfr[16];
#pragma unroll
            for (int ds = 0; ds < 8; ++ds) { kfr[2 * ds] = *(const LAS bf16x8*)(slot + ds * 1024); kfr[2 * ds + 1] = *(const LAS bf16x8*)(slot + (8 + ds) * 1024); }
            f32x16 p0, p1;
#pragma unroll
            for (int g4 = 0; g4 < 4; ++g4) { const f32x4 a = *(const LAS f32x4*)(fbs + 8 * g4 + 4 * hi), bq = *(const LAS f32x4*)(fbs + 32 + 8 * g4 + 4 * hi);
                p0[4 * g4] = a.x; p0[4 * g4 + 1] = a.y; p0[4 * g4 + 2] = a.z; p0[4 * g4 + 3] = a.w; p1[4 * g4] = bq.x; p1[4 * g4 + 1] = bq.y; p1[4 * g4 + 2] = bq.z; p1[4 * g4 + 3] = bq.w; }
            __builtin_amdgcn_sched_barrier(0);
#pragma unroll
            for (int ds = 0; ds < 8; ++ds) { p0 = __builtin_amdgcn_mfma_f32_32x32x16_bf16(kfr[2 * ds], qf[ds], p0, 0, 0, 0); p1 = __builtin_amdgcn_mfma_f32_32x32x16_bf16(kfr[2 * ds + 1], qf[ds], p1, 0, 0, 0); }
            __builtin_amdgcn_sched_barrier(0);
            bf16x8 va[8], vb[8];
#pragma unroll
            for (int q = 0; q < 8; ++q) va[q] = *(const LAS bf16x8*)(slot + 16384 + q * 1024);
            __builtin_amdgcn_sched_barrier(0);
            if (kt == kmax) { const int qrel = (w & 1) * 32 + r32;
#pragma unroll
                for (int r = 0; r < 16; ++r) { const int kr = (r & 3) + 8 * (r >> 2) + 4 * hi; if (kr > qrel) p0[r] = -1e30f; if (kr + 32 > qrel) p1[r] = -1e30f; } }
            float mx = fmaxf(p0[0], p1[0]);
#pragma unroll
            for (int r = 1; r < 16; ++r) mx = fmaxf(mx, fmaxf(p0[r], p1[r]));
            mx = fmaxf(mx, __shfl_xor(mx, 32));
            const float mnew = fmaxf(m, mx), f = __builtin_amdgcn_exp2f(m - mnew); m = mnew;
            float rs = 0.f;
#pragma unroll
            for (int r = 0; r < 16; ++r) { p0[r] = __builtin_amdgcn_exp2f(p0[r] - mnew); p1[r] = __builtin_amdgcn_exp2f(p1[r] - mnew); rs += p0[r] + p1[r]; }
            lsum = lsum * f + rs;
            if (!__all(f == 1.0f)) {
                if (hi == 0) WSF[r32] = f;
#pragma unroll
                for (int g4 = 0; g4 < 4; ++g4) { const f32x4 ff = *(const LAS f32x4*)(WSF + 8 * g4 + 4 * hi);
#pragma unroll
                    for (int d = 0; d < 4; ++d) { o[d][4 * g4] *= ff.x; o[d][4 * g4 + 1] *= ff.y; o[d][4 * g4 + 2] *= ff.z; o[d][4 * g4 + 3] *= ff.w; } }
            }
            u32x4v pa[4];
#pragma unroll
            for (int q = 0; q < 4; ++q) { pa[0][q] = cvtpk(p0[2 * q], p0[2 * q + 1]); pa[1][q] = cvtpk(p0[8 + 2 * q], p0[9 + 2 * q]); pa[2][q] = cvtpk(p1[2 * q], p1[2 * q + 1]); pa[3][q] = cvtpk(p1[8 + 2 * q], p1[9 + 2 * q]); }
            __builtin_amdgcn_sched_barrier(0);
#pragma unroll
            for (int q = 0; q < 8; ++q) vb[q] = *(const LAS bf16x8*)(slot + 16384 + (8 + q) * 1024);
            __builtin_amdgcn_sched_barrier(0);
#pragma unroll
            for (int d = 0; d < 2; ++d)
#pragma unroll
                for (int s = 0; s < 4; ++s) o[d] = __builtin_amdgcn_mfma_f32_32x32x16_bf16(__builtin_bit_cast(bf16x8, pa[s]), va[d * 4 + s], o[d], 0, 0, 0);
#pragma unroll
            for (int d = 0; d < 2; ++d)
#pragma unroll
                for (int s = 0; s < 4; ++s) o[d + 2] = __builtin_amdgcn_mfma_f32_32x32x16_bf16(__builtin_bit_cast(bf16x8, pa[s]), vb[d * 4 + s], o[d + 2], 0, 0, 0);
        }
        sc = (sc == 2) ? 0 : sc + 1;
    }
    lsum += __shfl_xor(lsum, 32);
    FOX_WAIT_BAR(0);
    { const float inv = lsum > 0.f ? 1.0f / lsum : 0.f; if (hi == 0) WSF[r32] = inv; }
    LAS unsigned short* stg = (LAS unsigned short*)(ring + w * 8192);
#pragma unroll
    for (int g4 = 0; g4 < 4; ++g4) { const f32x4 ww = *(const LAS f32x4*)(WSF + 8 * g4 + 4 * hi);
#pragma unroll
        for (int i = 0; i < 4; ++i) { const int q = 8 * g4 + 4 * hi + i; const float wq = i == 0 ? ww.x : i == 1 ? ww.y : i == 2 ? ww.z : ww.w;
#pragma unroll
            for (int d = 0; d < 4; ++d) stg[q * 128 + d * 32 + r32] = (unsigned short)f2bf(o[d][4 * g4 + i] * wq); } }
    bf16* dst; size_t ld;
    if (pidx < 0) { dst = (bf16*)(C.wsp() + WS_Y) + (size_t)tq0 * DM + Y_D + h * 128; ld = DM; }
    else { dst = (bf16*)(C.wsp() + WS_PO) + ((size_t)(bh * 16 + pidx) * 256 + w * 32) * 128; ld = 128;
        if (hi == 0) { float* ml = (float*)(C.wsp() + WS_ML) + ((size_t)(bh * 16 + pidx) * 256 + w * 32 + r32) * 2; __hip_atomic_store((unsigned long long*)ml, (unsigned long long)__float_as_uint(m) | ((unsigned long long)__float_as_uint(lsum) << 32), __ATOMIC_RELAXED, __HIP_MEMORY_SCOPE_AGENT); } }
#pragma unroll
    for (int i = 0; i < 8; ++i) { const int row = i * 4 + (lane >> 4), ch = lane & 15; const v4u vv = *(const LAS v4u*)(stg + row * 128 + ch * 8);
        if (pidx < 0) *(GAS v4u*)(dst + (size_t)row * ld + ch * 8) = vv; else st16_wt(dst + (size_t)row * ld + ch * 8, vv); }
    FOX_WAIT_BAR(0);
}
__device__ __forceinline__ void fox_wg(Ctx& C, int b, int h, int i) {
    const int nseg = (i == 13 || i == 15) ? 2 : 1;
    for (int s = 0; s < nseg; ++s) {
        int qb, t0, t1, pidx = i;
        if (s == 1) { qb = i == 13 ? 0 : 1; t0 = 0; t1 = i == 13 ? 4 : 8; pidx = -1; }
        else if (i < 4) { qb = 7; t0 = 8 * i; t1 = t0 + 8; }
        else if (i < 7) { qb = 6; t0 = i == 4 ? 0 : i == 5 ? 10 : 19; t1 = i == 4 ? 10 : i == 5 ? 19 : 28; }
        else if (i < 10) { qb = 5; t0 = 8 * (i - 7); t1 = t0 + 8; }
        else if (i < 12) { qb = 4; t0 = 10 * (i - 10); t1 = t0 + 10; }
        else if (i < 14) { qb = 3; t0 = i == 12 ? 0 : 10; t1 = i == 12 ? 10 : 16; }
        else { qb = 2; t0 = i == 14 ? 0 : 10; t1 = i == 14 ? 10 : 12; }
        fox_seg(C, b, h, qb, t0, t1, pidx);
    }
}
__device__ __forceinline__ void fox_combine_item(Ctx& C, int item) {
    const int bh = item / 24, r = item % 24, ui = r >> 2, chunk = r & 3, qb = 2 + ui;
    const int pb = ui == 0 ? 14 : ui == 1 ? 12 : ui == 2 ? 10 : ui == 3 ? 7 : ui == 4 ? 4 : 0, np = ui < 3 ? 2 : ui < 5 ? 3 : 4;
    const bf16* PO = (const bf16*)(C.wsp() + WS_PO); const float* ML = (const float*)(C.wsp() + WS_ML); bf16* Y = (bf16*)(C.wsp() + WS_Y);
    const int row = chunk * 64 + (C.tid >> 3), col0 = (C.tid & 7) * 16;
    float mm[4], ll[4], ms = -1e30f;
#pragma unroll
    for (int p = 0; p < 4; ++p) { if (p < np) { const float* ml = ML + ((size_t)(bh * 16 + pb + p) * 256 + row) * 2; mm[p] = ml[0]; ll[p] = ml[1]; } else { mm[p] = -1e30f; ll[p] = 0.f; } ms = fmaxf(ms, mm[p]); }
    float L = 0.f;
#pragma unroll
    for (int p = 0; p < 4; ++p) { ll[p] *= __builtin_amdgcn_exp2f(mm[p] - ms); L += ll[p]; }
    const float invL = 1.0f / L; float acc[16];
#pragma unroll
    for (int q = 0; q < 16; ++q) acc[q] = 0.f;
#pragma unroll
    for (int p = 0; p < 4; ++p) { if (p < np) { const bf16* po = PO + ((size_t)(bh * 16 + pb + p) * 256 + row) * 128 + col0; const float wgt = ll[p] * invL; float a[8], bq[8];
        unpack8(*(const GAS v4u*)po, a); unpack8(*(const GAS v4u*)(po + 8), bq);
#pragma unroll
        for (int q = 0; q < 8; ++q) { acc[q] += wgt * a[q]; acc[8 + q] += wgt * bq[q]; } } }
    bf16* yo = Y + (size_t)((bh >> 2) * SEQ + qb * 256 + row) * DM + Y_D + (bh & 3) * 128 + col0; float f8[8];
#pragma unroll
    for (int hh = 0; hh < 2; ++hh) {
#pragma unroll
        for (int q = 0; q < 8; ++q) f8[q] = acc[hh * 8 + q];
        *(GAS v4u*)(yo + hh * 8) = pack8(f8); }
}
#define FOX_UNIT fox_mfma_unit
#define GLA1_ITEM gla1_mfma_item
#define GLA3_ITEM gla3_mfma_item
#ifndef WGM_IN
#define WGM_IN 2
#endif
#ifndef WGM_GU
#define WGM_GU 2
#endif
#ifndef WGM_OUT
#define WGM_OUT 2
#endif
#ifndef WGM_DN
#define WGM_DN 2
#endif
#define ITEM_CTX() do { int t_ = C.tid; asm volatile("" : "+v"(t_)); C.tid = t_; C.lane = t_ & 63; } while (0)
__device__ __forceinline__ Ctx mk_ctx(LAS unsigned char* ldsbase) {
    Ctx C; KArgs ka = (KArgs)__builtin_amdgcn_kernarg_segment_ptr(); asm volatile("" : "+s"(ka)); C.ka = ka;
    int tid = threadIdx.x; asm volatile("" : "+v"(tid)); int G = gridDim.x, bid = blockIdx.x; asm volatile("" : "+s"(G), "+s"(bid));
    C.scr = ldsbase + SCR_OFF; C.tid = tid; C.lane = tid & 63; C.wave = __builtin_amdgcn_readfirstlane(tid >> 6); C.G = G; C.bid = bid; return C;
}
__global__ void __launch_bounds__(NT, 2) trunk_fwd(Args args_unused) {
    extern __shared__ __attribute__((aligned(16))) unsigned char lds[];
    volatile LAS unsigned* MISC = (volatile LAS unsigned*)((LAS unsigned char*)lds + MISC_OFF);
    for (int u = threadIdx.x; u < SCR_OFF / 4; u += NT) MISC[u] = 0u;
    __syncthreads();
    int ph_lo, ph_hi; XcdBarrier bar;
    { Ctx C = mk_ctx((LAS unsigned char*)lds); ph_lo = C.k()->ph_lo; ph_hi = C.k()->ph_hi;
      bar.bar = (unsigned*)((gu32*)(C.wsp() + WS_CTL) + CW_BAR); bar.x = 0; bar.st = nullptr;
      if (ph_hi - ph_lo > 1) bar = xcd_barrier_post((unsigned*)((gu32*)(C.wsp() + WS_CTL) + CW_BAR), MISC + 8); }
    PG8_LAS unsigned char* ring = (PG8_LAS unsigned char*)lds + SCR_OFF;

#ifndef REP_MASK
#define REP_MASK 0
#endif
    for (int ph = ph_lo; ph < ph_hi; ++ph)
    for (int rep = 0; rep < (REP_MASK != 0 && ((REP_MASK >> (ph == 0 ? 0 : 1 + (ph - 1) % 7)) & 1) ? 2 : 1); ++rep) {
        if (ph > 0 && (ph - 1) % 7 == 3) continue;
        int l = (ph - 1) / 7, sub = ph == 0 ? -1 : (ph - 1) % 7; asm volatile("" : "+s"(l), "+s"(sub));
        Ctx C = mk_ctx((LAS unsigned char*)lds);
        if (sub < 0) {
            p0_prologue(C);
        } else if (sub == 0) {
            unsigned char* ws = C.wsp();
            pg8::Gemm g{(const bf16*)(ws + WS_XB), (const bf16*)(ws + WS_WIN + l * WIN_BYTES), M, ZN, DM}; pg8::StaticOrder S; S.init(M, ZN, C.G, C.bid, WGM_IN);
            pg8::EpiZ E{(bf16*)(ws + WS_Z), (float*)(ws + WS_ZS), (const PG8_LAS float*)((PG8_LAS unsigned char*)lds + RST_OFF), (const unsigned long long*)(ws + WS_SSQ) + (size_t)(2 * l) * M + (C.bid & 7) * 1024};
            pg8::gemm_phase<pg8::EpiZ, pg8::StaticOrder, true, true>(ring, g, S, E);
#ifndef CV_ALL_IN_PROLOGUE
            if (l == 0) convert_in_tail(C, (M / 256) * (ZN / 256), CV_FIRST + I_GU, CV_PER_LAYER);
            else convert_in_tail(C, (M / 256) * (ZN / 256), CV_PER_LAYER + CV_FIRST + I_GU, 2 * CV_PER_LAYER);
#endif
        } else if (sub == 1) {
            gla_stage_wd(C, l, C.bid & 3);
            for (int it = C.bid; it < 1040; it += C.G) {
                ITEM_CTX();
                if (it < 512) GLA1_ITEM(C, l, it);
                else if (it < 640) conv_item(C, l, it - 512);
                else if (it < 768) pool_item(C, it - 640);
                else if (it < 896) vtprep_item(C, it - 768);
                else if (it < 1024) foxprep_item(C, l, it - 896);
                else fscan_item(C, l, it - 1024);
            }
        } else if (sub == 2) {
            gu32* scan_cnt = (gu32*)(C.wsp() + WS_CTL) + CW_SCAN + 64 * l;
            for (int it = C.bid; it < 256; it += C.G) { ITEM_CTX(); gla_scan_item(C, it); }
            asm volatile("s_waitcnt vmcnt(0)" ::: "memory"); __syncthreads();
            if (C.tid == 0) __hip_atomic_fetch_add(scan_cnt, 1u, __ATOMIC_RELAXED, __HIP_MEMORY_SCOPE_AGENT);
            for (int it = C.bid; it < 256; it += C.G) { ITEM_CTX(); const int v = (it & 7) * 32 + (it >> 3), bh = v >> 4; fox_wg(C, bh >> 2, bh & 3, v & 15); }
            gu32* fox_cnt = (gu32*)(C.wsp() + WS_CTL) + CW_SCAN + 1024 + 64 * l;
            asm volatile("s_waitcnt vmcnt(0)" ::: "memory"); __syncthreads();
            if (C.tid == 0) __hip_atomic_fetch_add(fox_cnt, 1u, __ATOMIC_RELAXED, __HIP_MEMORY_SCOPE_AGENT);
            if (C.tid == 0) { unsigned sp = 0;
                while (__hip_atomic_load(scan_cnt, __ATOMIC_RELAXED, __HIP_MEMORY_SCOPE_AGENT) < (unsigned)(C.G < 256 ? C.G : 256)) { __builtin_amdgcn_s_sleep(2); if (++sp > (1u << 22)) break; }
                __builtin_amdgcn_fence(__ATOMIC_ACQUIRE, "agent"); asm volatile("s_waitcnt vmcnt(0)" ::: "memory"); }
            __syncthreads();
            for (int it = C.bid; it < 512; it += C.G) { ITEM_CTX(); GLA3_ITEM(C, l, it); }
            if (C.tid == 0) { unsigned sp = 0;
                while (__hip_atomic_load(fox_cnt, __ATOMIC_RELAXED, __HIP_MEMORY_SCOPE_AGENT) < (unsigned)(C.G < 256 ? C.G : 256)) { __builtin_amdgcn_s_sleep(2); if (++sp > (1u << 22)) break; }
                __builtin_amdgcn_fence(__ATOMIC_ACQUIRE, "agent"); asm volatile("s_waitcnt vmcnt(0)" ::: "memory"); }
            __syncthreads();
            for (int it = C.bid; it < 384; it += C.G) { ITEM_CTX(); fox_combine_item(C, it); }
        } else if (sub == 3) {
        } else if (sub == 5) {
            unsigned char* ws = C.wsp();
            pg8::Gemm g{(const bf16*)(ws + WS_XB), (const bf16*)(ws + WS_WGU + l * WGU_BYTES), M, GUN, DM}; pg8::StaticOrder S; S.init(M, GUN, C.G, C.bid, WGM_GU);
            pg8::EpiSwiglu E{(bf16*)(ws + WS_H), (const PG8_LAS float*)((PG8_LAS unsigned char*)lds + RST_OFF), (const unsigned long long*)(ws + WS_SSQ) + (size_t)(2 * l + 1) * M + (C.bid & 7) * 1024};
            pg8::gemm_phase<pg8::EpiSwiglu, pg8::StaticOrder, true, true>(ring, g, S, E);
            warm_in_tail(C, (M / 256) * (GUN / 256), C.wsp() + WS_WDN + l * WDN_BYTES, WDN_BYTES);
#ifndef CV_ALL_IN_PROLOGUE
            if (l == 0) convert_in_tail(C, (M / 256) * (GUN / 256), CV_PER_LAYER, CV_PER_LAYER + I_IN + I_TAIL + I_POOL);
#endif
        } else {
            unsigned char* ws = C.wsp(); const bool dn = sub == 6;
            pg8::Gemm g{(const bf16*)(ws + (dn ? WS_H : WS_Y)), (const bf16*)(ws + (dn ? WS_WDN + l * WDN_BYTES : WS_WOUT + l * WOUT_BYTES)), M, DM, dn ? DFF : DM};
            pg8::StaticOrder S; S.init(M, DM, C.G, C.bid, dn ? WGM_DN : WGM_OUT);
            const int fin = (dn && l + 1 == DEPTH) ? 1 : 0;
            pg8::EpiRes E{C.outp(), (bf16*)(ws + WS_XB), (unsigned long long*)(ws + WS_SSQ) + (size_t)(dn ? 2 * l + 2 : 2 * l + 1) * M, fin ? 0 : 1, fin};
            pg8::gemm_phase<pg8::EpiRes, pg8::StaticOrder, false, true>(ring, g, S, E);
        }
        if (ph + 1 < ph_hi || rep == 0 && REP_MASK != 0) xcd_barrier(bar);
    }
}

extern "C" void kernel_launch(void* const* d_in, const int* in_sizes, int n_in, void* d_out, int out_size, void* d_ws, size_t ws_size, hipStream_t stream) {
    static int grid = 0;
    if (grid == 0) {
        if (n_in != 17 || in_sizes[0] != M * DM || out_size != M * DM || ws_size < WS_END2) { fprintf(stderr, "kernel_launch: unexpected shapes (n_in %d, in0 %d, out %d, ws %zu); nothing launched\n", n_in, n_in > 0 ? in_sizes[0] : -1, out_size, ws_size); grid = -1; return; }
        int dev = 0, cus = 0, per_cu = 0;
        if (hipGetDevice(&dev) != hipSuccess || hipDeviceGetAttribute(&cus, hipDeviceAttributeMultiprocessorCount, dev) != hipSuccess) { fprintf(stderr, "kernel_launch: device query failed\n"); grid = -1; return; }
        if (hipFuncSetAttribute((const void*)trunk_fwd, hipFuncAttributeMaxDynamicSharedMemorySize, LDS_BYTES) != hipSuccess) { fprintf(stderr, "kernel_launch: hipFuncSetAttribute failed\n"); grid = -1; return; }
        if (hipOccupancyMaxActiveBlocksPerMultiprocessor(&per_cu, (const void*)trunk_fwd, NT, LDS_BYTES) != hipSuccess || per_cu < 1) { fprintf(stderr, "kernel_launch: occupancy query reports %d workgroups per CU\n", per_cu); }
        (void)hipGetLastError();
        grid = cus;
        if (grid != 256) { fprintf(stderr, "kernel_launch: built for a 256-CU device, found %d CUs; nothing launched\n", cus); grid = -1; return; }
    }
    if (grid < 0) return;
    if (hipMemsetAsync((char*)d_ws + WS_CTL, 0, CTL_ZERO_BYTES, stream) != hipSuccess) { fprintf(stderr, "kernel_launch: hipMemsetAsync failed\n"); return; }
    Args a{};
    for (int i = 0; i < 17; ++i) a.in[i] = (const float*)d_in[i];
    a.out = (float*)d_out; a.ws = (unsigned char*)d_ws;
    if (MK_N_LAUNCHES == 1) { a.ph_lo = 0; a.ph_hi = NPHASE; hipLaunchKernelGGL(trunk_fwd, dim3(grid), dim3(NT), LDS_BYTES, stream, a); }
    else for (int p = 0; p < NPHASE; ++p) { a.ph_lo = p; a.ph_hi = p + 1; hipLaunchKernelGGL(trunk_fwd, dim3(grid), dim3(NT), LDS_BYTES, stream, a); }
    const hipError_t le = hipPeekAtLastError();
    if (le != hipSuccess) fprintf(stderr, "kernel_launch: launch failed: %s\n", hipGetErrorName(le));
}
```

```cpp
#include <hip/hip_runtime.h>
#include <cstdio>
#include <cstdint>
#define PF_TILES 4
namespace pg8 {
#define PG8_LAS __attribute__((address_space(3)))
typedef unsigned short bf16_t;
typedef short bf16x8 __attribute__((ext_vector_type(8)));
typedef float f32x4 __attribute__((ext_vector_type(4)));
typedef unsigned u32x4 __attribute__((ext_vector_type(4)));
constexpr int BM = 256, BK = 64, HALF = 128, HTB = HALF * BK * 2  , STAGE_BYTES = 8 * HTB, NXCD = 8, WGM = 8;

__host__ __device__ __forceinline__ int lds_byte(int r, int c) { const int st = (r >> 4) * 2 + (c >> 5), rr = r & 15, cc = c & 31, ob = rr * 64 + cc * 2; return st * 1024 + (ob ^ (((ob >> 9) & 1) << 5)); }
__host__ __device__ __forceinline__ void stage_rc(int b, int& R, int& C) { const int st = b / 1024, sb = b % 1024, swz = sb ^ (((sb >> 9) & 1) << 5); R = (st >> 1) * 16 + swz / 64; C = (st & 1) * 32 + (swz % 64) / 2; }
__host__ __device__ __forceinline__ int perm128b(int R) { const int wc = R >> 5, n = (R >> 4) & 1, i = R & 15; return 64 * wc + 16 * (i >> 2) + 4 * n + (i & 3); }
__host__ __device__ __forceinline__ int perm32(int rho) { const int n = rho >> 4, i = rho & 15; return 8 * (i >> 2) + 4 * n + (i & 3); }

struct Unit { int pm, pn; };
struct Gemm { const bf16_t* A; const bf16_t* Bt; int M, N, K; };

struct StaticOrder {
    int nM, nN, nwg, G, c, wgm;
    __host__ __device__ void init(int M, int N, int G_, int c_, int wgm_) { nM = M / BM; nN = N / BM; nwg = nM * nN; G = G_; c = c_; wgm = wgm_; }
    __host__ __device__ bool next(int i, Unit& u) const {
        const long L = (long)i * G + c; if (L >= nwg) return false;
        int wgid = (int)L; { const int q = nwg / NXCD, r = nwg % NXCD, xcd = wgid % NXCD, off = wgid / NXCD; wgid = (xcd < r ? xcd * (q + 1) : r * (q + 1) + (xcd - r) * q) + off; }
        const int nig = wgm * nN, gid = wgid / nig, fm = gid * wgm, gsz = (nM - fm) < wgm ? (nM - fm) : wgm;
        u.pm = fm + ((wgid % nig) % gsz); u.pn = (wgid % nig) / gsz; return true;
    }
    __device__ __forceinline__ void a_ready(const Unit&) const {}
    __device__ __forceinline__ void done(const Unit&) const {}
};

__device__ __forceinline__ unsigned cvt_pk_bf16(float lo, float hi) { unsigned r; asm volatile("v_cvt_pk_bf16_f32 %0, %1, %2" : "=v"(r) : "v"(lo), "v"(hi)); return r; }
typedef unsigned u32x2 __attribute__((ext_vector_type(2)));
template <bool WT> __device__ __forceinline__ void st16(void* p, const u32x4& v) {
    if constexpr (WT) asm volatile("global_store_dwordx4 %0, %1, off sc1\n\ts_nop 1" :: "v"(p), "v"(v) : "memory"); else *(u32x4*)p = v; }
__device__ __forceinline__ unsigned dpp_hi(unsigned old, unsigned src) { return (unsigned)__builtin_amdgcn_update_dpp((int)old, (int)src, 0x128, 0xf, 0xc, false); }
__device__ __forceinline__ unsigned dpp_lo(unsigned old, unsigned src) { return (unsigned)__builtin_amdgcn_update_dpp((int)old, (int)src, 0x128, 0xf, 0x3, false); }
__device__ __forceinline__ void xchg4(const u32x4& a, const u32x4& b, u32x4& x, u32x4& y) {
    x.x = dpp_hi(a.x, b.x); x.y = dpp_hi(a.y, b.y); x.z = dpp_hi(a.z, b.z); x.w = dpp_hi(a.w, b.w);
    y.x = dpp_lo(b.x, a.x); y.y = dpp_lo(b.y, a.y); y.z = dpp_lo(b.z, a.z); y.w = dpp_lo(b.w, a.w); }
__device__ __forceinline__ void xchg4f(const f32x4& a, const f32x4& b, f32x4& x, f32x4& y) {
#pragma unroll
    for (int k = 0; k < 4; ++k) { x[k] = __uint_as_float(dpp_hi(__float_as_uint(a[k]), __float_as_uint(b[k]))); y[k] = __uint_as_float(dpp_lo(__float_as_uint(b[k]), __float_as_uint(a[k]))); } }
typedef float f32x2 __attribute__((ext_vector_type(2)));
__device__ __forceinline__ void load_rstd(const unsigned long long* ssq, int row0, float (&rs)[2][4]) {
    unsigned long long v[2][4];
#pragma unroll
    for (int ai = 0; ai < 2; ++ai)
#pragma unroll
        for (int m = 0; m < 4; ++m) v[ai][m] = ssq[row0 + ai * HALF + m * 16];
#pragma unroll
    for (int ai = 0; ai < 2; ++ai)
#pragma unroll
        for (int m = 0; m < 4; ++m) { const float s = (float)(unsigned)(v[ai][m] >> 32) * 4294967296.0f + (float)(unsigned)v[ai][m];
            rs[ai][m] = __builtin_amdgcn_rsqf(s * (1.0f / (16777216.0f * 2048.0f)) + 1e-6f); }
}
__device__ __forceinline__ void build_rstd_table(const PG8_LAS float* rst, const unsigned long long* ssq, int tid) {
    PG8_LAS float* w = (PG8_LAS float*)rst; unsigned long long v[2];
#pragma unroll
    for (int i = 0; i < 2; ++i) v[i] = ssq[tid + 512 * i];
#pragma unroll
    for (int i = 0; i < 2; ++i) { const float s = (float)(unsigned)(v[i] >> 32) * 4294967296.0f + (float)(unsigned)v[i]; w[tid + 512 * i] = __builtin_amdgcn_rsqf(s * (1.0f / (16777216.0f * 2048.0f)) + 1e-6f); }
}
struct EpiZ {
    static constexpr int PERM = 2; static constexpr bool AFTER_DRAIN = false;
    bf16_t* Z; float* ZS; const PG8_LAS float* rst; const unsigned long long* ssq;
    __device__ __forceinline__ void pre(int tid) const { build_rstd_table(rst, ssq, tid); }
    __device__ __forceinline__ void operator()(const f32x4 (&acc)[2][2][4][2], const Unit& u, int wr, int wc, int fr, int fq, bool last) const { if (last) body<true>(acc, u, wr, wc, fr, fq); else body<false>(acc, u, wr, wc, fr, fq); }
    template <bool WT> __device__ __forceinline__ void body(const f32x4 (&acc)[2][2][4][2], const Unit& u, int wr, int wc, int fr, int fq) const {
        const int row0 = u.pm * BM + wr * 64 + fr; float rs[2][4];
#pragma unroll
        for (int ai = 0; ai < 2; ++ai)
#pragma unroll
            for (int m = 0; m < 4; ++m) rs[ai][m] = rst[(u.pm & 3) * BM + ai * HALF + wr * 64 + m * 16 + fr];
        if (u.pn < 20) {
            const int colx = u.pn * BM + wc * 64 + fq * 16 + (fr & 8);
#pragma unroll
            for (int ai = 0; ai < 2; ++ai)
#pragma unroll
                for (int m = 0; m < 4; ++m) { bf16_t* rowp = Z + (size_t)(u.pm * BM + wr * 64 + ai * HALF + m * 16 + (fr & 7)) * 5120 + colx; const float r = rs[ai][m];
                    u32x4 w[2];
#pragma unroll
                    for (int bj = 0; bj < 2; ++bj) { const f32x4 v0 = acc[ai][bj][m][0] * r, v1 = acc[ai][bj][m][1] * r;
                        w[bj].x = cvt_pk_bf16(v0[0], v0[1]); w[bj].y = cvt_pk_bf16(v0[2], v0[3]); w[bj].z = cvt_pk_bf16(v1[0], v1[1]); w[bj].w = cvt_pk_bf16(v1[2], v1[3]); }
                    u32x4 x, y; xchg4(w[0], w[1], x, y);
                    st16<WT>(rowp, x); st16<WT>(rowp + 8 * 5120, y); }
        } else if (wc == 0 && fq < 2) {
#pragma unroll
            for (int ai = 0; ai < 2; ++ai)
#pragma unroll
                for (int m = 0; m < 4; ++m) { float* rp = ZS + (size_t)(row0 + ai * HALF + m * 16) * 32 + 16 * fq; const float r = rs[ai][m];
                    *(f32x4*)rp = acc[ai][0][m][0] * r; *(f32x4*)(rp + 4) = acc[ai][0][m][1] * r;
                    if (fq == 0) { *(f32x4*)(rp + 8) = acc[ai][1][m][0] * r; *(f32x4*)(rp + 12) = acc[ai][1][m][1] * r; } }
        }
    }
};
struct EpiSwiglu {
    static constexpr int PERM = 1; static constexpr bool AFTER_DRAIN = false;
    bf16_t* H; const PG8_LAS float* rst; const unsigned long long* ssq;
    __device__ __forceinline__ void pre(int tid) const { build_rstd_table(rst, ssq, tid); }
    __device__ __forceinline__ void operator()(const f32x4 (&acc)[2][2][4][2], const Unit& u, int wr, int wc, int fr, int fq, bool last) const { if (last) body<true>(acc, u, wr, wc, fr, fq); else body<false>(acc, u, wr, wc, fr, fq); }
    template <bool WT> __device__ __forceinline__ void body(const f32x4 (&acc)[2][2][4][2], const Unit& u, int wr, int wc, int fr, int fq) const {
        const int row0 = u.pm * BM + wr * 64 + fr; float rs[2][4];
#pragma unroll
        for (int ai = 0; ai < 2; ++ai)
#pragma unroll
            for (int m = 0; m < 4; ++m) rs[ai][m] = rst[(u.pm & 3) * BM + ai * HALF + wr * 64 + m * 16 + fr];
        const int col0 = u.pn * HALF + wc * 32 + 8 * fq;
#pragma unroll
        for (int ai = 0; ai < 2; ++ai)
#pragma unroll
            for (int m = 0; m < 4; ++m) { bf16_t* rowp = H + (size_t)(row0 + ai * HALF + m * 16) * 5632 + col0; const float r = rs[ai][m];
                unsigned hw[4];
#pragma unroll
                for (int n = 0; n < 2; ++n)
#pragma unroll
                    for (int j = 0; j < 4; j += 2) { const f32x2 a = {acc[ai][0][m][n][j], acc[ai][0][m][n][j + 1]}, b = {acc[ai][1][m][n][j], acc[ai][1][m][n][j + 1]};
                        const f32x2 g = a * r, uu = b * r, t = g * -1.4426950408889634f;
                        f32x2 e2 = {__builtin_amdgcn_exp2f(t.x), __builtin_amdgcn_exp2f(t.y)}; e2 = e2 + 1.0f;
                        const f32x2 rc = {__builtin_amdgcn_rcpf(e2.x), __builtin_amdgcn_rcpf(e2.y)}; const f32x2 h = (g * rc) * uu;
                        hw[2 * n + (j >> 1)] = cvt_pk_bf16(h.x, h.y); }
                u32x4 w; w.x = hw[0]; w.y = hw[1]; w.z = hw[2]; w.w = hw[3];
                st16<WT>(rowp, w); }
    }
};
struct EpiRes {
    static constexpr int PERM = 2; static constexpr bool AFTER_DRAIN = true;
    float* out; bf16_t* xb; unsigned long long* ssp; int stats; int final; PG8_LAS unsigned char* sink;
    __device__ __forceinline__ void pre(int) const {}
    __device__ __forceinline__ void prefetch(const Unit& u, int tid, int wid) const {
        const char* base = (const char*)(xb + ((size_t)u.pm * BM * 2048 + (size_t)u.pn * BM));
        const unsigned voff = (unsigned)(tid >> 1) * 4096u + (unsigned)(tid & 1) * 256u;
        PG8_LAS unsigned* s = (PG8_LAS unsigned*)(sink + wid * 512);
        __builtin_amdgcn_global_load_lds((const unsigned*)(base + voff), s, 4, 0, 0); __builtin_amdgcn_global_load_lds((const unsigned*)(base + voff + 128u), s + 64, 4, 0, 0);
    }
    __device__ __forceinline__ void fused(f32x4 (&acc)[2][2][4][2], const Unit& u, int wr, int wc, int fr, int fq, PG8_LAS unsigned char* lds, int wid, int lane) const {
        PG8_LAS float* P = (PG8_LAS float*)lds;
        const int colx = u.pn * BM + wc * 64 + fq * 16 + (fr & 8);
        u32x4 pre[8][2];
#pragma unroll
        for (int gi = 0; gi < 8; ++gi) { const size_t off = (size_t)(u.pm * BM + (gi >> 2) * HALF + wr * 64 + (gi & 3) * 16 + (fr & 7)) * 2048 + colx;
            pre[gi][0] = *(const u32x4*)(xb + off); pre[gi][1] = *(const u32x4*)(xb + off + 8 * 2048); }
#pragma unroll
        for (int gi = 0; gi < 8; ++gi) { const int ai = gi >> 2, m = gi & 3; const int r = ai * HALF + wr * 64 + m * 16 + fr; const size_t off = (size_t)(u.pm * BM + ai * HALF + wr * 64 + m * 16 + (fr & 7)) * 2048 + colx;
            u32x4 b[2]; xchg4(pre[gi][0], pre[gi][1], b[0], b[1]);
            f32x4 o[2][2];
#pragma unroll
            for (int bj = 0; bj < 2; ++bj) {
                const f32x4 b0 = {__uint_as_float(b[bj].x << 16), __uint_as_float(b[bj].x & 0xffff0000u), __uint_as_float(b[bj].y << 16), __uint_as_float(b[bj].y & 0xffff0000u)};
                const f32x4 b1 = {__uint_as_float(b[bj].z << 16), __uint_as_float(b[bj].z & 0xffff0000u), __uint_as_float(b[bj].w << 16), __uint_as_float(b[bj].w & 0xffff0000u)};
                o[bj][0] = b0 + acc[ai][bj][m][0]; o[bj][1] = b1 + acc[ai][bj][m][1]; }
            if (final) { f32x4 x0, y0, x1, y1; xchg4f(o[0][0], o[1][0], x0, y0); xchg4f(o[0][1], o[1][1], x1, y1);
                *(f32x4*)(out + off) = x0; *(f32x4*)(out + off + 4) = x1; *(f32x4*)(out + off + 8 * 2048) = y0; *(f32x4*)(out + off + 8 * 2048 + 4) = y1; }
            if (stats) { float s = 0.f; u32x4 w[2];
#pragma unroll
                for (int bj = 0; bj < 2; ++bj) { const f32x4 o0 = o[bj][0], o1 = o[bj][1];
                    s += ((o0[0] * o0[0] + o0[1] * o0[1]) + (o0[2] * o0[2] + o0[3] * o0[3])) + ((o1[0] * o1[0] + o1[1] * o1[1]) + (o1[2] * o1[2] + o1[3] * o1[3]));
                    w[bj].x = cvt_pk_bf16(o0[0], o0[1]); w[bj].y = cvt_pk_bf16(o0[2], o0[3]); w[bj].z = cvt_pk_bf16(o1[0], o1[1]); w[bj].w = cvt_pk_bf16(o1[2], o1[3]); }
                u32x4 x, y; xchg4(w[0], w[1], x, y);
                st16<true>(xb + off, x); st16<true>(xb + off + 8 * 2048, y);
                s += __shfl_xor(s, 16); s += __shfl_xor(s, 32); if (fq == 0) P[r * 4 + wc] = s; }
        }
        if (stats) {
            asm volatile("s_waitcnt lgkmcnt(0)" ::: "memory"); __builtin_amdgcn_s_barrier(); asm volatile("" ::: "memory");
            const int tid = wid * 64 + lane;
            if (tid < 256) { const float s = (P[tid * 4 + 0] + P[tid * 4 + 1]) + (P[tid * 4 + 2] + P[tid * 4 + 3]); atomicAdd(ssp + (u.pm * BM + tid), (unsigned long long)(s * 16777216.0f)); }
        }
    }
};
template <class Epi, class Sched, bool ALIGN_EPI = false, bool SP2 = false>
__device__ __forceinline__ void gemm_phase(PG8_LAS unsigned char* lds, const Gemm g, const Sched& S, const Epi& E) {
    int tid_ = threadIdx.x; asm volatile("" : "+v"(tid_));
    const int tid = tid_, wid = __builtin_amdgcn_readfirstlane(tid >> 6), lane = tid & 63, wr = wid >> 2, wc = wid & 3, fr = lane & 15, fq = lane >> 4;
    const int K = g.K, nt = K / BK;
    unsigned voffA[2], voffB[2];
#pragma unroll
    for (int i = 0; i < 2; ++i) { int R, C; stage_rc(tid * 16 + i * 8192, R, C); const int Rb = Epi::PERM == 2 ? perm128b(R) : Epi::PERM == 1 ? ((R & ~31) + perm32(R & 31)) : R;
        voffA[i] = (unsigned)(R * K + C) * 2u; voffB[i] = (unsigned)(Rb * K + C) * 2u; }
    const size_t kstep = (size_t)(BK * 2);
    const size_t hstep = (size_t)HALF * K * 2;
    const size_t hstepB = Epi::PERM == 2 ? (size_t)8 * K * 2 : hstep;
    const size_t tstep = 2 * hstep;
    const unsigned ldsw = (unsigned)wid * 1024u;
    const int aoff = lds_byte(wr * 64 + fr, fq * 8), boff = lds_byte(wc * 32 + fr, fq * 8);
#define PG8_SA(b, h) (((b) * 2 + (h)) * HTB)
#define PG8_SB(b, h) ((4 + (b) * 2 + (h)) * HTB)
#define PG8_STAGE(bufoff, gbase, voff) do { _Pragma("unroll") for (int _i = 0; _i < 2; ++_i) \
        __builtin_amdgcn_global_load_lds((const unsigned*)((const char*)(gbase) + (voff)[_i]), (PG8_LAS unsigned*)(lds + (bufoff) + ldsw + _i * 8192), 16, 0, 0); } while (0)
#define PG8_LDA(dst, b, h) do { _Pragma("unroll") for (int m = 0; m < 4; ++m) _Pragma("unroll") for (int k = 0; k < 2; ++k) dst[m][k] = *(const PG8_LAS bf16x8*)(lds + PG8_SA(b, h) + aoff + m * 2048 + k * 1024); } while (0)
#define PG8_LDB(dst, b, h) do { _Pragma("unroll") for (int n = 0; n < 2; ++n) _Pragma("unroll") for (int k = 0; k < 2; ++k) dst[n][k] = *(const PG8_LAS bf16x8*)(lds + PG8_SB(b, h) + boff + n * 2048 + k * 1024); } while (0)
#define PG8_MMA(ai, bj, At, Bt) do { __builtin_amdgcn_s_setprio(1); _Pragma("unroll") for (int m = 0; m < 4; ++m) _Pragma("unroll") for (int n = 0; n < 2; ++n) _Pragma("unroll") for (int k = 0; k < 2; ++k) \
        acc[ai][bj][m][n] = __builtin_amdgcn_mfma_f32_16x16x32_bf16(Bt[n][k], At[m][k], acc[ai][bj][m][n], 0, 0, 0); __builtin_amdgcn_s_setprio(0); } while (0)
#define PG8_WAIT_V(n) asm volatile("s_waitcnt vmcnt(" #n ")" ::: "memory")
#define PG8_WAIT_L(n) asm volatile("s_waitcnt lgkmcnt(" #n ")" ::: "memory")
#define PG8_BAR __builtin_amdgcn_s_barrier()
#define PG8_SCHED __builtin_amdgcn_sched_barrier(0)
    Unit cur, nxt; int ui = 0;
    if (!S.next(0, cur)) return;
    f32x4 acc[2][2][4][2];
#pragma unroll
    for (int a = 0; a < 2; ++a)
#pragma unroll
        for (int b = 0; b < 2; ++b)
#pragma unroll
            for (int m = 0; m < 4; ++m)
#pragma unroll
                for (int n = 0; n < 2; ++n) acc[a][b][m][n] = (f32x4){0.f, 0.f, 0.f, 0.f};
    bf16x8 At[4][2], B0[2][2], B1[2][2];
    const char* cA = (const char*)g.A + (size_t)cur.pm * tstep; const char* cB = (const char*)g.Bt + (size_t)cur.pn * tstep;
    S.a_ready(cur);
    if constexpr (SP2) {
        PG8_STAGE(PG8_SB(0, 0), cB, voffB); PG8_STAGE(PG8_SB(0, 1), cB + hstepB, voffB); PG8_STAGE(PG8_SA(0, 0), cA, voffA); PG8_STAGE(PG8_SA(0, 1), cA + hstep, voffA);
        E.pre(tid);
        if (wr == 1) PG8_BAR;
        PG8_WAIT_V(2); PG8_BAR;
        PG8_STAGE(PG8_SB(1, 0), cB + kstep, voffB); PG8_STAGE(PG8_SA(1, 0), cA + kstep, voffA); PG8_STAGE(PG8_SB(1, 1), cB + hstepB + kstep, voffB);
        PG8_WAIT_V(6); PG8_BAR;
    } else {
        PG8_STAGE(PG8_SB(0, 0), cB, voffB); PG8_STAGE(PG8_SA(0, 0), cA, voffA); PG8_STAGE(PG8_SB(0, 1), cB + hstepB, voffB); PG8_STAGE(PG8_SA(0, 1), cA + hstep, voffA);
        if (wr == 1) PG8_BAR;
        PG8_WAIT_V(4); PG8_BAR;
        PG8_STAGE(PG8_SB(1, 0), cB + kstep, voffB); PG8_STAGE(PG8_SA(1, 0), cA + kstep, voffA); PG8_STAGE(PG8_SB(1, 1), cB + hstepB + kstep, voffB);
        PG8_WAIT_V(6); PG8_BAR;
    }
    for (;;) {
        const bool has_next = S.next(ui + 1, nxt);
        const char* nA = has_next ? (const char*)g.A + (size_t)nxt.pm * tstep : cA; const char* nB = has_next ? (const char*)g.Bt + (size_t)nxt.pn * tstep : cB;
        for (int t = 0; t < nt; t += 2) {
            const bool last = (t == nt - 2);
            const char* a1 = cA + (size_t)(t + 1) * kstep;
            const char* a2 = last ? nA : cA + (size_t)(t + 2) * kstep; const char* b2 = last ? nB : cB + (size_t)(t + 2) * kstep;
            const char* a3 = a2 + kstep; const char* b3 = b2 + kstep;
            if (last && has_next) S.a_ready(nxt);
            if constexpr (Epi::AFTER_DRAIN) { if (t == nt - PF_TILES) E.prefetch(cur, tid, wid); }
            if constexpr (SP2) {
            PG8_LDB(B0, 0, 0); PG8_LDB(B1, 0, 1); PG8_SCHED; PG8_LDA(At, 0, 0); PG8_STAGE(PG8_SA(1, 1), a1 + hstep, voffA);
            PG8_WAIT_V(8); PG8_WAIT_L(0); PG8_BAR; PG8_MMA(0, 0, At, B0); PG8_MMA(0, 1, At, B1); PG8_BAR; PG8_SCHED;
            PG8_LDA(At, 0, 1); PG8_STAGE(PG8_SB(0, 0), b2, voffB); PG8_STAGE(PG8_SB(0, 1), b2 + hstepB, voffB); PG8_STAGE(PG8_SA(0, 0), a2, voffA);
            PG8_WAIT_V(8); PG8_WAIT_L(0); PG8_BAR; PG8_MMA(1, 0, At, B0); PG8_MMA(1, 1, At, B1); PG8_BAR; PG8_SCHED;
            PG8_LDB(B0, 1, 0); PG8_LDB(B1, 1, 1); PG8_SCHED; PG8_LDA(At, 1, 0); PG8_STAGE(PG8_SA(0, 1), a2 + hstep, voffA);
            PG8_WAIT_V(8); PG8_WAIT_L(0); PG8_BAR; PG8_MMA(0, 0, At, B0); PG8_MMA(0, 1, At, B1); PG8_BAR; PG8_SCHED;
            PG8_LDA(At, 1, 1); PG8_STAGE(PG8_SB(1, 0), b3, voffB); PG8_STAGE(PG8_SB(1, 1), b3 + hstepB, voffB); PG8_STAGE(PG8_SA(1, 0), a3, voffA);
            PG8_WAIT_V(8); PG8_WAIT_L(0); PG8_BAR; PG8_MMA(1, 0, At, B0); PG8_MMA(1, 1, At, B1); PG8_BAR; PG8_SCHED;
            } else {
            PG8_LDB(B0, 0, 0); PG8_SCHED; PG8_LDA(At, 0, 0); PG8_STAGE(PG8_SA(1, 1), a1 + hstep, voffA);
            PG8_WAIT_L(8); PG8_BAR; PG8_WAIT_L(0); PG8_MMA(0, 0, At, B0); PG8_BAR; PG8_SCHED;
            PG8_LDB(B1, 0, 1); PG8_STAGE(PG8_SB(0, 0), b2, voffB);
            PG8_BAR; PG8_WAIT_L(0); PG8_MMA(0, 1, At, B1); PG8_BAR;
            PG8_LDA(At, 0, 1); PG8_STAGE(PG8_SA(0, 0), a2, voffA);
            PG8_BAR; PG8_WAIT_L(0); PG8_MMA(1, 0, At, B0); PG8_BAR; PG8_SCHED;
            PG8_STAGE(PG8_SB(0, 1), b2 + hstepB, voffB);
            PG8_WAIT_V(6); PG8_BAR; PG8_MMA(1, 1, At, B1); PG8_BAR;
            PG8_LDB(B0, 1, 0); PG8_SCHED; PG8_LDA(At, 1, 0); PG8_STAGE(PG8_SA(0, 1), a2 + hstep, voffA);
            PG8_WAIT_L(8); PG8_BAR; PG8_WAIT_L(0); PG8_MMA(0, 0, At, B0); PG8_BAR; PG8_SCHED;
            PG8_LDB(B1, 1, 1); PG8_STAGE(PG8_SB(1, 0), b3, voffB);
            PG8_BAR; PG8_WAIT_L(0); PG8_MMA(0, 1, At, B1); PG8_BAR;
            PG8_LDA(At, 1, 1); PG8_STAGE(PG8_SA(1, 0), a3, voffA);
            PG8_BAR; PG8_WAIT_L(0); PG8_MMA(1, 0, At, B0); PG8_BAR; PG8_SCHED;
            PG8_STAGE(PG8_SB(1, 1), b3 + hstepB, voffB);
            PG8_WAIT_V(6); PG8_BAR; PG8_MMA(1, 1, At, B1); PG8_BAR;
            }
        }
        if constexpr (ALIGN_EPI) { if (wr == 0) PG8_BAR; }
        if constexpr (!Epi::AFTER_DRAIN) { E(acc, cur, wr, wc, fr, fq, !has_next); S.done(cur); }
        if (!has_next) break;
#pragma unroll
        for (int a = 0; a < 2; ++a)
#pragma unroll
            for (int b = 0; b < 2; ++b)
#pragma unroll
                for (int m = 0; m < 4; ++m)
#pragma unroll
                    for (int n = 0; n < 2; ++n) acc[a][b][m][n] = (f32x4){0.f, 0.f, 0.f, 0.f};
        cur = nxt; cA = nA; cB = nB; ++ui;
        if constexpr (ALIGN_EPI) { if (wr == 1) PG8_BAR; }
    }
    PG8_WAIT_V(0);
    if constexpr (!ALIGN_EPI) { if (wr == 0) PG8_BAR; }
    PG8_BAR;
    if constexpr (Epi::AFTER_DRAIN) { E.fused(acc, cur, wr, wc, fr, fq, lds, wid, lane); S.done(cur); }
#undef PG8_SA
#undef PG8_SB
#undef PG8_STAGE
#undef PG8_LDA
#undef PG8_LDB
#undef PG8_MMA
#undef PG8_WAIT_V
#undef PG8_WAIT_L
#undef PG8_BAR
#undef PG8_SCHED
}
}
#define GAS __attribute__((address_space(1)))
#define LAS __attribute__((address_space(3)))
typedef unsigned short bf16;
typedef unsigned v4u __attribute__((ext_vector_type(4)));
typedef float f32x4 __attribute__((ext_vector_type(4)));
typedef short bf16x8 __attribute__((ext_vector_type(8)));
typedef GAS unsigned gu32;
typedef GAS unsigned long long gu64;
#define RLX_AGENT __ATOMIC_RELAXED, __HIP_MEMORY_SCOPE_AGENT
#define LDS_WAIT() asm volatile("s_waitcnt lgkmcnt(0)" ::: "memory")
#define VM_WAIT() asm volatile("s_waitcnt vmcnt(0)" ::: "memory")
__device__ __forceinline__ unsigned long long rt() { return __builtin_amdgcn_s_memrealtime(); }
__device__ __forceinline__ unsigned pk2(float lo, float hi) { unsigned r; asm("v_cvt_pk_bf16_f32 %0, %1, %2" : "=v"(r) : "v"(lo), "v"(hi)); return r; }
__device__ __forceinline__ unsigned f2bf(float f) { return pk2(f, 0.0f); }

#define XB_TMO      128
#define XB_XCNT(j)  (256  + 64 * (j))
#define XB_XSUB(j)  (1280 + 64 * (j))
#define XB_XGEN(j)  (2304 + 64 * (j))
#define XB_TOP      3328
#define XB_TOPGEN   3392
#define XCD_BAR_WORDS 3456
#define XB_SPIN_CAP (1u << 18)

__device__ __forceinline__ unsigned xb_ld(unsigned* p)              { return __hip_atomic_load(p, __ATOMIC_RELAXED, __HIP_MEMORY_SCOPE_AGENT); }
__device__ __forceinline__ unsigned xb_add(unsigned* p, unsigned v) { return __hip_atomic_fetch_add(p, v, __ATOMIC_RELAXED, __HIP_MEMORY_SCOPE_AGENT); }
__device__ __forceinline__ unsigned xb_xcc_id() { return (unsigned)__builtin_amdgcn_s_getreg((3 << 11) | 20) & 0xFu; }
#define XB_SPIN(cond, bar) do { unsigned _sp = 0; while (cond) { __builtin_amdgcn_s_sleep(1); \
    if ((++_sp & 255u) == 0u) { if (xb_ld(&(bar)[XB_TMO])) break; if (_sp > XB_SPIN_CAP) { atomicAdd(&(bar)[XB_TMO], 1u); break; } } } } while (0)

struct XcdBarrier {
    unsigned* bar; unsigned x;
    volatile LAS unsigned* st;
};

__device__ __forceinline__ XcdBarrier xcd_barrier_post(unsigned* bar, volatile LAS unsigned* st) {
    XcdBarrier b; b.bar = bar; b.x = xb_xcc_id(); b.st = st;
    if (threadIdx.x == 0) (void)xb_add(&bar[XB_XCNT(b.x)], 1u);
    return b;
}
__device__ __forceinline__ void xcd_barrier_complete(unsigned* bar, unsigned x, unsigned& nloc, unsigned& nx) {
    const unsigned G = gridDim.x * gridDim.y * gridDim.z;
    unsigned sum, cnt, mine, sp = 0u;
    for (;;) {
        sum = 0u; cnt = 0u; mine = 0u;
#pragma unroll
        for (unsigned j = 0; j < 16; ++j) { const unsigned c = xb_ld(&bar[XB_XCNT(j)]); sum += c; cnt += (c > 0u) ? 1u : 0u; mine = (j == x) ? c : mine; }
        if (sum == G) break;
        __builtin_amdgcn_s_sleep(1);
        if ((++sp & 255u) == 0u) { if (xb_ld(&bar[XB_TMO])) break; if (sp > XB_SPIN_CAP) { atomicAdd(&bar[XB_TMO], 1u); break; } }
    }
    nloc = mine > 0u ? mine : 1u; nx = cnt > 0u ? cnt : 1u;
}

__device__ __forceinline__ void xcd_barrier(const XcdBarrier& b) {
    asm volatile("s_waitcnt vmcnt(0)" ::: "memory");
    __syncthreads();
    if (threadIdx.x == 0) {
        unsigned* bar = b.bar; unsigned bx = b.x; asm volatile("" : "+s"(bar), "+s"(bx));
        __builtin_amdgcn_s_waitcnt(0);
        unsigned nloc = b.st[0], nx = b.st[1];
        if (nloc == 0u) { xcd_barrier_complete(bar, bx, nloc, nx); b.st[0] = nloc; b.st[1] = nx; }
        const unsigned old = xb_add(&bar[XB_XSUB(bx)], 1u);
        const unsigned gen = old / nloc;
        if (old + 1u == (gen + 1u) * nloc) {
            __builtin_amdgcn_fence(__ATOMIC_RELEASE, "agent");
            asm volatile("s_waitcnt vmcnt(0)" ::: "memory");
            const unsigned og = xb_add(&bar[XB_TOP], 1u);
            const unsigned tg = og / nx;
            if (og + 1u == (tg + 1u) * nx) xb_add(&bar[XB_TOPGEN], 1u);
            else XB_SPIN(xb_ld(&bar[XB_TOPGEN]) == tg, bar);
            xb_add(&bar[XB_XGEN(bx)], 1u);
            __builtin_amdgcn_fence(__ATOMIC_ACQUIRE, "agent");
            asm volatile("s_waitcnt vmcnt(0)" ::: "memory");
        } else {
            XB_SPIN(xb_ld(&bar[XB_XGEN(bx)]) == gen, bar);
            __builtin_amdgcn_fence(__ATOMIC_ACQUIRE, "agent");
            asm volatile("s_waitcnt vmcnt(0)" ::: "memory");
        }
    }
    __syncthreads();
}
constexpr int NWAVES = 8, NT = NWAVES * 64;
#ifndef MK_N_LAUNCHES
#define MK_N_LAUNCHES 1
#endif
constexpr int DM = 2048, NB = 4, SEQ = 2048, M = NB * SEQ, DEPTH = 2, INC = 5140, ZLD = 5120, ZN = 5376, DFF = 5632, GUN = 2 * DFF;
constexpr int Z_CB = 0, Z_CC = 512, Z_CH = 1024, Z_PU = 1536, Z_GQ = 2048, Z_GK = 2304, Z_GV = 2560, Z_GG = 3072, Z_FQ = 3584, Z_FK = 4096, Z_FV = 4608;
constexpr int Y_A = 0, Y_B = 512, Y_C = 1024, Y_D = 1536;
constexpr float EPS = 1e-6f, LOG2E = 1.4426950408889634f;
constexpr float QSCALE = 0.08838834764831845f * 1.4426950408889634f;
constexpr int NPHASE = 1 + 7 * DEPTH;
constexpr size_t MiB = 1u << 20;
constexpr size_t WS_CTL = 0, CTL_ZERO_BYTES = 1 * MiB;
constexpr size_t WS_WIN = 2 * MiB, WIN_BYTES = (size_t)ZN * DM * 2;
constexpr size_t WS_WOUT = 44 * MiB, WOUT_BYTES = (size_t)DM * DM * 2;
constexpr size_t WS_WGU = 60 * MiB, WGU_BYTES = (size_t)GUN * DM * 2;
constexpr size_t WS_WDN = 148 * MiB, WDN_BYTES = (size_t)DM * DFF * 2;
constexpr size_t WS_XB = 192 * MiB, WS_SSP = 224 * MiB, WS_ZS = 225 * MiB, WS_FB = 226 * MiB, WS_ELAST = 227 * MiB;
constexpr size_t WS_CC = 396 * MiB;
constexpr size_t WS_QN = 228 * MiB, WS_KN = 236 * MiB, WS_VT = 244 * MiB, WS_LOC = 252 * MiB, WS_SST = 268 * MiB;
constexpr size_t WS_Z = 284 * MiB, WS_Y = 364 * MiB, WS_H = 284 * MiB, WS_END = 404 * MiB;
static_assert(WS_WIN + 2 * WIN_BYTES <= WS_WOUT && WS_WOUT + 2 * WOUT_BYTES <= WS_WGU && WS_WGU + 2 * WGU_BYTES <= WS_WDN && WS_WDN + 2 * WDN_BYTES <= WS_XB, "weight map");
static_assert(WS_Z + (size_t)M * ZLD * 2 <= WS_Y && WS_Y + (size_t)M * DM * 2 <= WS_CC && WS_H + (size_t)M * DFF * 2 <= WS_CC, "activation map");
constexpr int CW_BAR = 4096;
constexpr int CW_SCAN = 16384;
constexpr size_t WS_SSQ = 256 * 1024;
constexpr int RST_OFF = 1024 + 131072;
constexpr int MISC_OFF = 0, SCR_OFF = 1024, LDS_BYTES = 147456;

struct Args { const float* in[17]; float* out; unsigned char* ws; int ph_lo, ph_hi; };
typedef const __attribute__((address_space(4))) Args* KArgs;
typedef unsigned u32x4v __attribute__((ext_vector_type(4)));
struct Ctx {
    KArgs ka; LAS unsigned char* scr; int tid, lane, wave, G, bid;
    __device__ __forceinline__ KArgs k() const { KArgs p = ka; asm volatile("" : "+s"(p)); return p; }
    __device__ __forceinline__ const float* inp(int i) const { return k()->in[i]; }
    __device__ __forceinline__ unsigned char* wsp() const { return k()->ws; }
    __device__ __forceinline__ float* outp() const { return k()->out; }
};
__device__ __forceinline__ float bf2f(unsigned h) { return __uint_as_float(h << 16); }
__device__ __forceinline__ void unpack8(const v4u w, float (&f)[8]) {
    f[0] = __uint_as_float(w.x << 16); f[1] = __uint_as_float(w.x & 0xffff0000u); f[2] = __uint_as_float(w.y << 16); f[3] = __uint_as_float(w.y & 0xffff0000u);
    f[4] = __uint_as_float(w.z << 16); f[5] = __uint_as_float(w.z & 0xffff0000u); f[6] = __uint_as_float(w.w << 16); f[7] = __uint_as_float(w.w & 0xffff0000u);
}
__device__ __forceinline__ v4u pack8(const float (&f)[8]) { v4u w; w.x = pk2(f[0], f[1]); w.y = pk2(f[2], f[3]); w.z = pk2(f[4], f[5]); w.w = pk2(f[6], f[7]); return w; }
__device__ __forceinline__ void st16_wt(void* p, v4u v) { asm volatile("global_store_dwordx4 %0, %1, off sc1\n\ts_nop 1" :: "v"(p), "v"(v) : "memory"); }
__device__ __forceinline__ float log_sigmoid(float x) { return fminf(x, 0.f) - log1pf(expf(-fabsf(x))); }
__device__ __forceinline__ float silu(float g) { return g / (1.0f + expf(-g)); }

__device__ __forceinline__ void tr_item(const float* W, int N, int K, int k0, int ns0, bf16* WT, int nd0, const float* gain, LAS float* scr, int lane, bool wt) {
    f32x4 v[16]; float g[16];
#pragma unroll
    for (int i = 0; i < 16; ++i) { const int kk = i * 4 + (lane >> 4), c = (lane & 15) * 4;
        v[i] = __builtin_nontemporal_load((const GAS f32x4*)(W + (size_t)(k0 + kk) * N + ns0 + c)); g[i] = gain ? gain[k0 + kk] : 1.0f; }
#pragma unroll
    for (int i = 0; i < 16; ++i) { const int kk = i * 4 + (lane >> 4), c = (lane & 15) * 4;
        LAS float* s = scr + kk * 65 + c; s[0] = v[i].x * g[i]; s[1] = v[i].y * g[i]; s[2] = v[i].z * g[i]; s[3] = v[i].w * g[i]; }
    LDS_WAIT(); asm volatile("" ::: "memory");
    const int c = lane & 7;
#pragma unroll
    for (int j = 0; j < 8; ++j) { const int n = j * 8 + (lane >> 3); const LAS float* s = scr + (8 * c) * 65 + n;
        v4u o; o.x = pk2(s[0 * 65], s[1 * 65]); o.y = pk2(s[2 * 65], s[3 * 65]); o.z = pk2(s[4 * 65], s[5 * 65]); o.w = pk2(s[6 * 65], s[7 * 65]);
        if (wt) st16_wt(WT + (size_t)(nd0 + n) * K + k0 + 8 * c, o); else __builtin_nontemporal_store(o, (GAS v4u*)(WT + (size_t)(nd0 + n) * K + k0 + 8 * c)); }
    LDS_WAIT(); asm volatile("" ::: "memory");
}
__device__ __forceinline__ void tr_item_tail(const float* W, int k0, bf16* WT, const float* gain, int lane) {
    const float* wr = W + (size_t)(k0 + lane) * INC; const float g = gain[k0 + lane]; float v[20];
#pragma unroll
    for (int q = 0; q < 4; ++q) { const f32x4 a = *(const GAS f32x4*)(wr + 3584 + 4 * q); v[4 * q] = a.x * g; v[4 * q + 1] = a.y * g; v[4 * q + 2] = a.z * g; v[4 * q + 3] = a.w * g; }
    { const f32x4 a = *(const GAS f32x4*)(wr + 5136); v[16] = a.x * g; v[17] = a.y * g; v[18] = a.z * g; v[19] = a.w * g; }
#pragma unroll
    for (int j = 0; j < 20; ++j) WT[(size_t)(5120 + j) * DM + k0 + lane] = (bf16)f2bf(v[j]);
    const v4u z = {0u, 0u, 0u, 0u};
    for (int i = 0; i < 30; ++i) { const int row = 5140 + i * 8 + (lane >> 3); if (row < ZN) *(GAS v4u*)(WT + (size_t)row * DM + k0 + (lane & 7) * 8) = z; }
}
typedef float f32x16p __attribute__((ext_vector_type(16)));
__device__ __forceinline__ void pool_fold_item(const float* W, const float* pw, const float* psc, const float* gain, bf16* WT, int gi, int k0, int dq, LAS float* scr, int lane) {
    f32x4 v[16];
#pragma unroll
    for (int i = 0; i < 16; ++i) { const int idx = i * 64 + lane, kk = idx >> 5, c4 = (idx & 31) * 4; v[i] = *(const GAS f32x4*)(W + (size_t)(k0 + kk) * INC + Z_PU + gi * 128 + c4); }
#pragma unroll
    for (int i = 0; i < 16; ++i) { const int idx = i * 64 + lane, kk = idx >> 5, c4 = (idx & 31) * 4; LAS float* s = scr + kk * 129 + c4; s[0] = v[i].x; s[1] = v[i].y; s[2] = v[i].z; s[3] = v[i].w; }
    LDS_WAIT(); asm volatile("" ::: "memory");
    const int r32 = lane & 31, hi = lane >> 5;
    const float* pwg = pw + (size_t)gi * 128 * 128 + dq * 32 + r32;
    f32x16p acc;
#pragma unroll
    for (int r = 0; r < 16; ++r) acc[r] = 0.f;
#pragma unroll 8
    for (int s = 0; s < 64; ++s) { const int c = 2 * s + hi; acc = __builtin_amdgcn_mfma_f32_32x32x2f32(scr[r32 * 129 + c], pwg[c * 128], acc, 0, 0, 0); }
    const float sc = psc[gi * 128 + dq * 32 + r32];
    bf16* o = WT + (size_t)(Z_PU + gi * 128 + dq * 32 + r32) * DM + k0 + 4 * hi;
#pragma unroll
    for (int g4 = 0; g4 < 4; ++g4) { const f32x4 gk = *(const GAS f32x4*)(gain + k0 + 8 * g4 + 4 * hi);
        const unsigned lo = pk2(acc[4 * g4] * sc * gk.x, acc[4 * g4 + 1] * sc * gk.y), hi2 = pk2(acc[4 * g4 + 2] * sc * gk.z, acc[4 * g4 + 3] * sc * gk.w);
        *(GAS unsigned long long*)(o + 8 * g4) = (unsigned long long)lo | ((unsigned long long)hi2 << 32); }
    LDS_WAIT(); asm volatile("" ::: "memory");
}
#define DPP_ADD_(v, ctrl) ((v) + __uint_as_float((unsigned)__builtin_amdgcn_update_dpp(0, (int)__float_as_uint(v), ctrl, 0xf, 0xf, true)))
__device__ __forceinline__ float sum16(float v) { v = DPP_ADD_(v, 0xB1); v = DPP_ADD_(v, 0x4E); v = DPP_ADD_(v, 0x141); v = DPP_ADD_(v, 0x140); return v; }
__device__ __forceinline__ float wave_sum(float v) {
#pragma unroll
    for (int o = 1; o < 64; o <<= 1) v += __shfl_xor(v, o);
    return v;
}
constexpr int I_IN = 80 * 32, I_TAIL = 32, I_POOL = 4 * 64 * 4, I_OUT = 32 * 32, I_GU = 176 * 32, I_DN = 32 * 88;
constexpr int GU0_T = 2048;
constexpr int GU1_A = 0, GU1_B = 2048, GU1_C = 3584, GU1_KEEP = I_GU - GU1_A - GU1_B - GU1_C;
constexpr int CV_PER_LAYER = I_IN + I_TAIL + I_POOL + I_OUT + I_GU + I_DN, CV_FIRST = I_IN + I_TAIL + I_POOL + I_OUT;
__device__ __forceinline__ void convert_range(Ctx& C, int lo, int hi, int slot, int nslots) {
    LAS float* scr = (LAS float*)(C.scr + C.wave * 16896);
    for (int it = lo + slot; it < hi; it += nslots) {
        const bool wt = it + nslots >= hi;
        const int l = it / CV_PER_LAYER; int r = it % CV_PER_LAYER;
        const float* g_mix = C.inp(1) + l * DM; const float* g_ffn = C.inp(13) + l * DM;
        const float* w_in = C.inp(2) + (size_t)l * DM * INC;
        bf16* win_t = (bf16*)(C.wsp() + WS_WIN + l * WIN_BYTES);
        if (r < I_IN) { const int nb = r / 32, kb = r % 32; const int nd0 = nb * 64;
            if (nd0 >= Z_PU && nd0 < Z_GQ) continue;
            const int ns0 = nd0 < 3584 ? nd0 : nd0 + 16;
            tr_item(w_in, INC, DM, kb * 64, ns0, win_t, nd0, g_mix, scr, C.lane, wt); continue; }
        r -= I_IN;
        if (r < I_TAIL) { tr_item_tail(w_in, r * 64, win_t, g_mix, C.lane); continue; }
        r -= I_TAIL;
        if (r < I_POOL) { const int gi = r >> 8, kb = (r >> 2) & 63, dq = r & 3;
            pool_fold_item(w_in, C.inp(4) + (size_t)l * 4 * 128 * 128, C.inp(5) + l * 512, g_mix, win_t, gi, kb * 32, dq, scr, C.lane); continue; }
        r -= I_POOL;
        if (r < I_OUT) { const int nb = r / 32, kb = r % 32;
            tr_item(C.inp(12) + (size_t)l * DM * DM, DM, DM, kb * 64, nb * 64, (bf16*)(C.wsp() + WS_WOUT + l * WOUT_BYTES), nb * 64, nullptr, scr, C.lane, wt); continue; }
        r -= I_OUT;
        if (r < I_GU) { const int nb = r / 32, kb = r % 32; const int nd0 = nb * 64, t = nd0 >> 8, j = nd0 & 255;
            const float* src = (j < 128 ? C.inp(14) : C.inp(15)) + (size_t)l * DM * DFF;
            tr_item(src, DFF, DM, kb * 64, t * 128 + (j & 127), (bf16*)(C.wsp() + WS_WGU + l * WGU_BYTES), nd0, g_ffn, scr, C.lane, wt); continue; }
        r -= I_GU;
        { const int nb = r / 88, kb = r % 88;
            tr_item(C.inp(16) + (size_t)l * DFF * DM, DM, DFF, kb * 64, nb * 64, (bf16*)(C.wsp() + WS_WDN + l * WDN_BYTES), nb * 64, nullptr, scr, C.lane, wt); }
    }
}
__device__ __forceinline__ void convert_in_tail(Ctx& C, int nunits, int lo, int hi, int lo2 = 0, int hi2 = 0) {
    const int rem = nunits % C.G; if (rem == 0 || C.bid < rem || lo >= hi) return;
#pragma nounroll
    for (int rr = 0; rr < 2; ++rr) { const int a = rr ? lo2 : lo, b = rr ? hi2 : hi;
        if (a < b) convert_range(C, a, b, (C.bid - rem) * NWAVES + C.wave, (C.G - rem) * NWAVES); }
    __syncthreads();
}
__device__ __forceinline__ void rstd_table(Ctx& C, const unsigned long long* ssq) {
    LAS float* rst = (LAS float*)(C.scr - SCR_OFF + RST_OFF); const int row0 = (C.bid & 7) * 1024;
#pragma unroll
    for (int i = 0; i < 2; ++i) { const int r = C.tid + NT * i; const unsigned long long v = ssq[row0 + r];
        const float s = (float)(unsigned)(v >> 32) * 4294967296.0f + (float)(unsigned)v; rst[r] = __builtin_amdgcn_rsqf(s * (1.0f / (16777216.0f * 2048.0f)) + 1e-6f); }
    __syncthreads();
}
__device__ __forceinline__ void warm_in_tail(Ctx& C, int nunits, const void* p, size_t bytes) {
    const int rem = nunits % C.G; if (rem == 0 || C.bid < rem) return;
    const size_t nlines = bytes >> 7, slot = (size_t)(C.bid - rem) * NT + C.tid, nslots = (size_t)(C.G - rem) * NT; unsigned acc = 0u;
#pragma unroll 8
    for (size_t i = slot; i < nlines; i += nslots) acc += *(const GAS unsigned*)((const char*)p + (i << 7));
    asm volatile("" :: "v"(acc));
}
__device__ __forceinline__ void p0_prologue(Ctx& C) {
    const int gw = C.bid * NWAVES + C.wave, NGW = C.G * NWAVES;
#ifndef CV_ALL_IN_PROLOGUE
    convert_range(C, 0, CV_FIRST + I_GU - GU0_T, gw, NGW);
#else
    convert_range(C, 0, DEPTH * CV_PER_LAYER, gw, NGW);
#endif
    bf16* XB = (bf16*)(C.wsp() + WS_XB); unsigned long long* SSQ = (unsigned long long*)(C.wsp() + WS_SSQ);
    for (int m = gw; m < M; m += NGW) {
        const GAS f32x4* xr = (const GAS f32x4*)(C.inp(0) + (size_t)m * DM) + C.lane; float s = 0.f;
        GAS unsigned long long* o8 = (GAS unsigned long long*)(XB + (size_t)m * DM) + C.lane;
#pragma unroll
        for (int j = 0; j < 8; ++j) { const f32x4 v = __builtin_nontemporal_load(xr + 64 * j); s += (v.x * v.x + v.y * v.y) + (v.z * v.z + v.w * v.w);
            o8[64 * j] = (unsigned long long)pk2(v.x, v.y) | ((unsigned long long)pk2(v.z, v.w) << 32); }
        s = wave_sum(s);
        if (C.lane == 0) SSQ[m] = (unsigned long long)(s * 16777216.0f);
    }
}

__device__ __forceinline__ void conv_item(Ctx& C, int l, int item) {
    const bf16* Z = (const bf16*)(C.wsp() + WS_Z); bf16* Y = (bf16*)(C.wsp() + WS_Y); const float* cw = C.inp(3) + l * 1536;
    const int c0 = C.lane * 8; float w0[8], w1[8], w2[8];
#pragma unroll
    for (int i = 0; i < 8; ++i) { w0[i] = cw[c0 + i]; w1[i] = cw[512 + c0 + i]; w2[i] = cw[1024 + c0 + i]; }
    const int t0 = item * 64 + C.wave * 8, s0 = t0 & (SEQ - 1);
    v4u rc[10], rh[10], rb[8];
#pragma unroll
    for (int r = 0; r < 10; ++r) { const bool ok = s0 + r - 2 >= 0; const bf16* zr = Z + (size_t)(t0 + (ok ? r - 2 : 0)) * ZLD + c0;
        rc[r] = __builtin_nontemporal_load((const GAS v4u*)(zr + Z_CC)); rh[r] = __builtin_nontemporal_load((const GAS v4u*)(zr + Z_CH)); if (!ok) { rc[r] = (v4u){0u, 0u, 0u, 0u}; } }
#pragma unroll
    for (int i = 0; i < 8; ++i) rb[i] = __builtin_nontemporal_load((const GAS v4u*)(Z + (size_t)(t0 + i) * ZLD + Z_CB + c0));
    float u0[8], u1[8], u2[8], a[8], b[8];
    unpack8(rc[0], a); unpack8(rh[0], b);
#pragma unroll
    for (int q = 0; q < 8; ++q) u0[q] = a[q] * b[q];
    unpack8(rc[1], a); unpack8(rh[1], b);
#pragma unroll
    for (int q = 0; q < 8; ++q) u1[q] = a[q] * b[q];
#pragma unroll
    for (int i = 0; i < 8; ++i) { unpack8(rc[i + 2], a); unpack8(rh[i + 2], b);
#pragma unroll
        for (int q = 0; q < 8; ++q) u2[q] = a[q] * b[q];
        unpack8(rb[i], a); float o[8];
#pragma unroll
        for (int q = 0; q < 8; ++q) { o[q] = a[q] * (w0[q] * u0[q] + w1[q] * u1[q] + w2[q] * u2[q]); u0[q] = u1[q]; u1[q] = u2[q]; }
        *(GAS v4u*)(Y + (size_t)(t0 + i) * DM + Y_A + c0) = pack8(o); }
}
template <int WIN> __device__ __forceinline__ void pool_wave(const bf16* Z, bf16* Y, int tfirst, int c0) {
    const int s0 = tfirst & (SEQ - 1);
    v4u rp[WIN + 7];
#pragma unroll
    for (int r = 0; r < WIN + 7; ++r) { const bool ok = s0 + r - (WIN - 1) >= 0; rp[r] = *(const GAS v4u*)(Z + (size_t)(tfirst + (ok ? r - (WIN - 1) : 0)) * ZLD + Z_PU + c0); if (!ok) rp[r] = (v4u){0u, 0u, 0u, 0u}; }
    float acc[8], a[8], b[8];
#pragma unroll
    for (int q = 0; q < 8; ++q) acc[q] = 0.f;
#pragma unroll
    for (int r = 0; r < WIN - 1; ++r) { unpack8(rp[r], a);
#pragma unroll
        for (int q = 0; q < 8; ++q) acc[q] += a[q]; }
#pragma unroll
    for (int i = 0; i < 8; ++i) { unpack8(rp[i + WIN - 1], a);
#pragma unroll
        for (int q = 0; q < 8; ++q) acc[q] += a[q];
        const int cnt = (s0 + i + 1) < WIN ? (s0 + i + 1) : WIN; const float inv = 1.0f / (float)cnt; float o[8];
#pragma unroll
        for (int q = 0; q < 8; ++q) o[q] = acc[q] * inv - a[q];
        *(GAS v4u*)(Y + (size_t)(tfirst + i) * DM + Y_B + c0) = pack8(o);
        unpack8(rp[i], b);
#pragma unroll
        for (int q = 0; q < 8; ++q) acc[q] -= b[q]; }
}
__device__ __forceinline__ void pool_item(Ctx& C, int item) {
    const bf16* Z = (const bf16*)(C.wsp() + WS_Z); bf16* Y = (bf16*)(C.wsp() + WS_Y);
    const int g = C.wave & 3, c0 = g * 128 + (C.lane & 15) * 8, tfirst = item * 64 + (C.wave >> 2) * 32 + (C.lane >> 4) * 8;
    if (g == 0) pool_wave<2>(Z, Y, tfirst, c0); else if (g == 1) pool_wave<4>(Z, Y, tfirst, c0); else if (g == 2) pool_wave<8>(Z, Y, tfirst, c0); else pool_wave<16>(Z, Y, tfirst, c0);
}
__device__ __forceinline__ void foxprep_item(Ctx& C, int l, int item) {
    const bf16* Z = (const bf16*)(C.wsp() + WS_Z); bf16* QN = (bf16*)(C.wsp() + WS_QN); bf16* KN = (bf16*)(C.wsp() + WS_KN);
    LAS unsigned short* T = (LAS unsigned short*)C.scr;
    const int t0 = item * 64, b = t0 >> 11, s0 = t0 & (SEQ - 1);
    const int d0 = (C.lane & 15) * 8; float gq[8], gk[8];
#pragma unroll
    for (int q = 0; q < 8; ++q) { gq[q] = C.inp(9)[l * 128 + d0 + q] * QSCALE; gk[q] = C.inp(10)[l * 128 + d0 + q]; }
    v4u rq[8], rk[8];
#pragma unroll
    for (int i = 0; i < 8; ++i) { const int ch = C.tid + NT * i, tok = ch >> 6, c8 = (ch & 63) * 8; const bf16* zr = Z + (size_t)(t0 + tok) * ZLD + c8;
        rq[i] = __builtin_nontemporal_load((const GAS v4u*)(zr + Z_FQ)); rk[i] = __builtin_nontemporal_load((const GAS v4u*)(zr + Z_FK)); }
#pragma unroll
    for (int i = 0; i < 8; ++i) { const int ch = C.tid + NT * i, tok = ch >> 6, c8 = (ch & 63) * 8; float a[8];
#pragma unroll
        for (int which = 0; which < 2; ++which) {
            unpack8(which ? rk[i] : rq[i], a);
            float ss = 0.f;
#pragma unroll
            for (int q = 0; q < 8; ++q) ss += a[q] * a[q];
            ss = sum16(ss);
            const float rstd = __builtin_amdgcn_rsqf(ss * (1.0f / 128.0f) + EPS);
#pragma unroll
            for (int q = 0; q < 8; ++q) a[q] = a[q] * rstd * (which ? gk[q] : gq[q]);
            if (which) *(LAS v4u*)(T + tok * 520 + c8) = pack8(a); else *(GAS v4u*)(QN + (size_t)(t0 + tok) * 512 + c8) = pack8(a); } }
    __syncthreads();
#pragma unroll
    for (int i = 0; i < 8; ++i) { const int oc = C.tid + NT * i, ln = oc & 63, ds = (oc >> 6) & 7, blk = (oc >> 9) & 1, h = oc >> 10;
        const v4u w = *(const LAS v4u*)(T + (blk * 32 + (ln & 31)) * 520 + h * 128 + ds * 16 + (ln >> 5) * 8);
        *(GAS v4u*)(KN + ((((size_t)(b * 4 + h) * 64 + (s0 >> 5) + blk) * 8 + ds) * 64 + ln) * 8) = w; }
    __syncthreads();
}
__device__ __forceinline__ float fls(float x) { const float e = __builtin_amdgcn_exp2f(-fabsf(x) * LOG2E); return fminf(x, 0.f) - 0.6931471805599453f * __builtin_amdgcn_logf(1.0f + e); }
__device__ __forceinline__ void fscan_item(Ctx& C, int l, int item) {
    const float* ZS = (const float*)(C.wsp() + WS_ZS); float* FB = (float*)(C.wsp() + WS_FB); LAS float* WTOT = (LAS float*)C.scr;
    const int b = item >> 2, h = item & 3; const float bf = C.inp(11)[l * 4 + h];
    const int s0 = C.tid * 4; float v[4]; float run = 0.f;
#pragma unroll
    for (int j = 0; j < 4; ++j) { run += fls(ZS[(size_t)(b * SEQ + s0 + j) * 32 + 16 + h] + bf); v[j] = run; }
    float inc = run;
#pragma unroll
    for (int o = 1; o < 64; o <<= 1) { const float nb = __shfl_up(inc, o); if (C.lane >= o) inc += nb; }
    if (C.lane == 63) WTOT[C.wave] = inc;
    __syncthreads();
    float excl = inc - run;
    for (int w = 0; w < C.wave; ++w) excl += WTOT[w];
    *(GAS f32x4*)(FB + (size_t)item * SEQ + s0) = (f32x4){-(v[0] + excl) * LOG2E, -(v[1] + excl) * LOG2E, -(v[2] + excl) * LOG2E, -(v[3] + excl) * LOG2E};
    __syncthreads();
}
__device__ __forceinline__ void gla_scan_item(Ctx& C, int item) {
    if (C.tid >= 128) return;
    const float* LOC = (const float*)(C.wsp() + WS_LOC); const float* EL = (const float*)(C.wsp() + WS_ELAST); float* SST = (float*)(C.wsp() + WS_SST);
    const int c = (item * 128 + C.tid) * 4, bh = c >> 13, kv = c & 8191, k = kv >> 7, b = bh >> 2, h = bh & 3;
    f32x4 st = {0.f, 0.f, 0.f, 0.f};
#pragma unroll
    for (int n0 = 0; n0 < 32; n0 += 16) {
        f32x4 lo[16]; float e[16];
#pragma unroll
        for (int n = 0; n < 16; ++n) { const int unit = (b * 32 + n0 + n) * 4 + h; lo[n] = *(const GAS f32x4*)(LOC + (size_t)unit * 8192 + kv); e[n] = EL[unit * 64 + k]; }
#pragma unroll
        for (int n = 0; n < 16; ++n) { const int unit = (b * 32 + n0 + n) * 4 + h; st16_wt(SST + (size_t)unit * 8192 + kv, __builtin_bit_cast(v4u, st)); st = st * e[n] + lo[n]; }
    }
}
typedef float f32x16 __attribute__((ext_vector_type(16)));
__device__ __forceinline__ void vtprep_item(Ctx& C, int item) {
    const bf16* Z = (const bf16*)(C.wsp() + WS_Z); bf16* VF = (bf16*)(C.wsp() + WS_VT);
    LAS unsigned short* T = (LAS unsigned short*)C.scr;
    const int t0 = item * 64, b = t0 >> 11, kt = (t0 & (SEQ - 1)) >> 6;
#pragma unroll
    for (int i = 0; i < 8; ++i) { const int ch = C.tid + NT * i, tok = ch >> 6, c8 = (ch & 63) * 8;
        *(LAS v4u*)(T + tok * 520 + c8) = __builtin_nontemporal_load((const GAS v4u*)(Z + (size_t)(t0 + tok) * ZLD + Z_FV + c8)); }
    __syncthreads();
#pragma unroll
    for (int i = 0; i < 8; ++i) { const int ch = C.tid + NT * i, ln = ch & 63, s = (ch >> 6) & 3, dblk = (ch >> 8) & 3, h = ch >> 10, hx = ln >> 5, li = ln & 15;
        const LAS unsigned short* p = T + (16 * s + 4 * hx + (li >> 2)) * 520 + h * 128 + dblk * 32 + 16 * ((ln >> 4) & 1) + 4 * (li & 3);
        typedef short v4s_t __attribute__((ext_vector_type(4)));
        const v4s_t lo = __builtin_amdgcn_ds_read_tr16_b64_v4i16((LAS v4s_t*)p), hi2 = __builtin_amdgcn_ds_read_tr16_b64_v4i16((LAS v4s_t*)(p + 8 * 520));
        v4u w; w.x = (unsigned short)lo[0] | ((unsigned)(unsigned short)lo[1] << 16); w.y = (unsigned short)lo[2] | ((unsigned)(unsigned short)lo[3] << 16);
        w.z = (unsigned short)hi2[0] | ((unsigned)(unsigned short)hi2[1] << 16); w.w = (unsigned short)hi2[2] | ((unsigned)(unsigned short)hi2[3] << 16);
        *(GAS v4u*)(VF + ((((size_t)(b * 4 + h) * 32 + kt) * 16 + dblk * 4 + s) * 64 + ln) * 8) = w; }
    __syncthreads();
}
__device__ __forceinline__ unsigned cvtpk(float lo, float hi) { typedef float f2 __attribute__((ext_vector_type(2))); typedef __bf16 b2 __attribute__((ext_vector_type(2))); f2 v = {lo, hi}; b2 r = __builtin_convertvector(v, b2); return __builtin_bit_cast(unsigned, r); }
typedef float f32x4m __attribute__((ext_vector_type(4)));
__device__ __forceinline__ float fast_log_sigmoid(float x) { const float e = __builtin_amdgcn_exp2f(-fabsf(x) * LOG2E); return fminf(x, 0.f) - 0.6931471805599453f * __builtin_amdgcn_logf(1.0f + e); }
__device__ __forceinline__ float ex2(float x) { return __builtin_amdgcn_exp2f(x); }
__device__ __forceinline__ void gla_stage_wd(Ctx& C, int l, int h) {
    LAS float* wd = (LAS float*)(C.scr - SCR_OFF + RST_OFF);
    for (int i = C.tid; i < 1024; i += NT) wd[i] = C.inp(6)[l * 4096 + (i >> 6) * 256 + h * 64 + (i & 63)];
    if (C.tid < 64) wd[1024 + C.tid] = C.inp(7)[l * 256 + h * 64 + C.tid];
    __syncthreads();
}
__device__ __forceinline__ void gla_cc8(Ctx& C, int l, int t0, int h, float (&cc)[8], LAS float* WT) {
    const int t = C.tid >> 3, k0 = (C.tid & 7) * 8;
    const float* zs = (const float*)(C.wsp() + WS_ZS) + (size_t)(t0 + t) * 32; const LAS float* wd = (const LAS float*)(C.scr - SCR_OFF + RST_OFF) + k0; const LAS float* bd = wd + 1024;
    float ga[16], x[8];
#pragma unroll
    for (int i = 0; i < 4; ++i) { const f32x4 v = *(const GAS f32x4*)(zs + 4 * i); ga[4 * i] = v.x; ga[4 * i + 1] = v.y; ga[4 * i + 2] = v.z; ga[4 * i + 3] = v.w; }
    { const f32x4 a = *(const LAS f32x4*)bd, b = *(const LAS f32x4*)(bd + 4); x[0] = a.x; x[1] = a.y; x[2] = a.z; x[3] = a.w; x[4] = b.x; x[5] = b.y; x[6] = b.z; x[7] = b.w; }
#pragma unroll
    for (int r = 0; r < 16; ++r) { const f32x4 a = *(const LAS f32x4*)(wd + r * 64), b = *(const LAS f32x4*)(wd + r * 64 + 4);
        x[0] += ga[r] * a.x; x[1] += ga[r] * a.y; x[2] += ga[r] * a.z; x[3] += ga[r] * a.w; x[4] += ga[r] * b.x; x[5] += ga[r] * b.y; x[6] += ga[r] * b.z; x[7] += ga[r] * b.w; }
#pragma unroll
    for (int q = 0; q < 8; ++q) cc[q] = fast_log_sigmoid(x[q]) * (1.0f / 16.0f);
#pragma unroll
    for (int off = 8; off < 64; off <<= 1)
#pragma unroll
        for (int q = 0; q < 8; ++q) { const float nb = __shfl_up(cc[q], off); if (C.lane >= off) cc[q] += nb; }
    if (C.lane >= 56) { *(LAS f32x4*)(WT + C.wave * 64 + k0) = (f32x4){cc[0], cc[1], cc[2], cc[3]}; *(LAS f32x4*)(WT + C.wave * 64 + k0 + 4) = (f32x4){cc[4], cc[5], cc[6], cc[7]}; }
    __syncthreads();
    for (int w = 0; w < C.wave; ++w) { const f32x4 a = *(const LAS f32x4*)(WT + w * 64 + k0), b = *(const LAS f32x4*)(WT + w * 64 + k0 + 4);
        cc[0] += a.x; cc[1] += a.y; cc[2] += a.z; cc[3] += a.w; cc[4] += b.x; cc[5] += b.y; cc[6] += b.z; cc[7] += b.w; }
}
__device__ __forceinline__ void wt_prefix(const LAS float* WT, int k0, int nw, float (&s)[8]) {
#pragma unroll
    for (int q = 0; q < 8; ++q) s[q] = 0.f;
    for (int w = 0; w < nw; ++w) { const f32x4 a = *(const LAS f32x4*)(WT + w * 64 + k0), b = *(const LAS f32x4*)(WT + w * 64 + k0 + 4);
        s[0] += a.x; s[1] += a.y; s[2] += a.z; s[3] += a.w; s[4] += b.x; s[5] += b.y; s[6] += b.z; s[7] += b.w; }
}
__device__ __forceinline__ void gla_load_v(Ctx& C, const bf16* Z, int t0, int h, v4u (&w)[2]) {
#pragma unroll
    for (int i = 0; i < 2; ++i) { const int ch = C.tid + NT * i, t = ch >> 4, v8 = (ch & 15) * 8; w[i] = *(const GAS v4u*)(Z + (size_t)(t0 + t) * ZLD + Z_GV + h * 128 + v8); }
}
__device__ __forceinline__ void gla_write_v(Ctx& C, const v4u (&wv)[2], LAS unsigned short* V) {
#pragma unroll
    for (int i = 0; i < 2; ++i) { const int ch = C.tid + NT * i, t = ch >> 4, v8 = (ch & 15) * 8; *(LAS v4u*)(V + t * 136 + v8) = wv[i]; }
}
typedef short v4i16_t __attribute__((ext_vector_type(4)));
__device__ __forceinline__ bf16x8 tr_frag(const LAS unsigned short* T, int stride, int kbase, int n0, int lane) {
    const int kg = lane >> 4, i = lane & 15;
    const LAS unsigned short* p = T + (kbase + 8 * kg + (i >> 2)) * stride + n0 + 4 * (i & 3);
    const v4i16_t lo = __builtin_amdgcn_ds_read_tr16_b64_v4i16((LAS v4i16_t*)p), hi = __builtin_amdgcn_ds_read_tr16_b64_v4i16((LAS v4i16_t*)(p + 4 * stride));
    return (bf16x8){lo[0], lo[1], lo[2], lo[3], hi[0], hi[1], hi[2], hi[3]};
}
#define GLA_MFMA(a, b, c) __builtin_amdgcn_mfma_f32_16x16x32_bf16(a, b, c, 0, 0, 0)
#define GLA_FRAG(base, row, ks) (*(const LAS bf16x8*)((base) + (row) * 72 + (ks) * 32 + 8 * (C.lane >> 4)))
__device__ __forceinline__ void gla1_mfma_item(Ctx& C, int l, int unit) {
    const bf16* Z = (const bf16*)(C.wsp() + WS_Z); float* LOC = (float*)(C.wsp() + WS_LOC); float* EL = (float*)(C.wsp() + WS_ELAST);
    const int h = unit & 3, n = (unit >> 2) & 31, b = unit >> 7, t0 = b * SEQ + n * 64;
    LAS float* WT = (LAS float*)C.scr; LAS unsigned short* KMD = (LAS unsigned short*)(C.scr + 4096); LAS unsigned short* VV = (LAS unsigned short*)(C.scr + 13312);
    const int t = C.tid >> 3, k0 = (C.tid & 7) * 8;
    float cc[8], last[8], kf[8];
    const v4u kraw = *(const GAS v4u*)(Z + (size_t)(t0 + t) * ZLD + Z_GK + h * 64 + k0); v4u vraw[2]; gla_load_v(C, Z, t0, h, vraw);
    gla_cc8(C, l, t0, h, cc, WT);
    wt_prefix(WT, k0, 8, last);
    unpack8(kraw, kf);
#pragma unroll
    for (int q = 0; q < 8; ++q) kf[q] *= ex2((last[q] - cc[q]) * LOG2E);
    *(LAS v4u*)(KMD + t * 72 + k0) = pack8(kf);
    if (t == 0) { float* e = EL + unit * 64 + k0;
#pragma unroll
        for (int q = 0; q < 8; ++q) e[q] = ex2(last[q] * LOG2E); }
    { float* cs = (float*)(C.wsp() + WS_CC) + ((size_t)unit * 64 + t) * 64 + k0;
        *(GAS f32x4*)cs = (f32x4){cc[0], cc[1], cc[2], cc[3]}; *(GAS f32x4*)(cs + 4) = (f32x4){cc[4], cc[5], cc[6], cc[7]}; }
    gla_write_v(C, vraw, VV);
    __syncthreads();
    const int tm = C.wave >> 1, fr = C.lane & 15, fq = C.lane >> 4;
    const bf16x8 a0 = tr_frag(KMD, 72, 0, 16 * tm, C.lane), a1 = tr_frag(KMD, 72, 32, 16 * tm, C.lane);
#pragma unroll
    for (int i = 0; i < 4; ++i) { const int tn = 4 * (C.wave & 1) + i; f32x4 acc = {0.f, 0.f, 0.f, 0.f};
        acc = GLA_MFMA(a0, tr_frag(VV, 136, 0, 16 * tn, C.lane), acc); acc = GLA_MFMA(a1, tr_frag(VV, 136, 32, 16 * tn, C.lane), acc);
        float* o = LOC + ((size_t)unit * 64 + 16 * tm + 4 * fq) * 128 + 16 * tn + fr;
        o[0] = acc.x; o[128] = acc.y; o[256] = acc.z; o[384] = acc.w; }
    __syncthreads();
}
__device__ __forceinline__ void gla3_mfma_item(Ctx& C, int l, int unit) {
    const bf16* Z = (const bf16*)(C.wsp() + WS_Z); const float* SST = (const float*)(C.wsp() + WS_SST) + (size_t)unit * 8192; bf16* Y = (bf16*)(C.wsp() + WS_Y);
    const int h = unit & 3, n = (unit >> 2) & 31, b = unit >> 7, t0 = b * SEQ + n * 64;
    LAS float* RS = (LAS float*)(C.scr + 2048);
    LAS unsigned short* QP = (LAS unsigned short*)(C.scr + 4096); LAS unsigned short* KM = QP + 4608; LAS unsigned short* QM = KM + 4608; LAS unsigned short* KP = QM + 4608;
    LAS unsigned short* PP = KP + 4608; LAS unsigned short* VV = PP + 4608; LAS unsigned short* STD = VV + 8704; LAS float* OUT = (LAS float*)(C.scr + 84992);
    const int t = C.tid >> 3, k0 = (C.tid & 7) * 8;
    const v4u qraw = *(const GAS v4u*)(Z + (size_t)(t0 + t) * ZLD + Z_GQ + h * 64 + k0), kraw = *(const GAS v4u*)(Z + (size_t)(t0 + t) * ZLD + Z_GK + h * 64 + k0);
    v4u vraw[2]; gla_load_v(C, Z, t0, h, vraw);
    f32x4 sraw[4];
#pragma unroll
    for (int i = 0; i < 4; ++i) { const int ch = C.tid + NT * i; sraw[i] = *(const GAS f32x4*)(SST + (ch >> 5) * 128 + (ch & 31) * 4); }
    v4u graw[2];
    { const bf16* gr = Z + (size_t)(t0 + t) * ZLD + Z_GG + h * 128 + (C.tid & 7) * 16; graw[0] = *(const GAS v4u*)gr; graw[1] = *(const GAS v4u*)(gr + 8); }
    const float* CCu = (const float*)(C.wsp() + WS_CC) + (size_t)unit * 4096;
    f32x4 ccr[2], c0r[2]; float c0s[4];
    ccr[0] = *(const GAS f32x4*)(CCu + t * 64 + k0); ccr[1] = *(const GAS f32x4*)(CCu + t * 64 + k0 + 4); c0r[0] = *(const GAS f32x4*)(CCu + 31 * 64 + k0); c0r[1] = *(const GAS f32x4*)(CCu + 31 * 64 + k0 + 4);
#pragma unroll
    for (int i = 0; i < 4; ++i) c0s[i] = CCu[31 * 64 + ((C.tid + NT * i) >> 5)];
    { float qf[8], kf[8], a[8];
        const float cc[8] = {ccr[0].x, ccr[0].y, ccr[0].z, ccr[0].w, ccr[1].x, ccr[1].y, ccr[1].z, ccr[1].w}, c0[8] = {c0r[0].x, c0r[0].y, c0r[0].z, c0r[0].w, c0r[1].x, c0r[1].y, c0r[1].z, c0r[1].w};
        unpack8(qraw, qf); unpack8(kraw, kf);
        float ep[8], em[8];
#pragma unroll
        for (int q = 0; q < 8; ++q) { ep[q] = ex2((cc[q] - c0[q]) * LOG2E); em[q] = ex2((c0[q] - cc[q]) * LOG2E); qf[q] *= 0.125f; }
#pragma unroll
        for (int q = 0; q < 8; ++q) a[q] = qf[q] * ep[q];
        *(LAS v4u*)(QP + t * 72 + k0) = pack8(a);
#pragma unroll
        for (int q = 0; q < 8; ++q) a[q] = qf[q] * em[q];
        *(LAS v4u*)(QM + t * 72 + k0) = pack8(a);
#pragma unroll
        for (int q = 0; q < 8; ++q) a[q] = kf[q] * em[q];
        *(LAS v4u*)(KM + t * 72 + k0) = pack8(a);
#pragma unroll
        for (int q = 0; q < 8; ++q) a[q] = kf[q] * ep[q];
        *(LAS v4u*)(KP + t * 72 + k0) = pack8(a); }
    gla_write_v(C, vraw, VV);
#pragma unroll
    for (int i = 0; i < 4; ++i) { const int ch = C.tid + NT * i, k = ch >> 5, v4 = (ch & 31) * 4; const f32x4 s = sraw[i];
        const float e = ex2(c0s[i] * LOG2E);
        *(LAS unsigned long long*)(STD + k * 136 + v4) = (unsigned long long)pk2(s.x * e, s.y * e) | ((unsigned long long)pk2(s.z * e, s.w * e) << 32); }
    __syncthreads();
    const int tm = C.wave >> 1, fr = C.lane & 15, fq = C.lane >> 4;
    const bf16x8 qp0 = GLA_FRAG(QP, 16 * tm + fr, 0), qp1 = GLA_FRAG(QP, 16 * tm + fr, 1);
    { const bf16x8 qm0 = GLA_FRAG(QM, 16 * tm + fr, 0), qm1 = GLA_FRAG(QM, 16 * tm + fr, 1);
#pragma unroll
        for (int i = 0; i < 2; ++i) { const int tn = 2 * (C.wave & 1) + i; f32x4 s1 = {0.f, 0.f, 0.f, 0.f}, s2 = {0.f, 0.f, 0.f, 0.f};
            s1 = GLA_MFMA(qp0, GLA_FRAG(KM, 16 * tn + fr, 0), s1); s1 = GLA_MFMA(qp1, GLA_FRAG(KM, 16 * tn + fr, 1), s1);
            s2 = GLA_MFMA(qm0, GLA_FRAG(KP, 16 * tn + fr, 0), s2); s2 = GLA_MFMA(qm1, GLA_FRAG(KP, 16 * tn + fr, 1), s2);
            const int s = 16 * tn + fr;
#pragma unroll
            for (int r = 0; r < 4; ++r) { const int tt = 16 * tm + 4 * fq + r; PP[tt * 72 + s] = (unsigned short)f2bf(s <= tt ? s1[r] : s2[r]); } } }
    __syncthreads();
    f32x4 acc[4];
    { const bf16x8 p0 = GLA_FRAG(PP, 16 * tm + fr, 0), p1 = GLA_FRAG(PP, 16 * tm + fr, 1);
#pragma unroll
        for (int i = 0; i < 4; ++i) { const int tn = 4 * (C.wave & 1) + i; f32x4 a = {0.f, 0.f, 0.f, 0.f};
            a = GLA_MFMA(p0, tr_frag(VV, 136, 0, 16 * tn, C.lane), a); a = GLA_MFMA(p1, tr_frag(VV, 136, 32, 16 * tn, C.lane), a);
            a = GLA_MFMA(qp0, tr_frag(STD, 136, 0, 16 * tn, C.lane), a); a = GLA_MFMA(qp1, tr_frag(STD, 136, 32, 16 * tn, C.lane), a); acc[i] = a; } }
#pragma unroll
    for (int r = 0; r < 4; ++r) { float ss = (acc[0][r] * acc[0][r] + acc[1][r] * acc[1][r]) + (acc[2][r] * acc[2][r] + acc[3][r] * acc[3][r]);
        ss = sum16(ss);
        if (fr == 0) RS[(16 * tm + 4 * fq + r) * 2 + (C.wave & 1)] = ss; }
    __syncthreads();
#pragma unroll
    for (int r = 0; r < 4; ++r) { const int tt = 16 * tm + 4 * fq + r; const float rstd = 1.0f / sqrtf((RS[tt * 2] + RS[tt * 2 + 1]) * (1.0f / 128.0f) + EPS);
#pragma unroll
        for (int i = 0; i < 4; ++i) OUT[tt * 132 + 16 * (4 * (C.wave & 1) + i) + fr] = acc[i][r] * rstd; }
    __syncthreads();
    { const int v0 = (C.tid & 7) * 16; bf16* yo = Y + (size_t)(t0 + t) * DM + Y_C + h * 128 + v0; const float* og = C.inp(8) + l * 128 + v0;
#pragma unroll
        for (int hh = 0; hh < 2; ++hh) { float g[8], f8[8]; unpack8(graw[hh], g);
            const f32x4 o0 = *(const LAS f32x4*)(OUT + t * 132 + v0 + hh * 8), o1 = *(const LAS f32x4*)(OUT + t * 132 + v0 + hh * 8 + 4);
            const float ov[8] = {o0.x, o0.y, o0.z, o0.w, o1.x, o1.y, o1.z, o1.w};
#pragma unroll
            for (int q = 0; q < 8; ++q) f8[q] = ov[q] * og[hh * 8 + q] * (g[q] * __builtin_amdgcn_rcpf(1.0f + ex2(-LOG2E * g[q])));
            *(GAS v4u*)(yo + hh * 8) = pack8(f8); } }
    __syncthreads();
}
constexpr int FOX_SLOT = 33024;
constexpr size_t WS_PO = 404 * MiB, WS_ML = 420 * MiB, WS_END2 = 421 * MiB;
__device__ __forceinline__ void glds16(const void* gsrc, unsigned lds_dst) { unsigned keep;
    asm volatile("s_mov_b32 %0, m0\n\ts_mov_b32 m0, %2\n\ts_nop 0\n\tglobal_load_lds_dwordx4 %1, off\n\ts_mov_b32 m0, %0" : "=&s"(keep) : "v"(gsrc), "s"(lds_dst) : "memory"); }
__device__ __forceinline__ void glds4(const void* gsrc, unsigned lds_dst) { unsigned keep;
    asm volatile("s_mov_b32 %0, m0\n\ts_mov_b32 m0, %2\n\ts_nop 0\n\tglobal_load_lds_dword %1, off\n\ts_mov_b32 m0, %0" : "=&s"(keep) : "v"(gsrc), "s"(lds_dst) : "memory"); }
#define FOX_WAIT_BAR(N) asm volatile("s_waitcnt vmcnt(" #N ") lgkmcnt(0)\n\ts_barrier" ::: "memory")
__device__ __forceinline__ void fox_dma(const char* kf, const char* vf, const char* fb, int t, unsigned slot_lds, int wave, int lane) {
    const char* kt = kf + (size_t)t * 16384 + lane * 16; const char* vt = vf + (size_t)t * 16384 + lane * 16;
    glds16(kt + wave * 1024, (unsigned)__builtin_amdgcn_readfirstlane(slot_lds + wave * 1024));
    glds16(kt + (wave + 8) * 1024, (unsigned)__builtin_amdgcn_readfirstlane(slot_lds + (wave + 8) * 1024));
    glds16(vt + wave * 1024, (unsigned)__builtin_amdgcn_readfirstlane(slot_lds + 16384 + wave * 1024));
    glds16(vt + (wave + 8) * 1024, (unsigned)__builtin_amdgcn_readfirstlane(slot_lds + 16384 + (wave + 8) * 1024));
    glds4(fb + (size_t)t * 256 + lane * 4, (unsigned)__builtin_amdgcn_readfirstlane(slot_lds + 32768));
}
__device__ __forceinline__ void fox_seg(Ctx& C, int b, int h, int qb, int t0, int t1, int pidx, gu32* pub = nullptr) {
    const bf16* QN = (const bf16*)(C.wsp() + WS_QN); const int bh = b * 4 + h;
    const char* kf = (const char*)(C.wsp() + WS_KN) + (size_t)bh * 64 * 8192; const char* vf = (const char*)(C.wsp() + WS_VT) + (size_t)bh * 32 * 16384;
    const char* fb = (const char*)((const float*)(C.wsp() + WS_FB) + (size_t)bh * SEQ);
    const int lane = C.lane, r32 = lane & 31, hi = lane >> 5, w = C.wave, n = t1 - t0;
    LAS unsigned char* ring = C.scr; const unsigned ring_lds = (unsigned)(uintptr_t)ring;
    LAS float* WSF = (LAS float*)(ring + 3 * FOX_SLOT) + w * 32;
    const int tq0 = b * SEQ + qb * 256 + w * 32;
    bf16x8 qf[8];
#pragma unroll
    for (int ds = 0; ds < 8; ++ds) qf[ds] = *(const GAS bf16x8*)(QN + (size_t)(tq0 + r32) * 512 + h * 128 + ds * 16 + hi * 8);
    asm volatile("" ::: "memory");
    fox_dma(kf, vf, fb, t0, ring_lds, w, lane);
    if (n > 1) fox_dma(kf, vf, fb, t0 + 1, ring_lds + FOX_SLOT, w, lane);
    f32x16 o[4];
#pragma unroll
    for (int d = 0; d < 4; ++d)
#pragma unroll
        for (int r = 0; r < 16; ++r) o[d][r] = 0.f;
    float m = -1e30f, lsum = 0.f;
    const int kmax = 4 * qb + (w >> 1);
    int sc = 0;
    for (int i = 0; i < n; ++i) {
        if (i == 0 && pub != nullptr) { FOX_WAIT_BAR(0);
            if (C.tid == 0) __hip_atomic_fetch_add(pub, 1u, __ATOMIC_RELAXED, __HIP_MEMORY_SCOPE_AGENT); }
        else if (i + 1 < n) FOX_WAIT_BAR(5); else FOX_WAIT_BAR(0);
        if (i + 2 < n) fox_dma(kf, vf, fb, t0 + i + 2, ring_lds + (unsigned)((sc + 2) % 3) * FOX_SLOT, w, lane);
        const int kt = t0 + i;
        if (kt <= kmax) {
            const LAS unsigned char* slot = ring + sc * FOX_SLOT + lane * 16; const LAS float* fbs = (const LAS float*)(ring + sc * FOX_SLOT + 32768);
            bf16x8 kfr[16];
#pragma unroll
            for (int ds = 0; ds < 8; ++ds) { kfr[2 * ds] = *(const LAS bf16x8*)(slot + ds * 1024); kfr[2 * ds + 1] = *(const LAS bf16x8*)(slot + (8 + ds) * 1024); }
            f32x16 p0, p1;
#pragma unroll
            for (int g4 = 0; g4 < 4; ++g4) { const f32x4 a = *(const LAS f32x4*)(fbs + 8 * g4 + 4 * hi), bq = *(const LAS f32x4*)(fbs + 32 + 8 * g4 + 4 * hi);
                p0[4 * g4] = a.x; p0[4 * g4 + 1] = a.y; p0[4 * g4 + 2] = a.z; p0[4 * g4 + 3] = a.w; p1[4 * g4] = bq.x; p1[4 * g4 + 1] = bq.y; p1[4 * g4 + 2] = bq.z; p1[4 * g4 + 3] = bq.w; }
            __builtin_amdgcn_sched_barrier(0);
#pragma unroll
            for (int ds = 0; ds < 8; ++ds) { p0 = __builtin_amdgcn_mfma_f32_32x32x16_bf16(kfr[2 * ds], qf[ds], p0, 0, 0, 0); p1 = __builtin_amdgcn_mfma_f32_32x32x16_bf16(kfr[2 * ds + 1], qf[ds], p1, 0, 0, 0); }
            __builtin_amdgcn_sched_barrier(0);
            bf16x8 va[8], vb[8];
#pragma unroll
            for (int q = 0; q < 8; ++q) va[q] = *(const LAS bf16x8*)(slot + 16384 + q * 1024);
            __builtin_amdgcn_sched_barrier(0);
            if (kt == kmax) { const int qrel = (w & 1) * 32 + r32;
#pragma unroll
                for (int r = 0; r < 16; ++r) { const int kr = (r & 3) + 8 * (r >> 2) + 4 * hi; if (kr > qrel) p0[r] = -1e30f; if (kr + 32 > qrel) p1[r] = -1e30f; } }
            float mx = fmaxf(p0[0], p1[0]);
#pragma unroll
            for (int r = 1; r < 16; ++r) mx = fmaxf(mx, fmaxf(p0[r], p1[r]));
            mx = fmaxf(mx, __shfl_xor(mx, 32));
            const float mnew = fmaxf(m, mx), f = __builtin_amdgcn_exp2f(m - mnew); m = mnew;
            float rs = 0.f;
#pragma unroll
            for (int r = 0; r < 16; ++r) { p0[r] = __builtin_amdgcn_exp2f(p0[r] - mnew); p1[r] = __builtin_amdgcn_exp2f(p1[r] - mnew); rs += p0[r] + p1[r]; }
            lsum = lsum * f + rs;
            if (!__all(f == 1.0f)) {
                if (hi == 0) WSF[r32] = f;
#pragma unroll
                for (int g4 = 0; g4 < 4; ++g4) { const f32x4 ff = *(const LAS f32x4*)(WSF + 8 * g4 + 4 * hi);
#pragma unroll
                    for (int d = 0; d < 4; ++d) { o[d][4 * g4] *= ff.x; o[d][4 * g4 + 1] *= ff.y; o[d][4 * g4 + 2] *= ff.z; o[d][4 * g4 + 3] *= ff.w; } }
            }
            u32x4v pa[4];
#pragma unroll
            for (int q = 0; q < 4; ++q) { pa[0][q] = cvtpk(p0[2 * q], p0[2 * q + 1]); pa[1][q] = cvtpk(p0[8 + 2 * q], p0[9 + 2 * q]); pa[2][q] = cvtpk(p1[2 * q], p1[2 * q + 1]); pa[3][q] = cvtpk(p1[8 + 2 * q], p1[9 + 2 * q]); }
            __builtin_amdgcn_sched_barrier(0);
#pragma unroll
            for (int q = 0; q < 8; ++q) vb[q] = *(const LAS bf16x8*)(slot + 16384 + (8 + q) * 1024);
            __builtin_amdgcn_sched_barrier(0);
#pragma unroll
            for (int d = 0; d < 2; ++d)
#pragma unroll
                for (int s = 0; s < 4; ++s) o[d] = __builtin_amdgcn_mfma_f32_32x32x16_bf16(__builtin_bit_cast(bf16x8, pa[s]), va[d * 4 + s], o[d], 0, 0, 0);
#pragma unroll
            for (int d = 0; d < 2; ++d)
#pragma unroll
                for (int s = 0; s < 4; ++s) o[d + 2] = __builtin_amdgcn_mfma_f32_32x32x16_bf16(__builtin_bit_cast(bf16x8, pa[s]), vb[d * 4 + s], o[d + 2], 0, 0, 0);
        }
        sc = (sc == 2) ? 0 : sc + 1;
    }
    lsum += __shfl_xor(lsum, 32);
    FOX_WAIT_BAR(0);
    { const float inv = lsum > 0.f ? 1.0f / lsum : 0.f; if (hi == 0) WSF[r32] = inv; }
    LAS unsigned short* stg = (LAS unsigned short*)(ring + w * 8192);
#pragma unroll
    for (int g4 = 0; g4 < 4; ++g4) { const f32x4 ww = *(const LAS f32x4*)(WSF + 8 * g4 + 4 * hi);
#pragma unroll
        for (int i = 0; i < 4; ++i) { const int q = 8 * g4 + 4 * hi + i; const float wq = i == 0 ? ww.x : i == 1 ? ww.y : i == 2 ? ww.z : ww.w;
#pragma unroll
            for (int d = 0; d < 4; ++d) stg[q * 128 + d * 32 + r32] = (unsigned short)f2bf(o[d][4 * g4 + i] * wq); } }
    bf16* dst; size_t ld;
    if (pidx < 0) { dst = (bf16*)(C.wsp() + WS_Y) + (size_t)tq0 * DM + Y_D + h * 128; ld = DM; }
    else { dst = (bf16*)(C.wsp() + WS_PO) + ((size_t)(bh * 16 + pidx) * 256 + w * 32) * 128; ld = 128;
        if (hi == 0) { float* ml = (float*)(C.wsp() + WS_ML) + ((size_t)(bh * 16 + pidx) * 256 + w * 32 + r32) * 2; __hip_atomic_store((unsigned long long*)ml, (unsigned long long)__float_as_uint(m) | ((unsigned long long)__float_as_uint(lsum) << 32), __ATOMIC_RELAXED, __HIP_MEMORY_SCOPE_AGENT); } }
#pragma unroll
    for (int i = 0; i < 8; ++i) { const int row = i * 4 + (lane >> 4), ch = lane & 15; const v4u vv = *(const LAS v4u*)(stg + row * 128 + ch * 8);
        if (pidx < 0) *(GAS v4u*)(dst + (size_t)row * ld + ch * 8) = vv; else st16_wt(dst + (size_t)row * ld + ch * 8, vv); }
    FOX_WAIT_BAR(0);
}
__device__ __forceinline__ void fox_wg(Ctx& C, int b, int h, int i, gu32* pub = nullptr) {
    const int nseg = (i == 13 || i == 15) ? 2 : 1;
    for (int s = 0; s < nseg; ++s) {
        int qb, t0, t1, pidx = i;
        if (s == 1) { qb = i == 13 ? 0 : 1; t0 = 0; t1 = i == 13 ? 4 : 8; pidx = -1; }
        else if (i < 4) { qb = 7; t0 = 8 * i; t1 = t0 + 8; }
        else if (i < 7) { qb = 6; t0 = i == 4 ? 0 : i == 5 ? 10 : 19; t1 = i == 4 ? 10 : i == 5 ? 19 : 28; }
        else if (i < 10) { qb = 5; t0 = 8 * (i - 7); t1 = t0 + 8; }
        else if (i < 12) { qb = 4; t0 = 10 * (i - 10); t1 = t0 + 10; }
        else if (i < 14) { qb = 3; t0 = i == 12 ? 0 : 10; t1 = i == 12 ? 10 : 16; }
        else { qb = 2; t0 = i == 14 ? 0 : 10; t1 = i == 14 ? 10 : 12; }
        fox_seg(C, b, h, qb, t0, t1, pidx, s == 0 ? pub : nullptr);
    }
}
__device__ __forceinline__ void fox_combine_item(Ctx& C, int item) {
    const int bh = item / 24, r = item % 24, ui = r >> 2, chunk = r & 3, qb = 2 + ui;
    const int pb = ui == 0 ? 14 : ui == 1 ? 12 : ui == 2 ? 10 : ui == 3 ? 7 : ui == 4 ? 4 : 0, np = ui < 3 ? 2 : ui < 5 ? 3 : 4;
    const bf16* PO = (const bf16*)(C.wsp() + WS_PO); const float* ML = (const float*)(C.wsp() + WS_ML); bf16* Y = (bf16*)(C.wsp() + WS_Y);
    const int row = chunk * 64 + (C.tid >> 3), col0 = (C.tid & 7) * 16;
    float mm[4], ll[4], ms = -1e30f;
#pragma unroll
    for (int p = 0; p < 4; ++p) { if (p < np) { const float* ml = ML + ((size_t)(bh * 16 + pb + p) * 256 + row) * 2; mm[p] = ml[0]; ll[p] = ml[1]; } else { mm[p] = -1e30f; ll[p] = 0.f; } ms = fmaxf(ms, mm[p]); }
    float L = 0.f;
#pragma unroll
    for (int p = 0; p < 4; ++p) { ll[p] *= __builtin_amdgcn_exp2f(mm[p] - ms); L += ll[p]; }
    const float invL = 1.0f / L; float acc[16];
#pragma unroll
    for (int q = 0; q < 16; ++q) acc[q] = 0.f;
#pragma unroll
    for (int p = 0; p < 4; ++p) { if (p < np) { const bf16* po = PO + ((size_t)(bh * 16 + pb + p) * 256 + row) * 128 + col0; const float wgt = ll[p] * invL; float a[8], bq[8];
        unpack8(*(const GAS v4u*)po, a); unpack8(*(const GAS v4u*)(po + 8), bq);
#pragma unroll
        for (int q = 0; q < 8; ++q) { acc[q] += wgt * a[q]; acc[8 + q] += wgt * bq[q]; } } }
    bf16* yo = Y + (size_t)((bh >> 2) * SEQ + qb * 256 + row) * DM + Y_D + (bh & 3) * 128 + col0; float f8[8];
#pragma unroll
    for (int hh = 0; hh < 2; ++hh) {
#pragma unroll
        for (int q = 0; q < 8; ++q) f8[q] = acc[hh * 8 + q];
        *(GAS v4u*)(yo + hh * 8) = pack8(f8); }
}
#define FOX_UNIT fox_mfma_unit
#define GLA1_ITEM gla1_mfma_item
#define GLA3_ITEM gla3_mfma_item
#ifndef WGM_IN
#define WGM_IN 2
#endif
#ifndef WGM_GU
#define WGM_GU 2
#endif
#ifndef WGM_OUT
#define WGM_OUT 2
#endif
#ifndef WGM_DN
#define WGM_DN 2
#endif
#define ITEM_CTX() do { int t_ = C.tid; asm volatile("" : "+v"(t_)); C.tid = t_; C.lane = t_ & 63; } while (0)
__device__ __forceinline__ void gla3_touch(Ctx& C, int unit) {
    const bf16* Z = (const bf16*)(C.wsp() + WS_Z); const char* SST = (const char*)((const float*)(C.wsp() + WS_SST) + (size_t)unit * 8192); const char* CCu = (const char*)((const float*)(C.wsp() + WS_CC) + (size_t)unit * 4096);
    const int h = unit & 3, n = (unit >> 2) & 31, b = unit >> 7, t0 = b * SEQ + n * 64, tid = C.tid;
    const unsigned sink = (unsigned)__builtin_amdgcn_readfirstlane((int)((unsigned)(uintptr_t)(C.scr - SCR_OFF + RST_OFF) + (unsigned)C.wave * 512u));
    const char* zq = (const char*)(Z + (size_t)(t0 + (tid & 63)) * ZLD + (tid < 448 ? Z_GQ : Z_GK) + h * 64);
    const char* p0 = tid < 256 ? SST + tid * 128 : tid < 384 ? CCu + (tid - 256) * 128 : zq;
    glds4(p0, sink);
    if (tid < 256) glds4((const char*)(Z + (size_t)(t0 + (tid & 63)) * ZLD + (tid < 128 ? Z_GV : Z_GG) + h * 128 + ((tid >> 6) & 1) * 64), sink + 256u);
}
__device__ __forceinline__ Ctx mk_ctx(LAS unsigned char* ldsbase) {
    Ctx C; KArgs ka = (KArgs)__builtin_amdgcn_kernarg_segment_ptr(); asm volatile("" : "+s"(ka)); C.ka = ka;
    int tid = threadIdx.x; asm volatile("" : "+v"(tid)); int G = gridDim.x, bid = blockIdx.x; asm volatile("" : "+s"(G), "+s"(bid));
    C.scr = ldsbase + SCR_OFF; C.tid = tid; C.lane = tid & 63; C.wave = __builtin_amdgcn_readfirstlane(tid >> 6); C.G = G; C.bid = bid; return C;
}
__global__ void __launch_bounds__(NT, 2) trunk_fwd(Args args_unused) {
    extern __shared__ __attribute__((aligned(16))) unsigned char lds[];
    volatile LAS unsigned* MISC = (volatile LAS unsigned*)((LAS unsigned char*)lds + MISC_OFF);
    for (int u = threadIdx.x; u < SCR_OFF / 4; u += NT) MISC[u] = 0u;
    __syncthreads();
    int ph_lo, ph_hi; XcdBarrier bar;
    { Ctx C = mk_ctx((LAS unsigned char*)lds); ph_lo = C.k()->ph_lo; ph_hi = C.k()->ph_hi;
      bar.bar = (unsigned*)((gu32*)(C.wsp() + WS_CTL) + CW_BAR); bar.x = 0; bar.st = nullptr;
      if (ph_hi - ph_lo > 1) bar = xcd_barrier_post((unsigned*)((gu32*)(C.wsp() + WS_CTL) + CW_BAR), MISC + 8); }
    PG8_LAS unsigned char* ring = (PG8_LAS unsigned char*)lds + SCR_OFF;

#ifndef REP_MASK
#define REP_MASK 0
#endif
    for (int ph = ph_lo; ph < ph_hi; ++ph)
    for (int rep = 0; rep < (REP_MASK != 0 && ((REP_MASK >> (ph == 0 ? 0 : 1 + (ph - 1) % 7)) & 1) ? 2 : 1); ++rep) {
        if (ph > 0 && (ph - 1) % 7 == 3) continue;
        int l = (ph - 1) / 7, sub = ph == 0 ? -1 : (ph - 1) % 7; asm volatile("" : "+s"(l), "+s"(sub));
        Ctx C = mk_ctx((LAS unsigned char*)lds);
        if (sub < 0) {
            p0_prologue(C);
        } else if (sub == 0) {
            unsigned char* ws = C.wsp();
            pg8::Gemm g{(const bf16*)(ws + WS_XB), (const bf16*)(ws + WS_WIN + l * WIN_BYTES), M, ZN, DM}; pg8::StaticOrder S; S.init(M, ZN, C.G, C.bid, WGM_IN);
            pg8::EpiZ E{(bf16*)(ws + WS_Z), (float*)(ws + WS_ZS), (const PG8_LAS float*)((PG8_LAS unsigned char*)lds + RST_OFF), (const unsigned long long*)(ws + WS_SSQ) + (size_t)(2 * l) * M + (C.bid & 7) * 1024};
            pg8::gemm_phase<pg8::EpiZ, pg8::StaticOrder, true, true>(ring, g, S, E);
#ifndef CV_ALL_IN_PROLOGUE
            { const int gu1 = CV_PER_LAYER + CV_FIRST + GU1_KEEP;
            if (l == 0) convert_in_tail(C, (M / 256) * (ZN / 256), CV_FIRST + I_GU - GU0_T, CV_PER_LAYER, gu1, gu1 + GU1_A);
            else convert_in_tail(C, (M / 256) * (ZN / 256), gu1 + GU1_A + GU1_B, gu1 + GU1_A + GU1_B + GU1_C, CV_PER_LAYER + I_IN + I_TAIL + I_POOL, CV_PER_LAYER + CV_FIRST); }
#endif
        } else if (sub == 1) {
            gla_stage_wd(C, l, C.bid & 3);
            for (int it = C.bid; it < 1040; it += C.G) {
                ITEM_CTX();
                if (it < 512) GLA1_ITEM(C, l, it);
                else if (it < 640) conv_item(C, l, it - 512);
                else if (it < 768) pool_item(C, it - 640);
                else if (it < 896) vtprep_item(C, it - 768);
                else if (it < 1024) foxprep_item(C, l, it - 896);
                else fscan_item(C, l, it - 1024);
            }
        } else if (sub == 2) {
            gu32* scan_cnt = (gu32*)(C.wsp() + WS_CTL) + CW_SCAN + 64 * l;
            for (int it = C.bid; it < 256; it += C.G) { ITEM_CTX(); gla_scan_item(C, it); }
            bool scan_pub = false;
            for (int it = C.bid; it < 256; it += C.G) { ITEM_CTX(); const int v = (it & 7) * 32 + (it >> 3), bh = v >> 4; fox_wg(C, bh >> 2, bh & 3, v & 15, scan_pub ? nullptr : scan_cnt); scan_pub = true; }
            if (!scan_pub) { asm volatile("s_waitcnt vmcnt(0)" ::: "memory"); __syncthreads(); if (C.tid == 0) __hip_atomic_fetch_add(scan_cnt, 1u, __ATOMIC_RELAXED, __HIP_MEMORY_SCOPE_AGENT); }
            gu32* fox_cnt = (gu32*)(C.wsp() + WS_CTL) + CW_SCAN + 1024 + 64 * l;
            asm volatile("s_waitcnt vmcnt(0)" ::: "memory"); __syncthreads();
            if (C.tid == 0) __hip_atomic_fetch_add(fox_cnt, 1u, __ATOMIC_RELAXED, __HIP_MEMORY_SCOPE_AGENT);
            if (C.tid == 0) { unsigned sp = 0;
                while (__hip_atomic_load(scan_cnt, __ATOMIC_RELAXED, __HIP_MEMORY_SCOPE_AGENT) < (unsigned)(C.G < 256 ? C.G : 256)) { __builtin_amdgcn_s_sleep(2); if (++sp > (1u << 22)) break; }
                __builtin_amdgcn_fence(__ATOMIC_ACQUIRE, "agent"); asm volatile("s_waitcnt vmcnt(0)" ::: "memory"); }
            __syncthreads();
            for (int it = C.bid; it < 512; it += C.G) { ITEM_CTX(); if (it + C.G < 512) gla3_touch(C, it + C.G); GLA3_ITEM(C, l, it); }
            if (C.tid == 0) { unsigned sp = 0;
                while (__hip_atomic_load(fox_cnt, __ATOMIC_RELAXED, __HIP_MEMORY_SCOPE_AGENT) < (unsigned)(C.G < 256 ? C.G : 256)) { __builtin_amdgcn_s_sleep(2); if (++sp > (1u << 22)) break; }
                __builtin_amdgcn_fence(__ATOMIC_ACQUIRE, "agent"); asm volatile("s_waitcnt vmcnt(0)" ::: "memory"); }
            __syncthreads();
            for (int it = C.bid; it < 384; it += C.G) { ITEM_CTX(); fox_combine_item(C, it); }
        } else if (sub == 3) {
        } else if (sub == 5) {
            unsigned char* ws = C.wsp();
            pg8::Gemm g{(const bf16*)(ws + WS_XB), (const bf16*)(ws + WS_WGU + l * WGU_BYTES), M, GUN, DM}; pg8::StaticOrder S; S.init(M, GUN, C.G, C.bid, WGM_GU);
            pg8::EpiSwiglu E{(bf16*)(ws + WS_H), (const PG8_LAS float*)((PG8_LAS unsigned char*)lds + RST_OFF), (const unsigned long long*)(ws + WS_SSQ) + (size_t)(2 * l + 1) * M + (C.bid & 7) * 1024};
            pg8::gemm_phase<pg8::EpiSwiglu, pg8::StaticOrder, true, true>(ring, g, S, E);
            if (l == 0) warm_in_tail(C, (M / 256) * (GUN / 256), C.wsp() + WS_WDN + l * WDN_BYTES, WDN_BYTES);
            else convert_in_tail(C, (M / 256) * (GUN / 256), CV_PER_LAYER + CV_FIRST + I_GU, 2 * CV_PER_LAYER);
#ifndef CV_ALL_IN_PROLOGUE
            if (l == 0) convert_in_tail(C, (M / 256) * (GUN / 256), CV_PER_LAYER, CV_PER_LAYER + I_IN + I_TAIL + I_POOL, CV_PER_LAYER + CV_FIRST + GU1_KEEP + GU1_A, CV_PER_LAYER + CV_FIRST + GU1_KEEP + GU1_A + GU1_B);
#endif
        } else {
            unsigned char* ws = C.wsp(); const bool dn = sub == 6;
            pg8::Gemm g{(const bf16*)(ws + (dn ? WS_H : WS_Y)), (const bf16*)(ws + (dn ? WS_WDN + l * WDN_BYTES : WS_WOUT + l * WOUT_BYTES)), M, DM, dn ? DFF : DM};
            pg8::StaticOrder S; S.init(M, DM, C.G, C.bid, dn ? WGM_DN : WGM_OUT);
            const int fin = (dn && l + 1 == DEPTH) ? 1 : 0;
            pg8::EpiRes E{C.outp(), (bf16*)(ws + WS_XB), (unsigned long long*)(ws + WS_SSQ) + (size_t)(dn ? 2 * l + 2 : 2 * l + 1) * M, fin ? 0 : 1, fin, (PG8_LAS unsigned char*)lds + RST_OFF};
            pg8::gemm_phase<pg8::EpiRes, pg8::StaticOrder, false, true>(ring, g, S, E);
        }
        if (ph + 1 < ph_hi || rep == 0 && REP_MASK != 0) xcd_barrier(bar);
    }
}

extern "C" void kernel_launch(void* const* d_in, const int* in_sizes, int n_in, void* d_out, int out_size, void* d_ws, size_t ws_size, hipStream_t stream) {
    static int grid = 0;
    if (grid == 0) {
        if (n_in != 17 || in_sizes[0] != M * DM || out_size != M * DM || ws_size < WS_END2) { fprintf(stderr, "kernel_launch: unexpected shapes (n_in %d, in0 %d, out %d, ws %zu); nothing launched\n", n_in, n_in > 0 ? in_sizes[0] : -1, out_size, ws_size); grid = -1; return; }
        int dev = 0, cus = 0, per_cu = 0;
        if (hipGetDevice(&dev) != hipSuccess || hipDeviceGetAttribute(&cus, hipDeviceAttributeMultiprocessorCount, dev) != hipSuccess) { fprintf(stderr, "kernel_launch: device query failed\n"); grid = -1; return; }
        if (hipFuncSetAttribute((const void*)trunk_fwd, hipFuncAttributeMaxDynamicSharedMemorySize, LDS_BYTES) != hipSuccess) { fprintf(stderr, "kernel_launch: hipFuncSetAttribute failed\n"); grid = -1; return; }
        if (hipOccupancyMaxActiveBlocksPerMultiprocessor(&per_cu, (const void*)trunk_fwd, NT, LDS_BYTES) != hipSuccess || per_cu < 1) { fprintf(stderr, "kernel_launch: occupancy query reports %d workgroups per CU\n", per_cu); }
        (void)hipGetLastError();
        grid = cus;
        if (grid != 256) { fprintf(stderr, "kernel_launch: built for a 256-CU device, found %d CUs; nothing launched\n", cus); grid = -1; return; }
    }
    if (grid < 0) return;
    if (hipMemsetAsync((char*)d_ws + WS_CTL, 0, CTL_ZERO_BYTES, stream) != hipSuccess) { fprintf(stderr, "kernel_launch: hipMemsetAsync failed\n"); return; }
    Args a{};
    for (int i = 0; i < 17; ++i) a.in[i] = (const float*)d_in[i];
    a.out = (float*)d_out; a.ws = (unsigned char*)d_ws;
    if (MK_N_LAUNCHES == 1) { a.ph_lo = 0; a.ph_hi = NPHASE; hipLaunchKernelGGL(trunk_fwd, dim3(grid), dim3(NT), LDS_BYTES, stream, a); }
    else for (int p = 0; p < NPHASE; ++p) { a.ph_lo = p; a.ph_hi = p + 1; hipLaunchKernelGGL(trunk_fwd, dim3(grid), dim3(NT), LDS_BYTES, stream, a); }
    const hipError_t le = hipPeekAtLastError();
    if (le != hipSuccess) fprintf(stderr, "kernel_launch: launch failed: %s\n", hipGetErrorName(le));
}
```
